# Optimizing an MI355X kernel written in HIP

```python
import math
import jax, jax.numpy as jnp
from jax import lax
import numpy as np

D_MODEL = 1024
BATCH = 8
SEQ = 4096
DEPTH = 2

GRID_W = 64
CTX_LEN = 256
NORM_EPS = 1e-6
N_MOD = 9

D_FF = 2816
MACARON_W = 0.5

D_LRU = 256
LRU_BLOCKS = 4
LRU_BS = D_LRU // LRU_BLOCKS
LRU_CONV = 4
LRU_PAD = (2, 1)
LRU_C = 8.0

D_HY = 256
HY_CONV = 3
HY_PAD = (1, 1)
HY_EMB = 33
HY_BANDS = (HY_EMB - 1) // 2
HY_HID = 64
HY_INNER = 2
HY_FAST = 0.3
HY_SLOW = 1.5
HY_TARGET = 1e-2

N_QH = 8
N_KVH = 2
HEAD_DIM = 64
Q_PER_KV = N_QH // N_KVH
D_ATTN = N_QH * HEAD_DIM
WINDOW = 128
BLOCK = 128
ROPE_THETA = 10000.0
ROPE_PAIRS_AXIS = HEAD_DIM // 4
NEG_INF = -1e30

D_IN = 2 * D_LRU + 3 * D_HY + (N_QH + 2 * N_KVH) * HEAD_DIM
D_CAT = D_LRU + D_HY + D_ATTN
SPLITS = np.cumsum([D_LRU, D_LRU, 3 * D_HY, N_QH * HEAD_DIM, N_KVH * HEAD_DIM]).tolist()

kernel_name = "hybrid_lru_hyena_swa_dit_block"

F32 = jnp.float32


def rmsnorm(x, g):
    xf = x.astype(F32)
    y = xf * lax.rsqrt(jnp.mean(xf * xf, axis=-1, keepdims=True) + NORM_EPS)
    return (y * g.astype(F32)).astype(x.dtype)


def ada_norm(x, g, shift, scale):
    return rmsnorm(x, g) * (1 + scale) + shift


def swiglu(h, w1, w2):
    a, b = jnp.split(h @ w1, 2, axis=-1)
    return (jax.nn.silu(a) * b) @ w2


def dwconv(x, w, b, pad):
    L = x.shape[1]
    xp = jnp.pad(x, ((0, 0), pad, (0, 0)))
    out = b
    for k in range(w.shape[0]):
        out = out + xp[:, k:k + L] * w[k]
    return out


def rglru_coeffs(u, wa, ba, wx, bx, lam):
    ub = u.reshape(u.shape[:-1] + (LRU_BLOCKS, LRU_BS))
    r = jax.nn.sigmoid(jnp.einsum('blnd,nde->blne', ub, wa.astype(F32)).reshape(u.shape) + ba.astype(F32))
    i = jax.nn.sigmoid(jnp.einsum('blnd,nde->blne', ub, wx.astype(F32)).reshape(u.shape) + bx.astype(F32))
    log_a = -LRU_C * r * jax.nn.softplus(-lam.astype(F32))
    a = jnp.exp(log_a)
    b = jnp.sqrt(-jnp.expm1(2.0 * log_a)) * (i * u)
    return a, b


def _combine(e1, e2):
    a1, b1 = e1
    a2, b2 = e2
    return a1 * a2, a2 * b1 + b2


def linear_scan(a, b, h0):
    a_cum, b_cum = lax.associative_scan(_combine, (a, b), axis=1)
    return a_cum * h0[:, None] + b_cum


def rglru_mixer(xl, gl, xlc, glc, conv_w, conv_b, wa, ba, wx, bx, lam, need_ctx):
    u = dwconv(xl, conv_w, conv_b, LRU_PAD).astype(F32)
    uc = dwconv(xlc, conv_w, conv_b, LRU_PAD).astype(F32)
    hs, hcs = [], []
    for d in range(2):
        ac, bc = rglru_coeffs(uc, wa[d], ba[d], wx[d], bx[d], lam[d])
        ax, bxl = rglru_coeffs(u, wa[d], ba[d], wx[d], bx[d], lam[d])
        if d == 1:
            ac, bc, ax, bxl = (jnp.flip(ac, 1), jnp.flip(bc, 1), jnp.flip(ax, 1), jnp.flip(bxl, 1))
        hc = linear_scan(ac, bc, jnp.zeros_like(ac[:, 0]))
        hx = linear_scan(ax, bxl, hc[:, -1])
        if d == 1:
            hc, hx = jnp.flip(hc, 1), jnp.flip(hx, 1)
        hs.append(hx)
        hcs.append(hc)
    y = ((hs[0] + hs[1]) * jax.nn.gelu(gl.astype(F32))).astype(xl.dtype)
    if not need_ctx:
        return y, None
    yc = ((hcs[0] + hcs[1]) * jax.nn.gelu(glc.astype(F32))).astype(xlc.dtype)
    return y, yc


def hyena_filter(L, fw0, fb0, fw_in, fb_in, freq, fw_last):
    t = jnp.linspace(0.0, 1.0, L, dtype=F32)[:, None]
    w = 2.0 * math.pi * jnp.arange(L, dtype=F32)[:, None] / L
    f = jnp.linspace(1e-4, HY_BANDS - 1, HY_BANDS, dtype=F32)[None, :]
    z = jnp.concatenate([t, jnp.cos(f * w), -jnp.sin(f * w)], axis=-1)
    fr = freq.astype(F32)
    hdn = jnp.sin(fr * (z @ fw0.astype(F32) + fb0.astype(F32)))
    for j in range(HY_INNER):
        hdn = jnp.sin(fr * (hdn @ fw_in[j].astype(F32) + fb_in[j].astype(F32)))
    k = hdn @ fw_last.astype(F32)
    max_decay = math.log(HY_TARGET) / HY_FAST
    min_decay = math.log(HY_TARGET) / HY_SLOW
    deltas = jnp.abs(jnp.linspace(min_decay, max_decay, D_HY, dtype=F32))
    decay = jnp.exp(-t * deltas)
    k_fwd = k[:, :D_HY] * decay
    k_bwd = k[:, D_HY:] * decay
    return jnp.concatenate([k_fwd, jnp.zeros((1, D_HY), F32), jnp.flip(k_bwd[1:], axis=0)], axis=0)


def hyena_op(z, conv_w, conv_b, fw0, fb0, fw_in, fb_in, freq, fw_last, skip):
    L = z.shape[1]
    zc = dwconv(z, conv_w, conv_b, HY_PAD).astype(F32)
    x0, x1, v = jnp.split(zc, 3, axis=-1)
    k = hyena_filter(L, fw0, fb0, fw_in, fb_in, freq, fw_last)
    u = x1 * v
    n = 2 * L
    y = jnp.fft.irfft(jnp.fft.rfft(u, n=n, axis=1) * jnp.fft.rfft(k, n=n, axis=0)[None], n=n, axis=1)[:, :L]
    y = y + u * skip.astype(F32)
    return (x0 * y).astype(z.dtype)


def rope_tables(rows):
    r = jnp.repeat(jnp.arange(rows, dtype=F32), GRID_W)
    col = jnp.tile(jnp.arange(GRID_W, dtype=F32), rows)
    inv = ROPE_THETA ** (-jnp.arange(ROPE_PAIRS_AXIS, dtype=F32) / ROPE_PAIRS_AXIS)
    ang = jnp.concatenate([r[:, None] * inv, col[:, None] * inv], axis=-1)
    return jnp.cos(ang), jnp.sin(ang)


def apply_rope(x, cos, sin):
    xf = x.astype(F32)
    x1, x2 = jnp.split(xf, 2, axis=-1)
    cc = cos[None, :, None]
    ss = sin[None, :, None]
    return jnp.concatenate([x1 * cc - x2 * ss, x1 * ss + x2 * cc], axis=-1).astype(x.dtype)


def sink_attend(s, vals, sink):
    sk = sink.astype(F32)[None, :, :, None, None]
    m = jnp.maximum(jnp.max(s, axis=-1, keepdims=True), sk)
    p = jnp.exp(s - m)
    denom = jnp.sum(p, axis=-1, keepdims=True) + jnp.exp(sk - m)
    return jnp.einsum('bhgqk,bkhd->bqhgd', p / denom, vals.astype(F32))


def window_attention(q, k, v, kc, vc, sink):
    B, L = q.shape[0], q.shape[1]
    nb = L // BLOCK
    span = BLOCK + 2 * WINDOW
    scale = HEAD_DIM ** -0.5
    qb = q.reshape(B, nb, BLOCK, N_KVH, Q_PER_KV, HEAD_DIM).swapaxes(0, 1)
    kp = jnp.pad(k, ((0, 0), (WINDOW, WINDOW), (0, 0), (0, 0)))
    vp = jnp.pad(v, ((0, 0), (WINDOW, WINDOW), (0, 0), (0, 0)))
    sink_g = sink.reshape(N_KVH, Q_PER_KV)
    n_ctx = kc.shape[1]

    def block_fn(args):
        qi, bi = args
        start = bi * BLOCK
        kw = lax.dynamic_slice_in_dim(kp, start, span, axis=1)
        vw = lax.dynamic_slice_in_dim(vp, start, span, axis=1)
        keys = jnp.concatenate([kw, kc], axis=1)
        vals = jnp.concatenate([vw, vc], axis=1)
        s = jnp.einsum('bqhgd,bkhd->bhgqk', qi, keys).astype(F32) * scale
        qpos = start + jnp.arange(BLOCK)
        kpos = start - WINDOW + jnp.arange(span)
        valid = (jnp.abs(qpos[:, None] - kpos[None, :]) <= WINDOW) & (kpos >= 0)[None] & (kpos < L)[None]
        valid = jnp.concatenate([valid, jnp.ones((BLOCK, n_ctx), dtype=bool)], axis=1)
        s = jnp.where(valid, s, NEG_INF)
        return sink_attend(s, vals, sink_g)

    o = lax.map(block_fn, (qb, jnp.arange(nb)))
    return o.swapaxes(0, 1).reshape(B, L, D_ATTN)


def context_attention(qc, kc, vc, sink):
    B, C = qc.shape[0], qc.shape[1]
    qg = qc.reshape(B, C, N_KVH, Q_PER_KV, HEAD_DIM)
    s = jnp.einsum('bqhgd,bkhd->bhgqk', qg, kc).astype(F32) * (HEAD_DIM ** -0.5)
    return sink_attend(s, vc, sink.reshape(N_KVH, Q_PER_KV)).reshape(B, C, D_ATTN)


def token_mixer(h, hc, cos, sin, w_in, w_out, lru_conv_w, lru_conv_b, lru_wa, lru_ba, lru_wx, lru_bx,
                lru_lam, hy_conv_w, hy_conv_b, hy_fw0, hy_fb0, hy_fw_in, hy_fb_in, hy_freq, hy_fw_last,
                hy_skip, attn_sink, need_ctx):
    B, L = h.shape[0], h.shape[1]
    C = hc.shape[1]
    xl, gl, zh, q, k, v = jnp.split(h @ w_in, SPLITS, axis=-1)
    xlc, glc, zhc, qc, kc, vc = jnp.split(hc @ w_in, SPLITS, axis=-1)

    y_lru, yc_lru = rglru_mixer(xl, gl, xlc, glc, lru_conv_w, lru_conv_b, lru_wa, lru_ba,
                                lru_wx, lru_bx, lru_lam, need_ctx)
    y_hy = hyena_op(zh, hy_conv_w, hy_conv_b, hy_fw0, hy_fb0, hy_fw_in, hy_fb_in, hy_freq, hy_fw_last, hy_skip)

    q = apply_rope(q.reshape(B, L, N_QH, HEAD_DIM), cos, sin)
    k = apply_rope(k.reshape(B, L, N_KVH, HEAD_DIM), cos, sin)
    v = v.reshape(B, L, N_KVH, HEAD_DIM)
    kc = kc.reshape(B, C, N_KVH, HEAD_DIM)
    vc = vc.reshape(B, C, N_KVH, HEAD_DIM)
    y_att = window_attention(q, k, v, kc, vc, attn_sink).astype(h.dtype)

    y = jnp.concatenate([y_lru, y_hy, y_att], axis=-1) @ w_out
    if not need_ctx:
        return y, None
    yc_hy = hyena_op(zhc, hy_conv_w, hy_conv_b, hy_fw0, hy_fb0, hy_fw_in, hy_fb_in, hy_freq, hy_fw_last, hy_skip)
    yc_att = context_attention(qc.reshape(B, C, N_QH, HEAD_DIM), kc, vc, attn_sink).astype(hc.dtype)
    yc = jnp.concatenate([yc_lru, yc_hy, yc_att], axis=-1) @ w_out
    return y, yc


def setup_inputs(seed: int = 0) -> dict:
    key = jax.random.key(seed)
    ks = jax.random.split(key, 32)
    D = D_MODEL

    def nrm(k, shape, s):
        return jax.random.normal(k, shape, F32) * s

    u = jax.random.uniform(ks[17], (DEPTH, 2, D_LRU), F32, 0.9, 0.999)
    a = u ** (1.0 / LRU_C)
    lam = jnp.log(a) - jnp.log1p(-a)
    return {
        "x": nrm(ks[0], (BATCH, SEQ, D), 1.0),
        "c": nrm(ks[1], (BATCH, D), 1.0),
        "ctx": nrm(ks[2], (BATCH, CTX_LEN, D), 1.0),
        "c_ctx": nrm(ks[3], (D,), 1.0),
        "w_mod": nrm(ks[4], (DEPTH, D, N_MOD * D), 0.5 * D ** -0.5),
        "b_mod": nrm(ks[5], (DEPTH, N_MOD * D), 0.02),
        "norm_g": 1.0 + nrm(ks[6], (DEPTH, 3, D), 0.05),
        "ffn_w1": nrm(ks[7], (DEPTH, 2, D, 2 * D_FF), D ** -0.5),
        "ffn_w2": nrm(ks[8], (DEPTH, 2, D_FF, D), D_FF ** -0.5),
        "w_in": nrm(ks[9], (DEPTH, D, D_IN), D ** -0.5),
        "w_out": nrm(ks[10], (DEPTH, D_CAT, D), D_CAT ** -0.5),
        "lru_conv_w": nrm(ks[11], (DEPTH, LRU_CONV, D_LRU), LRU_CONV ** -0.5),
        "lru_conv_b": nrm(ks[12], (DEPTH, D_LRU), 0.02),
        "lru_wa": nrm(ks[13], (DEPTH, 2, LRU_BLOCKS, LRU_BS, LRU_BS), LRU_BS ** -0.5),
        "lru_ba": nrm(ks[14], (DEPTH, 2, D_LRU), 0.02),
        "lru_wx": nrm(ks[15], (DEPTH, 2, LRU_BLOCKS, LRU_BS, LRU_BS), LRU_BS ** -0.5),
        "lru_bx": nrm(ks[16], (DEPTH, 2, D_LRU), 0.02),
        "lru_lam": lam,
        "hy_conv_w": nrm(ks[18], (DEPTH, HY_CONV, 3 * D_HY), HY_CONV ** -0.5),
        "hy_conv_b": nrm(ks[19], (DEPTH, 3 * D_HY), 0.02),
        "hy_fw0": nrm(ks[20], (DEPTH, HY_EMB, HY_HID), HY_EMB ** -0.5),
        "hy_fb0": nrm(ks[21], (DEPTH, HY_HID), 0.1),
        "hy_fw_in": nrm(ks[22], (DEPTH, HY_INNER, HY_HID, HY_HID), HY_HID ** -0.5),
        "hy_fb_in": nrm(ks[23], (DEPTH, HY_INNER, HY_HID), 0.1),
        "hy_freq": 1.0 + nrm(ks[24], (DEPTH, HY_HID), 0.05),
        "hy_fw_last": nrm(ks[25], (DEPTH, HY_HID, 2 * D_HY), 0.1 * HY_HID ** -0.5),
        "hy_skip": nrm(ks[26], (DEPTH, D_HY), 0.5),
        "attn_sink": nrm(ks[27], (DEPTH, N_QH), 0.5),
        "final_g": 1.0 + nrm(ks[28], (D,), 0.05),
    }


def reference(x, c, ctx, c_ctx, w_mod, b_mod, norm_g, ffn_w1, ffn_w2, w_in, w_out, lru_conv_w, lru_conv_b,
              lru_wa, lru_ba, lru_wx, lru_bx, lru_lam, hy_conv_w, hy_conv_b, hy_fw0, hy_fb0, hy_fw_in,
              hy_fb_in, hy_freq, hy_fw_last, hy_skip, attn_sink, final_g):
    B = x.shape[0]
    ROWS = x.shape[1] // GRID_W
    cos, sin = rope_tables(ROWS)
    s_lat = jax.nn.silu(c)
    s_ctx = jax.nn.silu(c_ctx)
    xc = ctx
    for l in range(DEPTH):
        need_ctx = l < DEPTH - 1
        mod = (s_lat @ w_mod[l] + b_mod[l]).reshape(B, N_MOD, 1, D_MODEL)
        modc = (s_ctx @ w_mod[l] + b_mod[l]).reshape(N_MOD, D_MODEL)
        m = [mod[:, i] for i in range(N_MOD)]
        mc = [modc[i] for i in range(N_MOD)]

        x = x + MACARON_W * m[2] * swiglu(ada_norm(x, norm_g[l, 0], m[0], m[1]), ffn_w1[l, 0], ffn_w2[l, 0])
        xc = xc + MACARON_W * mc[2] * swiglu(ada_norm(xc, norm_g[l, 0], mc[0], mc[1]), ffn_w1[l, 0], ffn_w2[l, 0])

        h = ada_norm(x, norm_g[l, 1], m[3], m[4])
        hc = ada_norm(xc, norm_g[l, 1], mc[3], mc[4])
        y, yc = token_mixer(h, hc, cos, sin, w_in[l], w_out[l], lru_conv_w[l], lru_conv_b[l], lru_wa[l],
                            lru_ba[l], lru_wx[l], lru_bx[l], lru_lam[l], hy_conv_w[l], hy_conv_b[l], hy_fw0[l],
                            hy_fb0[l], hy_fw_in[l], hy_fb_in[l], hy_freq[l], hy_fw_last[l], hy_skip[l],
                            attn_sink[l], need_ctx)
        x = x + m[5] * y

        x = x + MACARON_W * m[8] * swiglu(ada_norm(x, norm_g[l, 2], m[6], m[7]), ffn_w1[l, 1], ffn_w2[l, 1])
        if need_ctx:
            xc = xc + mc[5] * yc
            xc = xc + MACARON_W * mc[8] * swiglu(ada_norm(xc, norm_g[l, 2], mc[6], mc[7]), ffn_w1[l, 1], ffn_w2[l, 1])
    return rmsnorm(x, final_g)
```

```cpp
#include <hip/hip_runtime.h>
#include <hip/hip_cooperative_groups.h>
#include <cstdio>
namespace cg = cooperative_groups;

using bf16x8 = __attribute__((ext_vector_type(8))) short;
using bf16x4 = __attribute__((ext_vector_type(4))) short;
using f32x4  = __attribute__((ext_vector_type(4))) float;
typedef unsigned short u16;
#define DEVI __device__ __forceinline__

constexpr int D = 1024, NB = 8, SEQ = 4096, CTXL = 256, TL = NB * SEQ, TC = NB * CTXL, T = TL + TC;
constexpr int DFF = 2816, DIN = 2048;
constexpr int NTHREADS = 512;
constexpr int LDS_BYTES = 131072;

constexpr size_t OFF_X    = 0;
constexpr size_t OFF_H    = OFF_X + (size_t)T * D * 4;
constexpr size_t OFF_BIG  = OFF_H + (size_t)T * D * 2;
constexpr size_t OFF_PT   = OFF_BIG;
constexpr size_t OFF_QK   = OFF_PT + (size_t)1408 * T * 2;
constexpr size_t OFF_UT   = OFF_QK + (size_t)T * 640 * 2;
constexpr size_t OFF_X0T  = OFF_UT + (size_t)256 * T * 2;
constexpr size_t OFF_SUMM = OFF_X0T + (size_t)256 * T * 2;
constexpr size_t OFF_W1T  = OFF_BIG + (size_t)T * DFF * 2;
constexpr size_t OFF_W2T  = OFF_W1T + (size_t)4 * 5632 * 1024 * 2;
constexpr size_t OFF_WINT = OFF_W2T + (size_t)4 * 1024 * 2816 * 2;
constexpr size_t OFF_WOT  = OFF_WINT + (size_t)2 * 2048 * 1024 * 2;
constexpr size_t OFF_MOD  = OFF_WOT + (size_t)2 * 1024 * 1024 * 2;
constexpr size_t OFF_KF   = OFF_MOD + (size_t)2 * 9 * 9216 * 4;
constexpr size_t OFF_KFC  = OFF_KF + (size_t)2 * 256 * 8192 * 2;
constexpr size_t OFF_ROPE = OFF_KFC + (size_t)256 * 512 * 2;
constexpr size_t WS_END   = OFF_ROPE + (size_t)2 * 4096 * 32 * 4;
static_assert(OFF_SUMM + 2 * 272 * 256 * 8 <= OFF_W1T, "mixer buffers overflow ACT region");

struct Params {
  const float* in[29];
  float* out;
  unsigned char* ws;
};

extern __shared__ __attribute__((aligned(16))) unsigned char smem[];

DEVI unsigned pk_bf16(float lo, float hi) { unsigned r; asm volatile("v_cvt_pk_bf16_f32 %0, %1, %2" : "=v"(r) : "v"(lo), "v"(hi)); return r; }
DEVI u16 f2bf(float x) { return (u16)(pk_bf16(x, 0.f) & 0xffffu); }
DEVI float bf2f(u16 h) { return __uint_as_float(((unsigned)h) << 16); }
DEVI float sigmoidf_(float x) { return 1.f / (1.f + __expf(-x)); }
DEVI float gelu_tanh(float x) { float z = 0.7978845608028654f * (x + 0.044715f * x * x * x); float th = 1.f - 2.f / (1.f + __expf(2.f * z)); return 0.5f * x * (1.f + th); }
template <class Tp> DEVI const Tp* opaque(const Tp* q) { asm volatile("" : "+s"(q)); return q; }
DEVI int otid() { int t = threadIdx.x; asm volatile("" : "+v"(t)); return t; }
DEVI float shx(float v, int o, int lane) { return __int_as_float(__builtin_amdgcn_ds_bpermute((lane ^ o) << 2, __float_as_int(v))); }
DEVI f32x4 mfma16(bf16x8 a, bf16x8 b, f32x4 c) { return __builtin_amdgcn_mfma_f32_16x16x32_bf16(a, b, c, 0, 0, 0); }

constexpr int BM = 256, BK = 64, HALF = 128, HT = HALF * BK;
DEVI int lds_byte(int r, int c) { int st = (r >> 4) * 2 + (c >> 5), rr = r & 15, cc = c & 31, ob = rr * 64 + cc * 2; return st * 1024 + (ob ^ (((ob >> 9) & 1) << 5)); }
DEVI void stage_rc(int b, int& R, int& C) { int st = b / 1024, sb = b % 1024, swz = sb ^ (((sb >> 9) & 1) << 5); R = (st >> 1) * 16 + swz / 64; C = (st & 1) * 32 + (swz % 64) / 2; }

template <class Epi>
DEVI void gemm_tile(const u16* __restrict__ A, const u16* __restrict__ Bt, const int K, const int brow, const int bcol, const Epi& epi) {
  u16* shm = (u16*)smem;
#define SA(b, h) (shm + ((b) * 2 + (h)) * HT)
#define SB(b, h) (shm + (4 + (b) * 2 + (h)) * HT)
#define STAGE(P, BASE, br, kt) do { const char* _ub = (const char*)(BASE + (long)(br) * K + (long)(kt) * BK); \
      __builtin_amdgcn_global_load_lds((const unsigned*)(_ub + soff0), (unsigned*)((char*)(P) + tid * 16), 16, 0, 0); \
      __builtin_amdgcn_global_load_lds((const unsigned*)(_ub + soff1), (unsigned*)((char*)(P) + tid * 16 + 8192), 16, 0, 0); } while (0)
#define LDA(dst, b, h) for (int m = 0; m < 4; ++m) for (int k = 0; k < 2; ++k) \
    dst[m][k] = *reinterpret_cast<const bf16x8*>((char*)SA(b, h) + lds_byte(wr * 64 + m * 16 + fr, k * 32 + fq * 8))
#define LDB(dst, b, h) for (int n = 0; n < 2; ++n) for (int k = 0; k < 2; ++k) \
    dst[n][k] = *reinterpret_cast<const bf16x8*>((char*)SB(b, h) + lds_byte(wc * 32 + n * 16 + fr, k * 32 + fq * 8))
#define MMA(ai, bj, At_, Bt_) do { __builtin_amdgcn_s_setprio(1); \
    for (int m = 0; m < 4; ++m) for (int n = 0; n < 2; ++n) for (int k = 0; k < 2; ++k) \
      acc[ai][bj][m][n] = __builtin_amdgcn_mfma_f32_16x16x32_bf16(At_[m][k], Bt_[n][k], acc[ai][bj][m][n], 0, 0, 0); \
    __builtin_amdgcn_s_setprio(0); } while (0)
#define WAIT_V(n) asm volatile("s_waitcnt vmcnt(" #n ")" ::: "memory")
#define WAIT_L(n) asm volatile("s_waitcnt lgkmcnt(" #n ")" ::: "memory")
#define BAR __builtin_amdgcn_s_barrier()
#define SCHED __builtin_amdgcn_sched_barrier(0)
  const int tid = otid();
  const int wid = tid >> 6, lane = tid & 63, wr = wid >> 2, wc = wid & 3, fr = lane & 15, fq = lane >> 4;
  unsigned soff0, soff1;
  { int r_, c_; stage_rc(tid * 16, r_, c_); soff0 = (unsigned)(r_ * K + c_) * 2u; stage_rc(tid * 16 + 8192, r_, c_); soff1 = (unsigned)(r_ * K + c_) * 2u; }
  f32x4 acc[2][2][4][2] = {};
  bf16x8 At[4][2], B0[2][2], B1[2][2];
  const int nt = K / BK;
  STAGE(SB(0, 0), Bt, bcol, 0); STAGE(SA(0, 0), A, brow, 0);
  STAGE(SB(0, 1), Bt, bcol + HALF, 0); STAGE(SA(0, 1), A, brow + HALF, 0);
  if (wr == 1) BAR;
  WAIT_V(4); BAR;
  STAGE(SB(1, 0), Bt, bcol, 1); STAGE(SA(1, 0), A, brow, 1); STAGE(SB(1, 1), Bt, bcol + HALF, 1);
  WAIT_V(6); BAR;
  for (int t = 0; t < nt - 2; t += 2) {
    LDB(B0, 0, 0); SCHED; LDA(At, 0, 0); STAGE(SA(1, 1), A, brow + HALF, t + 1);
    WAIT_L(8); BAR; WAIT_L(0); MMA(0, 0, At, B0); BAR; SCHED;
    LDB(B1, 0, 1); STAGE(SB(0, 0), Bt, bcol, t + 2);
    BAR; WAIT_L(0); MMA(0, 1, At, B1); BAR;
    LDA(At, 0, 1); STAGE(SA(0, 0), A, brow, t + 2);
    BAR; WAIT_L(0); MMA(1, 0, At, B0); BAR; SCHED;
    STAGE(SB(0, 1), Bt, bcol + HALF, t + 2);
    WAIT_V(6); BAR; MMA(1, 1, At, B1); BAR;
    LDB(B0, 1, 0); SCHED; LDA(At, 1, 0); STAGE(SA(0, 1), A, brow + HALF, t + 2);
    WAIT_L(8); BAR; WAIT_L(0); MMA(0, 0, At, B0); BAR; SCHED;
    LDB(B1, 1, 1); STAGE(SB(1, 0), Bt, bcol, t + 3);
    BAR; WAIT_L(0); MMA(0, 1, At, B1); BAR;
    LDA(At, 1, 1); STAGE(SA(1, 0), A, brow, t + 3);
    BAR; WAIT_L(0); MMA(1, 0, At, B0); BAR; SCHED;
    STAGE(SB(1, 1), Bt, bcol + HALF, t + 3);
    WAIT_V(6); BAR; MMA(1, 1, At, B1); BAR;
  }
  { LDB(B0, 0, 0); LDA(At, 0, 0); STAGE(SA(1, 1), A, brow + HALF, nt - 1);
    BAR; WAIT_L(0); MMA(0, 0, At, B0); BAR;
    LDB(B1, 0, 1); BAR; WAIT_L(0); MMA(0, 1, At, B1); BAR;
    LDA(At, 0, 1); WAIT_V(4); BAR; WAIT_L(0); MMA(1, 0, At, B0); MMA(1, 1, At, B1); BAR; }
  { LDB(B0, 1, 0); LDA(At, 1, 0); WAIT_V(2); BAR; WAIT_L(0); MMA(0, 0, At, B0); BAR;
    LDB(B1, 1, 1); WAIT_V(0); BAR; WAIT_L(0); MMA(0, 1, At, B1); BAR;
    LDA(At, 1, 1); BAR; WAIT_L(0); MMA(1, 0, At, B0); MMA(1, 1, At, B1); BAR; }
  if (wr == 0) BAR;
#pragma unroll
  for (int ai = 0; ai < 2; ++ai)
#pragma unroll
    for (int bj = 0; bj < 2; ++bj)
#pragma unroll
      for (int m = 0; m < 4; ++m) {
        const int row0 = brow + ai * HALF + wr * 64 + m * 16 + fq * 4;
        const int colb = bcol + bj * HALF + wc * 32;
        epi(row0, colb, fr, acc[ai][bj][m][0], acc[ai][bj][m][1]);
      }
  __syncthreads();
#undef SA
#undef SB
#undef STAGE
#undef LDA
#undef LDB
#undef MMA
}

DEVI bool tile_next(int i, int nM, int nN, int& pm, int& pn) {
  const int nwg = nM * nN; const long Lx = (long)i * gridDim.x + blockIdx.x; if (Lx >= nwg) return false;
  int wgid = (int)Lx; { const int q = nwg / 8, r = nwg % 8, xcd = wgid % 8, off = wgid / 8; wgid = (xcd < r ? xcd * (q + 1) : r * (q + 1) + (xcd - r) * q) + off; }
  const int nig = 8 * nN, gid = wgid / nig, fm = gid * 8, gsz = (nM - fm) < 8 ? (nM - fm) : 8;
  pm = fm + ((wgid % nig) % gsz); pn = (wgid % nig) / gsz; return true;
}
template <class Epi>
DEVI void gemm_phase(const u16* A, const u16* Bt, int M, int N, int K, const Epi& epi) {
  const int nM = M / BM, nN = N / BM;
  for (int i = 0;; ++i) { int pm, pn; if (!tile_next(i, nM, nN, pm, pn)) break; gemm_tile(A, Bt, K, pm * BM, pn * BM, epi); }
}

struct EpiAct {
  u16* act;
  DEVI void operator()(int row0, int colb, int fr, const f32x4& a0, const f32x4& a1) const {
    const int oc = (colb >> 5) * 16 + fr;
#pragma unroll
    for (int j = 0; j < 4; ++j) { float a = a0[j]; float v = a * sigmoidf_(a) * a1[j]; act[(size_t)(row0 + j) * DFF + oc] = f2bf(v); }
  }
};
struct EpiRes {
  const float* xin_lat; const float* xin_ctx;
  float* xout; const float* modl;
  int gi; float coef;
  DEVI void operator()(int row0, int colb, int fr, const f32x4& a0, const f32x4& a1) const {
    const int r = row0 < TL ? (row0 >> 12) : 8;
    const float* gate = modl + (size_t)(r * 9 + gi) * D;
#pragma unroll
    for (int n = 0; n < 2; ++n) {
      const int col = colb + n * 16 + fr; const float gv = coef * gate[col];
#pragma unroll
      for (int j = 0; j < 4; ++j) {
        const int row = row0 + j;
        const float* src = row < TL ? xin_lat + (size_t)row * D : xin_ctx + (size_t)(row - TL) * D;
        xout[(size_t)row * D + col] = src[col] + gv * (n ? a1[j] : a0[j]);
      }
    }
  }
};
struct EpiProj {
  u16* pt; u16* qk; const float* cost; const float* sint;
  DEVI void operator()(int row0, int colb, int fr, const f32x4& a0, const f32x4& a1) const {
    if (colb < 1280 || colb >= 1920) {
#pragma unroll
      for (int n = 0; n < 2; ++n) {
        const int pc = colb + n * 16 + fr; const int ptc = pc < 1280 ? pc : pc - 640;
        const f32x4& a = n ? a1 : a0;
        uint2 o; o.x = pk_bf16(a[0], a[1]); o.y = pk_bf16(a[2], a[3]);
        *(uint2*)(pt + (size_t)ptc * T + row0) = o;
      }
    } else {
      const int off = colb - 1280, head = off >> 6, grp = (off >> 5) & 1, pidx = 16 * grp + fr;
      const int d1 = head * 64 + pidx, d2 = d1 + 32;
      const float qs = head < 8 ? 0.125f : 1.f;
#pragma unroll
      for (int j = 0; j < 4; ++j) {
        const int row = row0 + j; float c = 1.f, s = 0.f;
        if (row < TL) { const int t = row & 4095; c = cost[t * 32 + pidx]; s = sint[t * 32 + pidx]; }
        const float o1 = (a0[j] * c - a1[j] * s) * qs, o2 = (a0[j] * s + a1[j] * c) * qs;
        qk[(size_t)row * 640 + d1] = f2bf(o1); qk[(size_t)row * 640 + d2] = f2bf(o2);
      }
    }
  }
};

DEVI int srccol(int mode, int pn) {
  if (mode == 1) { const int g = pn >> 5, hh = (pn >> 4) & 1, i = pn & 15; return hh * DFF + g * 16 + i; }
  if (mode == 2) { if (pn < 1280 || pn >= 1920) return pn; const int off = pn - 1280, head = off >> 6, w = off & 63, grp = w >> 5, hh = (w >> 4) & 1, i = w & 15; return 1280 + head * 64 + 16 * grp + i + 32 * hh; }
  return pn;
}
DEVI void transpose_item(const float* __restrict__ W, int K, int N, u16* __restrict__ WT, int mode, int item) {
  float* tile = (float*)smem;
  const int tid = otid(), nblk = N / 64, kb = item / nblk, nb = item % nblk, k0 = kb * 64, n0 = nb * 64;
  { const int nn = tid & 63, kr = tid >> 6, src = srccol(mode, n0 + nn);
#pragma unroll
    for (int r = 0; r < 8; ++r) { const int kk = kr + 8 * r; tile[kk * 65 + nn] = W[(size_t)(k0 + kk) * N + src]; } }
  __syncthreads();
  { const int rown = tid >> 3, kc = tid & 7; const float* s = tile + (kc * 8) * 65 + rown;
    uint4 o; o.x = pk_bf16(s[0], s[65]); o.y = pk_bf16(s[130], s[195]); o.z = pk_bf16(s[260], s[325]); o.w = pk_bf16(s[390], s[455]);
    *(uint4*)(WT + (size_t)(n0 + rown) * K + k0 + kc * 8) = o; }
  __syncthreads();
}
DEVI void mod_item(const Params& p, int item) {
  float* sv = (float*)smem;
  float* red = sv + 9 * 1024;
  const int tid = otid(), l = item / 72, n0 = (item % 72) * 128;
  for (int i = tid; i < 9 * 1024; i += NTHREADS) { const int r = i >> 10, k = i & 1023; const float cv = r < 8 ? p.in[1][r * 1024 + k] : p.in[3][k]; sv[i] = cv * sigmoidf_(cv); }
  __syncthreads();
  const int cc = tid & 127, kq = tid >> 7;
  const float* w = p.in[4] + (size_t)l * 1024 * 9216 + n0 + cc;
  float acc[9];
#pragma unroll
  for (int r = 0; r < 9; ++r) acc[r] = 0.f;
#pragma unroll 2
  for (int k4 = 0; k4 < 64; ++k4) {
    const int k = kq * 256 + k4 * 4;
    const float w0 = w[(size_t)k * 9216], w1 = w[(size_t)(k + 1) * 9216], w2 = w[(size_t)(k + 2) * 9216], w3 = w[(size_t)(k + 3) * 9216];
#pragma unroll
    for (int r = 0; r < 9; ++r) { const float4 s4 = *(const float4*)(sv + r * 1024 + k); acc[r] += s4.x * w0 + s4.y * w1 + s4.z * w2 + s4.w * w3; }
  }
#pragma unroll
  for (int r = 0; r < 9; ++r) red[(kq * 9 + r) * 128 + cc] = acc[r];
  __syncthreads();
  float* MOD = (float*)(p.ws + OFF_MOD);
  for (int i = tid; i < 9 * 128; i += NTHREADS) {
    const int r = i >> 7, c2 = i & 127;
    const float v = red[(0 * 9 + r) * 128 + c2] + red[(1 * 9 + r) * 128 + c2] + red[(2 * 9 + r) * 128 + c2] + red[(3 * 9 + r) * 128 + c2] + p.in[5][l * 9216 + n0 + c2];
    MOD[(size_t)(l * 9 + r) * 9216 + n0 + c2] = v;
  }
  __syncthreads();
}
DEVI void filter_item(const Params& p, int l, int L, u16* __restrict__ KF, int posblk) {
  float* zs = (float*)smem;
  float* hb = zs + 8 * 36;
  const int tid = otid(), w = tid >> 6, j = tid & 63, t = posblk * 8 + w;
  const float* fw0 = opaque(p.in[20] + l * 33 * 64); const float* fb0 = opaque(p.in[21] + l * 64);
  const float* fwin = opaque(p.in[22] + l * 2 * 64 * 64); const float* fbin = opaque(p.in[23] + l * 2 * 64);
  const float* freq = opaque(p.in[24] + l * 64); const float* fwl = opaque(p.in[25] + l * 64 * 512);
  const float tn = (float)t / (float)(L - 1);
  if (j < 33) {
    float z;
    if (j == 0) z = tn;
    else { const int bi = (j - 1) & 15; const float f = 1e-4f + (float)bi * ((15.f - 1e-4f) / 15.f); const float wv = 6.283185307179586f * (float)t / (float)L; const float a = f * wv; z = (j <= 16) ? __cosf(a) : -__sinf(a); }
    zs[w * 36 + j] = z;
  }
  __syncthreads();
  const float fr = freq[j];
  { float acc = fb0[j];
#pragma unroll 3
    for (int i = 0; i < 33; ++i) acc += zs[w * 36 + i] * fw0[i * 64 + j];
    hb[(0 * 8 + w) * 64 + j] = __sinf(fr * acc); }
  __syncthreads();
#pragma unroll
  for (int q = 0; q < 2; ++q) {
    float acc = fbin[q * 64 + j];
#pragma unroll 8
    for (int i = 0; i < 64; ++i) acc += hb[((q & 1) * 8 + w) * 64 + i] * fwin[q * 4096 + i * 64 + j];
    hb[(((q + 1) & 1) * 8 + w) * 64 + j] = __sinf(fr * acc);
    __syncthreads();
  }
  const float mind = -3.0701134573253945f, maxd = -15.350567286626973f;
#pragma unroll 1
  for (int qq = 0; qq < 8; ++qq) {
    const int n = j + 64 * qq;
    float acc = 0.f;
#pragma unroll 8
    for (int i = 0; i < 64; ++i) acc += hb[(0 * 8 + w) * 64 + i] * fwl[i * 512 + n];
    const int c = n & 255; const float delta = fabsf(mind + (float)c * ((maxd - mind) / 255.f));
    const float val = acc * __expf(-tn * delta);
    if (n < 256) KF[(size_t)c * 2 * L + (L - t)] = f2bf(val);
    else if (t >= 1) KF[(size_t)c * 2 * L + (L + t)] = f2bf(val);
  }
  if (t == 0) {
#pragma unroll
    for (int qq = 0; qq < 4; ++qq) KF[(size_t)(j + 64 * qq) * 2 * L] = 0;
  }
  __syncthreads();
}
DEVI void phase0(const Params& p) {
  const int N_MOD_IT = 144, N_FIL = 512 + 512 + 32;
  constexpr int I_W1 = 16 * 88, I_W2 = 44 * 16, I_WIN = 16 * 32, I_WO = 16 * 16;
  const int N_TR = 4 * I_W1 + 4 * I_W2 + 2 * I_WIN + 2 * I_WO;
  const int NIT = N_MOD_IT + N_FIL + N_TR;
  for (int it = blockIdx.x; it < NIT; it += gridDim.x) {
    asm volatile("" ::: "memory");
    int r = it;
    if (r < N_MOD_IT) { mod_item(p, r); continue; } r -= N_MOD_IT;
    if (r < N_FIL) {
      if (r < 512) filter_item(p, 0, 4096, (u16*)(p.ws + OFF_KF), r);
      else if (r < 1024) filter_item(p, 1, 4096, (u16*)(p.ws + OFF_KF) + (size_t)256 * 8192, r - 512);
      else filter_item(p, 0, 256, (u16*)(p.ws + OFF_KFC), r - 1024);
      continue;
    }
    r -= N_FIL;
    if (r < 4 * I_W1) { const int mi = r / I_W1; transpose_item(p.in[7] + (size_t)mi * 1024 * 5632, 1024, 5632, (u16*)(p.ws + OFF_W1T) + (size_t)mi * 5632 * 1024, 1, r % I_W1); continue; } r -= 4 * I_W1;
    if (r < 4 * I_W2) { const int mi = r / I_W2; transpose_item(p.in[8] + (size_t)mi * 2816 * 1024, 2816, 1024, (u16*)(p.ws + OFF_W2T) + (size_t)mi * 1024 * 2816, 0, r % I_W2); continue; } r -= 4 * I_W2;
    if (r < 2 * I_WIN) { const int mi = r / I_WIN; transpose_item(p.in[9] + (size_t)mi * 1024 * 2048, 1024, 2048, (u16*)(p.ws + OFF_WINT) + (size_t)mi * 2048 * 1024, 2, r % I_WIN); continue; } r -= 2 * I_WIN;
    { const int mi = r / I_WO; transpose_item(p.in[10] + (size_t)mi * 1024 * 1024, 1024, 1024, (u16*)(p.ws + OFF_WOT) + (size_t)mi * 1024 * 1024, 0, r % I_WO); }
  }
  float* cost = (float*)(p.ws + OFF_ROPE); float* sint = cost + 4096 * 32;
  for (int idx = blockIdx.x * NTHREADS + otid(); idx < 4096 * 32; idx += gridDim.x * NTHREADS) {
    const int t = idx >> 5, pp = idx & 31;
    const float inv = exp2f(-(float)(pp & 15) * (13.287712379549449f / 16.f));
    const float pos = pp < 16 ? (float)(t >> 6) : (float)(t & 63);
    const float ang = pos * inv;
    cost[idx] = __cosf(ang); sint[idx] = __sinf(ang);
  }
}

DEVI float wave_sum(float v, int lane) {
#pragma unroll
  for (int o = 1; o < 64; o <<= 1) v += shx(v, o, lane);
  return v;
}
DEVI void norm_phase(const Params& p, int l, int which, int Mrows, bool from_input) {
  const int tid = otid();
  const int lane = tid & 63, gw = blockIdx.x * 8 + (tid >> 6), NW = gridDim.x * 8;
  const float* X = (const float*)(p.ws + OFF_X); u16* H = (u16*)(p.ws + OFF_H);
  const float* MOD = (const float*)(p.ws + OFF_MOD);
  const f32x4* g4 = (const f32x4*)(p.in[6] + (size_t)(l * 3 + which) * D) + lane;
  for (int row = gw; row < Mrows; row += NW) {
    const float* xr = from_input ? (row < TL ? p.in[0] + (size_t)row * D : p.in[2] + (size_t)(row - TL) * D) : X + (size_t)row * D;
    const int r = row < TL ? (row >> 12) : 8;
    const f32x4* sh4 = (const f32x4*)(MOD + (size_t)((l * 9 + r) * 9 + which * 3) * D) + lane;
    const f32x4* sc4 = sh4 + D / 4;
    const f32x4* x4 = (const f32x4*)xr + lane;
    f32x4 v[4]; float ss = 0.f;
#pragma unroll
    for (int j = 0; j < 4; ++j) { v[j] = x4[64 * j]; ss += (v[j][0] * v[j][0] + v[j][1] * v[j][1]) + (v[j][2] * v[j][2] + v[j][3] * v[j][3]); }
    const float rinv = rsqrtf(wave_sum(ss, lane) * (1.f / D) + 1e-6f);
    uint2* o8 = (uint2*)(H + (size_t)row * D) + lane;
#pragma unroll
    for (int j = 0; j < 4; ++j) {
      const f32x4 g = g4[64 * j], sh = sh4[64 * j], sc = sc4[64 * j];
      f32x4 y;
#pragma unroll
      for (int q = 0; q < 4; ++q) y[q] = v[j][q] * rinv * g[q] * (1.f + sc[q]) + sh[q];
      uint2 o; o.x = pk_bf16(y[0], y[1]); o.y = pk_bf16(y[2], y[3]); o8[64 * j] = o;
    }
  }
}
DEVI void final_norm_phase(const Params& p) {
  const int tid = otid();
  const int lane = tid & 63, gw = blockIdx.x * 8 + (tid >> 6), NW = gridDim.x * 8;
  const float* X = (const float*)(p.ws + OFF_X);
  const f32x4* g4 = (const f32x4*)p.in[28] + lane;
  for (int row = gw; row < TL; row += NW) {
    const f32x4* x4 = (const f32x4*)(X + (size_t)row * D) + lane;
    f32x4 v[4]; float ss = 0.f;
#pragma unroll
    for (int j = 0; j < 4; ++j) { v[j] = x4[64 * j]; ss += (v[j][0] * v[j][0] + v[j][1] * v[j][1]) + (v[j][2] * v[j][2] + v[j][3] * v[j][3]); }
    const float rinv = rsqrtf(wave_sum(ss, lane) * (1.f / D) + 1e-6f);
    f32x4* o4 = (f32x4*)(p.out + (size_t)row * D) + lane;
#pragma unroll
    for (int j = 0; j < 4; ++j) { const f32x4 g = g4[64 * j]; f32x4 y; for (int q = 0; q < 4; ++q) y[q] = v[j][q] * rinv * g[q]; o4[64 * j] = y; }
  }
}

DEVI void attn_item(const Params& p, int l, int item) {
  const u16* QK = (const u16*)(p.ws + OFF_QK); const u16* PT = (const u16*)(p.ws + OFF_PT); u16* YC = (u16*)(p.ws + OFF_H);
  const int tid = otid();
  const int wave = tid >> 6, lane = tid & 63, fr = lane & 15, g = lane >> 4;
  int h, b, qb, isctx;
  if (item < 2048) { h = item & 7; qb = (item >> 3) & 31; b = item >> 8; isctx = 0; }
  else { const int it = item - 2048; h = it & 7; qb = (it >> 3) & 1; b = it >> 4; isctx = 1; }
  const int kh = h >> 2;
  const int rowbase = isctx ? TL + b * CTXL : b * SEQ;
  const int ctxbase = TL + b * CTXL;
  const int q0 = qb * 128 + wave * 16;
  const int qrow = rowbase + q0 + fr, qpos = q0 + fr;
  const bf16x8 Qf0 = *(const bf16x8*)(QK + (size_t)qrow * 640 + h * 64 + g * 8);
  const bf16x8 Qf1 = *(const bf16x8*)(QK + (size_t)qrow * 640 + h * 64 + 32 + g * 8);
  const float sink = p.in[27][l * 8 + h];
  float m = sink, lsum = 0.f;
  f32x4 O[4];
#pragma unroll
  for (int dt = 0; dt < 4; ++dt) O[dt] = (f32x4){0.f, 0.f, 0.f, 0.f};
  const int nwin = isctx ? 0 : 9;
  for (int ci = 0; ci < nwin + 8; ++ci) {
    const bool win = ci < nwin;
    const int kstart = win ? (q0 - 128 + 32 * ci) : (ci - nwin) * 32;
    const int kbase = win ? rowbase : ctxbase;
    const int klen = win ? SEQ : CTXL;
    f32x4 st[2];
#pragma unroll
    for (int tt = 0; tt < 2; ++tt) {
      int kp = kstart + 16 * tt + fr; kp = kp < 0 ? 0 : (kp > klen - 1 ? klen - 1 : kp);
      const u16* kr = QK + (size_t)(kbase + kp) * 640 + 512 + kh * 64 + g * 8;
      const bf16x8 K0 = *(const bf16x8*)kr, K1 = *(const bf16x8*)(kr + 32);
      f32x4 z = {0.f, 0.f, 0.f, 0.f};
      z = mfma16(K0, Qf0, z); z = mfma16(K1, Qf1, z); st[tt] = z;
    }
    float mx = -3.0e38f;
#pragma unroll
    for (int tt = 0; tt < 2; ++tt)
#pragma unroll
      for (int j = 0; j < 4; ++j) {
        const int kp = kstart + 16 * tt + 4 * g + j;
        int dq = qpos - kp; dq = dq < 0 ? -dq : dq;
        const bool valid = win ? (kp >= 0 && kp < SEQ && dq <= 128) : true;
        const float s = valid ? st[tt][j] : -1e30f;
        st[tt][j] = s; mx = fmaxf(mx, s);
      }
    mx = fmaxf(mx, shx(mx, 16, lane)); mx = fmaxf(mx, shx(mx, 32, lane));
    const float mnew = fmaxf(m, mx);
    const float alpha = __expf(m - mnew); m = mnew;
    float ps = 0.f; float pv[2][4];
#pragma unroll
    for (int tt = 0; tt < 2; ++tt)
#pragma unroll
      for (int j = 0; j < 4; ++j) { const float e = __expf(st[tt][j] - mnew); pv[tt][j] = e; ps += e; }
    lsum = lsum * alpha + ps;
#pragma unroll
    for (int dt = 0; dt < 4; ++dt) { O[dt][0] *= alpha; O[dt][1] *= alpha; O[dt][2] *= alpha; O[dt][3] *= alpha; }
    union { unsigned u[4]; bf16x8 v; } Pf;
    Pf.u[0] = pk_bf16(pv[0][0], pv[0][1]); Pf.u[1] = pk_bf16(pv[0][2], pv[0][3]);
    Pf.u[2] = pk_bf16(pv[1][0], pv[1][1]); Pf.u[3] = pk_bf16(pv[1][2], pv[1][3]);
    int k0p = kstart + 4 * g, k1p = kstart + 16 + 4 * g;
    k0p = k0p < 0 ? 0 : (k0p > klen - 4 ? klen - 4 : k0p);
    k1p = k1p < 0 ? 0 : (k1p > klen - 4 ? klen - 4 : k1p);
#pragma unroll
    for (int dt = 0; dt < 4; ++dt) {
      const u16* vrow = PT + (size_t)(1280 + kh * 64 + 16 * dt + fr) * T + kbase;
      union { uint2 u[2]; bf16x8 v; } Vf;
      Vf.u[0] = *(const uint2*)(vrow + k0p); Vf.u[1] = *(const uint2*)(vrow + k1p);
      O[dt] = mfma16(Vf.v, Pf.v, O[dt]);
    }
  }
  lsum += shx(lsum, 16, lane); lsum += shx(lsum, 32, lane);
  const float inv = 1.f / (lsum + __expf(sink - m));
#pragma unroll
  for (int dt = 0; dt < 4; ++dt) {
    uint2 o; o.x = pk_bf16(O[dt][0] * inv, O[dt][1] * inv); o.y = pk_bf16(O[dt][2] * inv, O[dt][3] * inv);
    *(uint2*)(YC + (size_t)qrow * D + 512 + h * 64 + 16 * dt + 4 * g) = o;
  }
}

DEVI void lru_item(const Params& p, int l, int item, int pass) {
  const u16* PT = (const u16*)(p.ws + OFF_PT); u16* YC = (u16*)(p.ws + OFF_H);
  float2* SUMM = (float2*)(p.ws + OFF_SUMM);
  const int ch = item >> 2, n = item & 3;
  const int isctx = ch >= 256;
  int b, tq; if (!isctx) { b = ch >> 5; tq = ch & 31; } else { b = (ch - 256) >> 1; tq = (ch - 256) & 1; }
  const int Lseq = isctx ? CTXL : SEQ, rowbase = isctx ? TL + b * CTXL : b * SEQ, t0 = tq * 128;
  float* xs = (float*)smem;
  float* gs = xs + 64 * 145;
  float* ul = gs + 64 * 145;
  float* sm = ul + 128 * 64;
  float* hc = sm + 2 * 8 * 64 * 2;
  const int tid = otid(), e = tid & 63, tg = tid >> 6, c = n * 64 + e;
  for (int idx = tid; idx < 64 * 18; idx += NTHREADS) {
    const int chn = idx / 18, ck = idx % 18, t = t0 - 8 + ck * 8;
    const bool ok = (t >= 0 && t < Lseq);
    bf16x8 v = {0, 0, 0, 0, 0, 0, 0, 0};
    if (ok) v = *(const bf16x8*)(PT + (size_t)(n * 64 + chn) * T + rowbase + t);
#pragma unroll
    for (int q = 0; q < 8; ++q) xs[chn * 145 + ck * 8 + q] = bf2f((u16)v[q]);
    if (pass) {
      bf16x8 v2 = {0, 0, 0, 0, 0, 0, 0, 0};
      if (ok) v2 = *(const bf16x8*)(PT + (size_t)(256 + n * 64 + chn) * T + rowbase + t);
#pragma unroll
      for (int q = 0; q < 8; ++q) gs[chn * 145 + ck * 8 + q] = bf2f((u16)v2[q]);
    }
  }
  if (pass && tid < 128) {
    const int d = tid >> 6, cc = n * 64 + (tid & 63);
    const float2* S = SUMM + (size_t)d * 272 * 256 + cc;
    float h = 0.f;
    const int c0i = 256 + b * 2, l0i = b * 32;
    if (d == 0) {
      if (isctx) { for (int j = 0; j < tq; ++j) { const float2 s = S[(size_t)(c0i + j) * 256]; h = s.x * h + s.y; } }
      else {
        { const float2 s = S[(size_t)(c0i + 0) * 256]; h = s.x * h + s.y; }
        { const float2 s = S[(size_t)(c0i + 1) * 256]; h = s.x * h + s.y; }
        for (int q = 0; q < tq; ++q) { const float2 s = S[(size_t)(l0i + q) * 256]; h = s.x * h + s.y; }
      }
    } else {
      if (isctx) { for (int j = 1; j > tq; --j) { const float2 s = S[(size_t)(c0i + j) * 256]; h = s.x * h + s.y; } }
      else {
        { const float2 s = S[(size_t)(c0i + 1) * 256]; h = s.x * h + s.y; }
        { const float2 s = S[(size_t)(c0i + 0) * 256]; h = s.x * h + s.y; }
        for (int q = 31; q > tq; --q) { const float2 s = S[(size_t)(l0i + q) * 256]; h = s.x * h + s.y; }
      }
    }
    hc[tid] = h;
  }
  __syncthreads();
  float uo[16];
  { const float* cw = p.in[11] + (size_t)l * 4 * 256 + c;
    const float w0 = cw[0], w1 = cw[256], w2 = cw[512], w3 = cw[768], cb = p.in[12][l * 256 + c];
    const float* xr = xs + e * 145 + 8 + 16 * tg;
#pragma unroll
    for (int tt = 0; tt < 16; ++tt) { const float u = cb + w0 * xr[tt - 2] + w1 * xr[tt - 1] + w2 * xr[tt] + w3 * xr[tt + 1]; uo[tt] = u; ul[(16 * tg + tt) * 64 + e] = u; } }
  __syncthreads();
  float av[2][16], bv[2][16];
#pragma unroll
  for (int d = 0; d < 2; ++d) {
    const float* WA = p.in[13] + (size_t)(((l * 2 + d) * 4 + n) * 64) * 64 + e;
    const float* WX = p.in[15] + (size_t)(((l * 2 + d) * 4 + n) * 64) * 64 + e;
    float accr[16], acci[16];
    { const float ba = p.in[14][(l * 2 + d) * 256 + c], bx = p.in[16][(l * 2 + d) * 256 + c];
#pragma unroll
      for (int tt = 0; tt < 16; ++tt) { accr[tt] = ba; acci[tt] = bx; } }
    for (int k4 = 0; k4 < 16; ++k4) {
      const float wa0 = WA[(4 * k4 + 0) * 64], wa1 = WA[(4 * k4 + 1) * 64], wa2 = WA[(4 * k4 + 2) * 64], wa3 = WA[(4 * k4 + 3) * 64];
      const float wx0 = WX[(4 * k4 + 0) * 64], wx1 = WX[(4 * k4 + 1) * 64], wx2 = WX[(4 * k4 + 2) * 64], wx3 = WX[(4 * k4 + 3) * 64];
#pragma unroll
      for (int tt = 0; tt < 16; ++tt) {
        const float4 uu = *(const float4*)(ul + (16 * tg + tt) * 64 + 4 * k4);
        accr[tt] += uu.x * wa0 + uu.y * wa1 + uu.z * wa2 + uu.w * wa3;
        acci[tt] += uu.x * wx0 + uu.y * wx1 + uu.z * wx2 + uu.w * wx3;
      }
    }
    const float lam = p.in[17][(l * 2 + d) * 256 + c];
    const float ex = __expf(-lam); const float sp = ex * (1.f - ex * (0.5f - ex * (0.33333334f - 0.25f * ex)));
    float Ap = 1.f, Bp = 0.f;
#pragma unroll
    for (int q = 0; q < 16; ++q) {
      const int tt = d == 0 ? q : 15 - q;
      const float r = sigmoidf_(accr[tt]), ig = sigmoidf_(acci[tt]);
      const float la = -8.f * r * sp;
      const float a = __expf(la);
      const float y2 = 2.f * la;
      const float om = y2 > -0.1f ? -y2 * (1.f + y2 * (0.5f + y2 * (0.16666667f + y2 * (0.041666668f + y2 * 0.008333334f)))) : 1.f - __expf(y2);
      const float bb = sqrtf(om) * (ig * uo[tt]);
      av[d][tt] = a; bv[d][tt] = bb;
      Bp = a * Bp + bb; Ap *= a;
    }
    sm[((d * 8 + tg) * 64 + e) * 2 + 0] = Ap; sm[((d * 8 + tg) * 64 + e) * 2 + 1] = Bp;
  }
  __syncthreads();
  if (!pass) {
    if (tid < 128) {
      const int d = tid >> 6, ee = tid & 63;
      float A = 1.f, Bc = 0.f;
      if (d == 0) { for (int g2 = 0; g2 < 8; ++g2) { const float a = sm[((0 * 8 + g2) * 64 + ee) * 2], bq = sm[((0 * 8 + g2) * 64 + ee) * 2 + 1]; Bc = a * Bc + bq; A *= a; } }
      else { for (int g2 = 7; g2 >= 0; --g2) { const float a = sm[((1 * 8 + g2) * 64 + ee) * 2], bq = sm[((1 * 8 + g2) * 64 + ee) * 2 + 1]; Bc = a * Bc + bq; A *= a; } }
      SUMM[((size_t)d * 272 + ch) * 256 + n * 64 + ee] = make_float2(A, Bc);
    }
  } else {
    float hs[16];
    { float h = hc[e];
      for (int g2 = 0; g2 < tg; ++g2) { const float a = sm[((0 * 8 + g2) * 64 + e) * 2], bq = sm[((0 * 8 + g2) * 64 + e) * 2 + 1]; h = a * h + bq; }
#pragma unroll
      for (int tt = 0; tt < 16; ++tt) { h = av[0][tt] * h + bv[0][tt]; hs[tt] = h; } }
    { float h = hc[64 + e];
      for (int g2 = 7; g2 > tg; --g2) { const float a = sm[((1 * 8 + g2) * 64 + e) * 2], bq = sm[((1 * 8 + g2) * 64 + e) * 2 + 1]; h = a * h + bq; }
#pragma unroll
      for (int tt = 15; tt >= 0; --tt) { h = av[1][tt] * h + bv[1][tt]; hs[tt] += h; } }
    const float* gr = gs + e * 145 + 8 + 16 * tg;
#pragma unroll
    for (int tt = 0; tt < 16; ++tt) {
      const float y = hs[tt] * gelu_tanh(gr[tt]);
      YC[(size_t)(rowbase + t0 + 16 * tg + tt) * D + c] = f2bf(y);
    }
  }
  __syncthreads();
}

DEVI void uprep_phase(const Params& p, int l) {
  const u16* PT = (const u16*)(p.ws + OFF_PT); u16* UT = (u16*)(p.ws + OFF_UT); u16* X0T = (u16*)(p.ws + OFF_X0T);
  constexpr int NCH = T / 8;
  for (int idx = blockIdx.x * NTHREADS + otid(); idx < 256 * NCH; idx += gridDim.x * NTHREADS) {
    const int c = idx / NCH, ck = idx % NCH, row = ck * 8;
    int t, Lseq; if (row < TL) { t = row & 4095; Lseq = SEQ; } else { t = (row - TL) & 255; Lseq = CTXL; }
    float o[3][8];
#pragma unroll
    for (int k = 0; k < 3; ++k) {
      const int col = k * 256 + c;
      const u16* src = PT + (size_t)(512 + col) * T + row;
      const bf16x8 v = *(const bf16x8*)src;
      float x[10];
      x[0] = t > 0 ? bf2f(src[-1]) : 0.f;
      x[9] = (t + 8 < Lseq) ? bf2f(src[8]) : 0.f;
#pragma unroll
      for (int q = 0; q < 8; ++q) x[q + 1] = bf2f((u16)v[q]);
      const float w0 = p.in[18][(l * 3 + 0) * 768 + col], w1 = p.in[18][(l * 3 + 1) * 768 + col], w2 = p.in[18][(l * 3 + 2) * 768 + col], bb = p.in[19][l * 768 + col];
#pragma unroll
      for (int q = 0; q < 8; ++q) o[k][q] = bb + w0 * x[q] + w1 * x[q + 1] + w2 * x[q + 2];
    }
    uint4 uo, xo;
    uo.x = pk_bf16(o[1][0] * o[2][0], o[1][1] * o[2][1]); uo.y = pk_bf16(o[1][2] * o[2][2], o[1][3] * o[2][3]);
    uo.z = pk_bf16(o[1][4] * o[2][4], o[1][5] * o[2][5]); uo.w = pk_bf16(o[1][6] * o[2][6], o[1][7] * o[2][7]);
    xo.x = pk_bf16(o[0][0], o[0][1]); xo.y = pk_bf16(o[0][2], o[0][3]); xo.z = pk_bf16(o[0][4], o[0][5]); xo.w = pk_bf16(o[0][6], o[0][7]);
    *(uint4*)(UT + (size_t)c * T + row) = uo;
    *(uint4*)(X0T + (size_t)c * T + row) = xo;
  }
}

DEVI bf16x8 ld_frag8(const u16* a) { union { uint2 u[2]; bf16x8 v; } f; f.u[0] = *(const uint2*)a; f.u[1] = *(const uint2*)(a + 4); return f.v; }
DEVI void toep_item(const Params& p, int l, int c, int isctx) {
  const int L = isctx ? CTXL : SEQ;
  const u16* KF = isctx ? (const u16*)(p.ws + OFF_KFC) + (size_t)c * 512 : (const u16*)(p.ws + OFF_KF) + (size_t)(l * 256 + c) * 8192;
  u16* R = (u16*)smem; const int CS = 2 * L + 8;
  const int tid = otid(), wave = tid >> 6, lane = tid & 63, fr = lane & 15, g = lane >> 4;
  for (int idx = tid; idx < 4 * CS; idx += NTHREADS) { const int mm = idx / CS, y = idx % CS, x = y - mm; R[idx] = (x >= 0 && x < 2 * L) ? KF[x] : (u16)0; }
  __syncthreads();
  const u16* Uc = (const u16*)(p.ws + OFF_UT) + (size_t)c * T;
  const u16* X0c = (const u16*)(p.ws + OFF_X0T) + (size_t)c * T;
  u16* YC = (u16*)(p.ws + OFF_H);
  const float skip = p.in[26][l * 256 + c];
  const int nT = L / 128;
  const int mcp = fr & 3;
  const u16* Rl = R + mcp * CS + (L + 8 * g - (fr - mcp));
  const size_t urow = isctx ? (size_t)TL + (size_t)(fr & 7) * CTXL : (size_t)(fr & 7) * SEQ;
  for (int wt = wave; wt < nT; wt += 8) {
    const int T0 = wt * 128;
    f32x4 acc[8];
#pragma unroll
    for (int m8 = 0; m8 < 8; ++m8) acc[m8] = (f32x4){0.f, 0.f, 0.f, 0.f};
    bf16x8 F[8];
#pragma unroll
    for (int m8 = 2; m8 < 8; ++m8) F[m8] = ld_frag8(Rl + (0 - T0 - 16 * m8));
    for (int s0 = 0; s0 < L; s0 += 128) {
#pragma unroll
      for (int k = 0; k < 4; ++k) {
        const int s = s0 + 32 * k;
        bf16x8 Bf = {0, 0, 0, 0, 0, 0, 0, 0};
        if (fr < 8) Bf = *(const bf16x8*)(Uc + urow + s + 8 * g);
        F[(8 - 2 * k) & 7] = ld_frag8(Rl + (s - T0));
        F[(9 - 2 * k) & 7] = ld_frag8(Rl + (s - T0 - 16));
#pragma unroll
        for (int m8 = 0; m8 < 8; ++m8) acc[m8] = mfma16(F[(m8 + 8 - 2 * k) & 7], Bf, acc[m8]);
      }
    }
    if (fr < 8) {
#pragma unroll
      for (int m8 = 0; m8 < 8; ++m8) {
        const size_t row = urow + T0 + 16 * m8 + 4 * g;
        const bf16x4 u4 = *(const bf16x4*)(Uc + row), x4 = *(const bf16x4*)(X0c + row);
#pragma unroll
        for (int j = 0; j < 4; ++j) {
          const float y = bf2f((u16)x4[j]) * (acc[m8][j] + skip * bf2f((u16)u4[j]));
          YC[(row + j) * D + 256 + c] = f2bf(y);
        }
      }
    }
  }
  __syncthreads();
}

__global__ void __launch_bounds__(NTHREADS) mega(Params p) {
  cg::grid_group grid = cg::this_grid();
  phase0(p);
  grid.sync();
#pragma unroll 1
  for (int l = 0; l < 2; ++l) {
    const int Mpost = l == 0 ? T : TL;
    norm_phase(p, l, 0, T, l == 0);
    grid.sync();
    { EpiAct e{(u16*)(p.ws + OFF_BIG)};
      gemm_phase((const u16*)(p.ws + OFF_H), (const u16*)(p.ws + OFF_W1T) + (size_t)(l * 2 + 0) * 5632 * 1024, T, 2 * DFF, D, e); }
    grid.sync();
    { float* X = (float*)(p.ws + OFF_X);
      EpiRes e{l == 0 ? p.in[0] : X, l == 0 ? p.in[2] : X + (size_t)TL * D, X, (const float*)(p.ws + OFF_MOD) + (size_t)l * 9 * 9216, 2, 0.5f};
      gemm_phase((const u16*)(p.ws + OFF_BIG), (const u16*)(p.ws + OFF_W2T) + (size_t)(l * 2 + 0) * 1024 * 2816, T, D, DFF, e); }
    grid.sync();
    norm_phase(p, l, 1, T, false);
    grid.sync();
    { EpiProj e{(u16*)(p.ws + OFF_PT), (u16*)(p.ws + OFF_QK), (const float*)(p.ws + OFF_ROPE), (const float*)(p.ws + OFF_ROPE) + 4096 * 32};
      gemm_phase((const u16*)(p.ws + OFF_H), (const u16*)(p.ws + OFF_WINT) + (size_t)l * 2048 * 1024, T, DIN, D, e); }
    grid.sync();
    { const int n_att = l == 0 ? 2048 + 128 : 2048, n_lru = 1088;
      for (int it = blockIdx.x; it < n_att + n_lru; it += gridDim.x) { if (it < n_att) attn_item(p, l, it); else lru_item(p, l, it - n_att, 0); }
      uprep_phase(p, l); }
    grid.sync();
    { const int n_t1 = 256, n_t2 = l == 0 ? 256 : 0, n_lru = l == 0 ? 1088 : 1024;
      for (int it = blockIdx.x; it < n_t1 + n_t2 + n_lru; it += gridDim.x) {
        if (it < n_t1) toep_item(p, l, it, 0);
        else if (it < n_t1 + n_t2) toep_item(p, l, it - n_t1, 1);
        else lru_item(p, l, it - n_t1 - n_t2, 1);
      } }
    grid.sync();
    { float* X = (float*)(p.ws + OFF_X);
      EpiRes e{X, X + (size_t)TL * D, X, (const float*)(p.ws + OFF_MOD) + (size_t)l * 9 * 9216, 5, 1.0f};
      gemm_phase((const u16*)(p.ws + OFF_H), (const u16*)(p.ws + OFF_WOT) + (size_t)l * 1024 * 1024, Mpost, D, D, e); }
    grid.sync();
    norm_phase(p, l, 2, Mpost, false);
    grid.sync();
    { EpiAct e{(u16*)(p.ws + OFF_BIG)};
      gemm_phase((const u16*)(p.ws + OFF_H), (const u16*)(p.ws + OFF_W1T) + (size_t)(l * 2 + 1) * 5632 * 1024, Mpost, 2 * DFF, D, e); }
    grid.sync();
    { float* X = (float*)(p.ws + OFF_X);
      EpiRes e{X, X + (size_t)TL * D, X, (const float*)(p.ws + OFF_MOD) + (size_t)l * 9 * 9216, 8, 0.5f};
      gemm_phase((const u16*)(p.ws + OFF_BIG), (const u16*)(p.ws + OFF_W2T) + (size_t)(l * 2 + 1) * 1024 * 2816, Mpost, D, DFF, e); }
    grid.sync();
  }
  final_norm_phase(p);
}

extern "C" void kernel_launch(void* const* d_in, const int* in_sizes, int n_in, void* d_out, int out_size, void* d_ws, size_t ws_size, hipStream_t stream) {
  static int grid_blocks = 0;
  if (!grid_blocks) {
    if (ws_size < WS_END || n_in != 29) { fprintf(stderr, "kernel_launch: workspace %zu < %zu or n_in %d != 29\n", ws_size, (size_t)WS_END, n_in); grid_blocks = -1; return; }
    int dev = 0, cus = 0, per_cu = 0;
    hipGetDevice(&dev);
    hipDeviceGetAttribute(&cus, hipDeviceAttributeMultiprocessorCount, dev);
    if (hipFuncSetAttribute((const void*)mega, hipFuncAttributeMaxDynamicSharedMemorySize, LDS_BYTES) != hipSuccess) { fprintf(stderr, "hipFuncSetAttribute failed\n"); }
    hipOccupancyMaxActiveBlocksPerMultiprocessor(&per_cu, (const void*)mega, NTHREADS, LDS_BYTES);
    if (per_cu < 1) { fprintf(stderr, "occupancy query returned %d\n", per_cu); per_cu = 1; }
    if (per_cu > 1) per_cu = 1;
    grid_blocks = cus * per_cu;
    (void)hipGetLastError();
  }
  if (grid_blocks < 0) return;
  Params p{};
  for (int i = 0; i < 29; ++i) p.in[i] = (const float*)d_in[i];
  p.out = (float*)d_out; p.ws = (unsigned char*)d_ws;
  void* args[] = {&p};
  hipError_t e = hipLaunchCooperativeKernel((void*)mega, dim3(grid_blocks), dim3(NTHREADS), args, LDS_BYTES, stream);
  if (e != hipSuccess) fprintf(stderr, "cooperative launch failed: %s (grid %d)\n", hipGetErrorString(e), grid_blocks);
}
```

```cpp
#include <hip/hip_runtime.h>
#include <hip/hip_cooperative_groups.h>
#include <cstdio>
namespace cg = cooperative_groups;

using bf16x8 = __attribute__((ext_vector_type(8))) short;
using bf16x4 = __attribute__((ext_vector_type(4))) short;
using f32x4  = __attribute__((ext_vector_type(4))) float;
typedef unsigned short u16;
#define DEVI __device__ __forceinline__

constexpr int D = 1024, NB = 8, SEQ = 4096, CTXL = 256, TL = NB * SEQ, TC = NB * CTXL, T = TL + TC;
constexpr int DFF = 2816, DIN = 2048;
constexpr int NTHREADS = 512;
constexpr int LDS_BYTES = 163840;

constexpr size_t OFF_X    = 0;
constexpr size_t OFF_H    = OFF_X + (size_t)T * D * 4;
constexpr size_t OFF_BIG  = OFF_H + (size_t)T * D * 2;
constexpr size_t OFF_PT   = OFF_BIG;
constexpr size_t OFF_QK   = OFF_PT + (size_t)1408 * T * 2;
constexpr size_t OFF_UT   = OFF_QK + (size_t)T * 640 * 2;
constexpr size_t OFF_X0T  = OFF_UT + (size_t)256 * T * 2;
constexpr size_t OFF_SUMM = OFF_X0T + (size_t)256 * T * 2;
constexpr size_t OFF_W1T  = OFF_BIG + (size_t)T * DFF * 2;
constexpr size_t OFF_W2T  = OFF_W1T + (size_t)4 * 5632 * 1024 * 2;
constexpr size_t OFF_WINT = OFF_W2T + (size_t)4 * 1024 * 2816 * 2;
constexpr size_t OFF_WOT  = OFF_WINT + (size_t)2 * 2048 * 1024 * 2;
constexpr size_t OFF_MOD  = OFF_WOT + (size_t)2 * 1024 * 1024 * 2;
constexpr size_t OFF_KF   = OFF_MOD + (size_t)2 * 9 * 9216 * 4;
constexpr size_t OFF_KFC  = OFF_KF + (size_t)2 * 256 * 8192 * 2;
constexpr size_t OFF_ROPE = OFF_KFC + (size_t)256 * 512 * 2;
constexpr size_t WS_END   = OFF_ROPE + (size_t)2 * 4096 * 32 * 4;
static_assert(OFF_SUMM + 2 * 272 * 256 * 8 <= OFF_W1T, "mixer buffers overflow ACT region");

struct Params {
  const float* in[29];
  float* out;
  unsigned char* ws;
};

extern __shared__ __attribute__((aligned(16))) unsigned char smem[];

DEVI unsigned pk_bf16(float lo, float hi) { unsigned r; asm volatile("v_cvt_pk_bf16_f32 %0, %1, %2" : "=v"(r) : "v"(lo), "v"(hi)); return r; }
DEVI u16 f2bf(float x) { return (u16)(pk_bf16(x, 0.f) & 0xffffu); }
DEVI float bf2f(u16 h) { return __uint_as_float(((unsigned)h) << 16); }
DEVI float sigmoidf_(float x) { return 1.f / (1.f + __expf(-x)); }
DEVI float gelu_tanh(float x) { float z = 0.7978845608028654f * (x + 0.044715f * x * x * x); float th = 1.f - 2.f / (1.f + __expf(2.f * z)); return 0.5f * x * (1.f + th); }
template <class Tp> DEVI const Tp* opaque(const Tp* q) { asm volatile("" : "+s"(q)); return q; }
DEVI int otid() { int t = threadIdx.x; asm volatile("" : "+v"(t)); return t; }
DEVI float shx(float v, int o, int lane) { return __int_as_float(__builtin_amdgcn_ds_bpermute((lane ^ o) << 2, __float_as_int(v))); }
DEVI f32x4 mfma16(bf16x8 a, bf16x8 b, f32x4 c) { return __builtin_amdgcn_mfma_f32_16x16x32_bf16(a, b, c, 0, 0, 0); }

constexpr int BM = 256, BK = 64, HALF = 128, HT = HALF * BK;
DEVI int lds_byte(int r, int c) { int st = (r >> 4) * 2 + (c >> 5), rr = r & 15, cc = c & 31, ob = rr * 64 + cc * 2; return st * 1024 + (ob ^ (((ob >> 9) & 1) << 5)); }
DEVI void stage_rc(int b, int& R, int& C) { int st = b / 1024, sb = b % 1024, swz = sb ^ (((sb >> 9) & 1) << 5); R = (st >> 1) * 16 + swz / 64; C = (st & 1) * 32 + (swz % 64) / 2; }

template <class Epi>
DEVI void gemm_tile(const u16* __restrict__ A, const u16* __restrict__ Bt, const int K, const int brow, const int bcol, const Epi& epi) {
  u16* shm = (u16*)smem;
#define SA(b, h) (shm + ((b) * 2 + (h)) * HT)
#define SB(b, h) (shm + (4 + (b) * 2 + (h)) * HT)
#define STAGE(P, BASE, br, kt) do { const char* _ub = (const char*)(BASE + (long)(br) * K + (long)(kt) * BK); \
      __builtin_amdgcn_global_load_lds((const unsigned*)(_ub + soff0), (unsigned*)((char*)(P) + tid * 16), 16, 0, 0); \
      __builtin_amdgcn_global_load_lds((const unsigned*)(_ub + soff1), (unsigned*)((char*)(P) + tid * 16 + 8192), 16, 0, 0); } while (0)
#define LDA(dst, b, h) for (int m = 0; m < 4; ++m) for (int k = 0; k < 2; ++k) \
    dst[m][k] = *reinterpret_cast<const bf16x8*>((char*)SA(b, h) + lds_byte(wr * 64 + m * 16 + fr, k * 32 + fq * 8))
#define LDB(dst, b, h) for (int n = 0; n < 2; ++n) for (int k = 0; k < 2; ++k) \
    dst[n][k] = *reinterpret_cast<const bf16x8*>((char*)SB(b, h) + lds_byte(wc * 32 + n * 16 + fr, k * 32 + fq * 8))
#define MMA(ai, bj, At_, Bt_) do { __builtin_amdgcn_s_setprio(1); \
    for (int m = 0; m < 4; ++m) for (int n = 0; n < 2; ++n) for (int k = 0; k < 2; ++k) \
      acc[ai][bj][m][n] = __builtin_amdgcn_mfma_f32_16x16x32_bf16(At_[m][k], Bt_[n][k], acc[ai][bj][m][n], 0, 0, 0); \
    __builtin_amdgcn_s_setprio(0); } while (0)
#define WAIT_V(n) asm volatile("s_waitcnt vmcnt(" #n ")" ::: "memory")
#define WAIT_L(n) asm volatile("s_waitcnt lgkmcnt(" #n ")" ::: "memory")
#define BAR __builtin_amdgcn_s_barrier()
#define SCHED __builtin_amdgcn_sched_barrier(0)
  const int tid = otid();
  const int wid = tid >> 6, lane = tid & 63, wr = wid >> 2, wc = wid & 3, fr = lane & 15, fq = lane >> 4;
  unsigned soff0, soff1;
  { int r_, c_; stage_rc(tid * 16, r_, c_); soff0 = (unsigned)(r_ * K + c_) * 2u; stage_rc(tid * 16 + 8192, r_, c_); soff1 = (unsigned)(r_ * K + c_) * 2u; }
  f32x4 acc[2][2][4][2] = {};
  bf16x8 At[4][2], B0[2][2], B1[2][2];
  const int nt = K / BK;
  STAGE(SB(0, 0), Bt, bcol, 0); STAGE(SA(0, 0), A, brow, 0);
  STAGE(SB(0, 1), Bt, bcol + HALF, 0); STAGE(SA(0, 1), A, brow + HALF, 0);
  if (wr == 1) BAR;
  WAIT_V(4); BAR;
  STAGE(SB(1, 0), Bt, bcol, 1); STAGE(SA(1, 0), A, brow, 1); STAGE(SB(1, 1), Bt, bcol + HALF, 1);
  WAIT_V(6); BAR;
  for (int t = 0; t < nt - 2; t += 2) {
    LDB(B0, 0, 0); SCHED; LDA(At, 0, 0); STAGE(SA(1, 1), A, brow + HALF, t + 1);
    WAIT_L(8); BAR; WAIT_L(0); MMA(0, 0, At, B0); BAR; SCHED;
    LDB(B1, 0, 1); STAGE(SB(0, 0), Bt, bcol, t + 2);
    BAR; WAIT_L(0); MMA(0, 1, At, B1); BAR;
    LDA(At, 0, 1); STAGE(SA(0, 0), A, brow, t + 2);
    BAR; WAIT_L(0); MMA(1, 0, At, B0); BAR; SCHED;
    STAGE(SB(0, 1), Bt, bcol + HALF, t + 2);
    WAIT_V(6); BAR; MMA(1, 1, At, B1); BAR;
    LDB(B0, 1, 0); SCHED; LDA(At, 1, 0); STAGE(SA(0, 1), A, brow + HALF, t + 2);
    WAIT_L(8); BAR; WAIT_L(0); MMA(0, 0, At, B0); BAR; SCHED;
    LDB(B1, 1, 1); STAGE(SB(1, 0), Bt, bcol, t + 3);
    BAR; WAIT_L(0); MMA(0, 1, At, B1); BAR;
    LDA(At, 1, 1); STAGE(SA(1, 0), A, brow, t + 3);
    BAR; WAIT_L(0); MMA(1, 0, At, B0); BAR; SCHED;
    STAGE(SB(1, 1), Bt, bcol + HALF, t + 3);
    WAIT_V(6); BAR; MMA(1, 1, At, B1); BAR;
  }
  { LDB(B0, 0, 0); LDA(At, 0, 0); STAGE(SA(1, 1), A, brow + HALF, nt - 1);
    BAR; WAIT_L(0); MMA(0, 0, At, B0); BAR;
    LDB(B1, 0, 1); BAR; WAIT_L(0); MMA(0, 1, At, B1); BAR;
    LDA(At, 0, 1); WAIT_V(4); BAR; WAIT_L(0); MMA(1, 0, At, B0); MMA(1, 1, At, B1); BAR; }
  { LDB(B0, 1, 0); LDA(At, 1, 0); WAIT_V(2); BAR; WAIT_L(0); MMA(0, 0, At, B0); BAR;
    LDB(B1, 1, 1); WAIT_V(0); BAR; WAIT_L(0); MMA(0, 1, At, B1); BAR;
    LDA(At, 1, 1); BAR; WAIT_L(0); MMA(1, 0, At, B0); MMA(1, 1, At, B1); BAR; }
  if (wr == 0) BAR;
#pragma unroll
  for (int ai = 0; ai < 2; ++ai)
#pragma unroll
    for (int bj = 0; bj < 2; ++bj)
#pragma unroll
      for (int m = 0; m < 4; ++m) {
        const int row0 = brow + ai * HALF + wr * 64 + m * 16 + fq * 4;
        const int colb = bcol + bj * HALF + wc * 32;
        epi(row0, colb, fr, acc[ai][bj][m][0], acc[ai][bj][m][1]);
      }
  __syncthreads();
#undef SA
#undef SB
#undef STAGE
#undef LDA
#undef LDB
#undef MMA
}

DEVI bool tile_next(int i, int nM, int nN, int& pm, int& pn) {
  const int nwg = nM * nN; const long Lx = (long)i * gridDim.x + blockIdx.x; if (Lx >= nwg) return false;
  int wgid = (int)Lx; { const int q = nwg / 8, r = nwg % 8, xcd = wgid % 8, off = wgid / 8; wgid = (xcd < r ? xcd * (q + 1) : r * (q + 1) + (xcd - r) * q) + off; }
  const int nig = 8 * nN, gid = wgid / nig, fm = gid * 8, gsz = (nM - fm) < 8 ? (nM - fm) : 8;
  pm = fm + ((wgid % nig) % gsz); pn = (wgid % nig) / gsz; return true;
}
template <class Epi>
DEVI void gemm_phase(const u16* A, const u16* Bt, int M, int N, int K, const Epi& epi) {
  const int nM = M / BM, nN = N / BM;
  for (int i = 0;; ++i) { int pm, pn; if (!tile_next(i, nM, nN, pm, pn)) break; gemm_tile(A, Bt, K, pm * BM, pn * BM, epi); }
}

struct EpiAct {
  u16* act;
  DEVI void operator()(int row0, int colb, int fr, const f32x4& a0, const f32x4& a1) const {
    const int oc = (colb >> 5) * 16 + fr;
#pragma unroll
    for (int j = 0; j < 4; ++j) { float a = a0[j]; float v = a * sigmoidf_(a) * a1[j]; act[(size_t)(row0 + j) * DFF + oc] = f2bf(v); }
  }
};
struct EpiRes {
  const float* xin_lat; const float* xin_ctx;
  float* xout; const float* modl;
  int gi; float coef;
  DEVI void operator()(int row0, int colb, int fr, const f32x4& a0, const f32x4& a1) const {
    const int r = row0 < TL ? (row0 >> 12) : 8;
    const float* gate = modl + (size_t)(r * 9 + gi) * D;
#pragma unroll
    for (int n = 0; n < 2; ++n) {
      const int col = colb + n * 16 + fr; const float gv = coef * gate[col];
#pragma unroll
      for (int j = 0; j < 4; ++j) {
        const int row = row0 + j;
        const float* src = row < TL ? xin_lat + (size_t)row * D : xin_ctx + (size_t)(row - TL) * D;
        xout[(size_t)row * D + col] = src[col] + gv * (n ? a1[j] : a0[j]);
      }
    }
  }
};
struct EpiProj {
  u16* pt; u16* qk; const float* cost; const float* sint;
  DEVI void operator()(int row0, int colb, int fr, const f32x4& a0, const f32x4& a1) const {
    if (colb < 1280 || colb >= 1920) {
#pragma unroll
      for (int n = 0; n < 2; ++n) {
        const int pc = colb + n * 16 + fr; const int ptc = pc < 1280 ? pc : pc - 640;
        const f32x4& a = n ? a1 : a0;
        uint2 o; o.x = pk_bf16(a[0], a[1]); o.y = pk_bf16(a[2], a[3]);
        *(uint2*)(pt + (size_t)ptc * T + row0) = o;
      }
    } else {
      const int off = colb - 1280, head = off >> 6, grp = (off >> 5) & 1, pidx = 16 * grp + fr;
      const int d1 = head * 64 + pidx, d2 = d1 + 32;
      const float qs = head < 8 ? 0.125f : 1.f;
#pragma unroll
      for (int j = 0; j < 4; ++j) {
        const int row = row0 + j; float c = 1.f, s = 0.f;
        if (row < TL) { const int t = row & 4095; c = cost[t * 32 + pidx]; s = sint[t * 32 + pidx]; }
        const float o1 = (a0[j] * c - a1[j] * s) * qs, o2 = (a0[j] * s + a1[j] * c) * qs;
        qk[(size_t)row * 640 + d1] = f2bf(o1); qk[(size_t)row * 640 + d2] = f2bf(o2);
      }
    }
  }
};

DEVI int srccol(int mode, int pn) {
  if (mode == 1) { const int g = pn >> 5, hh = (pn >> 4) & 1, i = pn & 15; return hh * DFF + g * 16 + i; }
  if (mode == 2) { if (pn < 1280 || pn >= 1920) return pn; const int off = pn - 1280, head = off >> 6, w = off & 63, grp = w >> 5, hh = (w >> 4) & 1, i = w & 15; return 1280 + head * 64 + 16 * grp + i + 32 * hh; }
  return pn;
}
DEVI void transpose_item(const float* __restrict__ W, int K, int N, u16* __restrict__ WT, int mode, int item) {
  float* tile = (float*)smem;
  const int tid = otid(), nblk = N / 64, kb = item / nblk, nb = item % nblk, k0 = kb * 64, n0 = nb * 64;
  { const int nn = tid & 63, kr = tid >> 6, src = srccol(mode, n0 + nn);
#pragma unroll
    for (int r = 0; r < 8; ++r) { const int kk = kr + 8 * r; tile[kk * 65 + nn] = W[(size_t)(k0 + kk) * N + src]; } }
  __syncthreads();
  { const int rown = tid >> 3, kc = tid & 7; const float* s = tile + (kc * 8) * 65 + rown;
    uint4 o; o.x = pk_bf16(s[0], s[65]); o.y = pk_bf16(s[130], s[195]); o.z = pk_bf16(s[260], s[325]); o.w = pk_bf16(s[390], s[455]);
    *(uint4*)(WT + (size_t)(n0 + rown) * K + k0 + kc * 8) = o; }
  __syncthreads();
}
DEVI void mod_item(const Params& p, int item) {
  float* sv = (float*)smem;
  float* red = sv + 9 * 1024;
  const int tid = otid(), l = item / 72, n0 = (item % 72) * 128;
  for (int i = tid; i < 9 * 1024; i += NTHREADS) { const int r = i >> 10, k = i & 1023; const float cv = r < 8 ? p.in[1][r * 1024 + k] : p.in[3][k]; sv[i] = cv * sigmoidf_(cv); }
  __syncthreads();
  const int cc = tid & 127, kq = tid >> 7;
  const float* w = p.in[4] + (size_t)l * 1024 * 9216 + n0 + cc;
  float acc[9];
#pragma unroll
  for (int r = 0; r < 9; ++r) acc[r] = 0.f;
#pragma unroll 2
  for (int k4 = 0; k4 < 64; ++k4) {
    const int k = kq * 256 + k4 * 4;
    const float w0 = w[(size_t)k * 9216], w1 = w[(size_t)(k + 1) * 9216], w2 = w[(size_t)(k + 2) * 9216], w3 = w[(size_t)(k + 3) * 9216];
#pragma unroll
    for (int r = 0; r < 9; ++r) { const float4 s4 = *(const float4*)(sv + r * 1024 + k); acc[r] += s4.x * w0 + s4.y * w1 + s4.z * w2 + s4.w * w3; }
  }
#pragma unroll
  for (int r = 0; r < 9; ++r) red[(kq * 9 + r) * 128 + cc] = acc[r];
  __syncthreads();
  float* MOD = (float*)(p.ws + OFF_MOD);
  for (int i = tid; i < 9 * 128; i += NTHREADS) {
    const int r = i >> 7, c2 = i & 127;
    const float v = red[(0 * 9 + r) * 128 + c2] + red[(1 * 9 + r) * 128 + c2] + red[(2 * 9 + r) * 128 + c2] + red[(3 * 9 + r) * 128 + c2] + p.in[5][l * 9216 + n0 + c2];
    MOD[(size_t)(l * 9 + r) * 9216 + n0 + c2] = v;
  }
  __syncthreads();
}
DEVI void filter_item(const Params& p, int l, int L, u16* __restrict__ KF, int posblk) {
  float* zs = (float*)smem;
  float* hb = zs + 8 * 36;
  const int tid = otid(), w = tid >> 6, j = tid & 63, t = posblk * 8 + w;
  const float* fw0 = opaque(p.in[20] + l * 33 * 64); const float* fb0 = opaque(p.in[21] + l * 64);
  const float* fwin = opaque(p.in[22] + l * 2 * 64 * 64); const float* fbin = opaque(p.in[23] + l * 2 * 64);
  const float* freq = opaque(p.in[24] + l * 64); const float* fwl = opaque(p.in[25] + l * 64 * 512);
  const float tn = (float)t / (float)(L - 1);
  if (j < 33) {
    float z;
    if (j == 0) z = tn;
    else { const int bi = (j - 1) & 15; const float f = 1e-4f + (float)bi * ((15.f - 1e-4f) / 15.f); const float wv = 6.283185307179586f * (float)t / (float)L; const float a = f * wv; z = (j <= 16) ? __cosf(a) : -__sinf(a); }
    zs[w * 36 + j] = z;
  }
  __syncthreads();
  const float fr = freq[j];
  { float acc = fb0[j];
#pragma unroll 3
    for (int i = 0; i < 33; ++i) acc += zs[w * 36 + i] * fw0[i * 64 + j];
    hb[(0 * 8 + w) * 64 + j] = __sinf(fr * acc); }
  __syncthreads();
#pragma unroll
  for (int q = 0; q < 2; ++q) {
    float acc = fbin[q * 64 + j];
#pragma unroll 8
    for (int i = 0; i < 64; ++i) acc += hb[((q & 1) * 8 + w) * 64 + i] * fwin[q * 4096 + i * 64 + j];
    hb[(((q + 1) & 1) * 8 + w) * 64 + j] = __sinf(fr * acc);
    __syncthreads();
  }
  const float mind = -3.0701134573253945f, maxd = -15.350567286626973f;
#pragma unroll 1
  for (int qq = 0; qq < 8; ++qq) {
    const int n = j + 64 * qq;
    float acc = 0.f;
#pragma unroll 8
    for (int i = 0; i < 64; ++i) acc += hb[(0 * 8 + w) * 64 + i] * fwl[i * 512 + n];
    const int c = n & 255; const float delta = fabsf(mind + (float)c * ((maxd - mind) / 255.f));
    const float val = acc * __expf(-tn * delta);
    if (n < 256) KF[(size_t)c * 2 * L + (L - t)] = f2bf(val);
    else if (t >= 1) KF[(size_t)c * 2 * L + (L + t)] = f2bf(val);
  }
  if (t == 0) {
#pragma unroll
    for (int qq = 0; qq < 4; ++qq) KF[(size_t)(j + 64 * qq) * 2 * L] = 0;
  }
  __syncthreads();
}
DEVI void phase0(const Params& p) {
  const int N_MOD_IT = 144, N_FIL = 512 + 512 + 32;
  constexpr int I_W1 = 16 * 88, I_W2 = 44 * 16, I_WIN = 16 * 32, I_WO = 16 * 16;
  const int N_TR = 4 * I_W1 + 4 * I_W2 + 2 * I_WIN + 2 * I_WO;
  const int NIT = N_MOD_IT + N_FIL + N_TR;
  for (int it = blockIdx.x; it < NIT; it += gridDim.x) {
    asm volatile("" ::: "memory");
    int r = it;
    if (r < N_MOD_IT) { mod_item(p, r); continue; } r -= N_MOD_IT;
    if (r < N_FIL) {
      if (r < 512) filter_item(p, 0, 4096, (u16*)(p.ws + OFF_KF), r);
      else if (r < 1024) filter_item(p, 1, 4096, (u16*)(p.ws + OFF_KF) + (size_t)256 * 8192, r - 512);
      else filter_item(p, 0, 256, (u16*)(p.ws + OFF_KFC), r - 1024);
      continue;
    }
    r -= N_FIL;
    if (r < 4 * I_W1) { const int mi = r / I_W1; transpose_item(p.in[7] + (size_t)mi * 1024 * 5632, 1024, 5632, (u16*)(p.ws + OFF_W1T) + (size_t)mi * 5632 * 1024, 1, r % I_W1); continue; } r -= 4 * I_W1;
    if (r < 4 * I_W2) { const int mi = r / I_W2; transpose_item(p.in[8] + (size_t)mi * 2816 * 1024, 2816, 1024, (u16*)(p.ws + OFF_W2T) + (size_t)mi * 1024 * 2816, 0, r % I_W2); continue; } r -= 4 * I_W2;
    if (r < 2 * I_WIN) { const int mi = r / I_WIN; transpose_item(p.in[9] + (size_t)mi * 1024 * 2048, 1024, 2048, (u16*)(p.ws + OFF_WINT) + (size_t)mi * 2048 * 1024, 2, r % I_WIN); continue; } r -= 2 * I_WIN;
    { const int mi = r / I_WO; transpose_item(p.in[10] + (size_t)mi * 1024 * 1024, 1024, 1024, (u16*)(p.ws + OFF_WOT) + (size_t)mi * 1024 * 1024, 0, r % I_WO); }
  }
  float* cost = (float*)(p.ws + OFF_ROPE); float* sint = cost + 4096 * 32;
  for (int idx = blockIdx.x * NTHREADS + otid(); idx < 4096 * 32; idx += gridDim.x * NTHREADS) {
    const int t = idx >> 5, pp = idx & 31;
    const float inv = exp2f(-(float)(pp & 15) * (13.287712379549449f / 16.f));
    const float pos = pp < 16 ? (float)(t >> 6) : (float)(t & 63);
    const float ang = pos * inv;
    cost[idx] = __cosf(ang); sint[idx] = __sinf(ang);
  }
}

DEVI float wave_sum(float v, int lane) {
#pragma unroll
  for (int o = 1; o < 64; o <<= 1) v += shx(v, o, lane);
  return v;
}
DEVI void norm_phase(const Params& p, int l, int which, int Mrows, bool from_input) {
  const int tid = otid();
  const int lane = tid & 63, gw = blockIdx.x * 8 + (tid >> 6), NW = gridDim.x * 8;
  const float* X = (const float*)(p.ws + OFF_X); u16* H = (u16*)(p.ws + OFF_H);
  const float* MOD = (const float*)(p.ws + OFF_MOD);
  const f32x4* g4 = (const f32x4*)(p.in[6] + (size_t)(l * 3 + which) * D) + lane;
  for (int row = gw; row < Mrows; row += NW) {
    const float* xr = from_input ? (row < TL ? p.in[0] + (size_t)row * D : p.in[2] + (size_t)(row - TL) * D) : X + (size_t)row * D;
    const int r = row < TL ? (row >> 12) : 8;
    const f32x4* sh4 = (const f32x4*)(MOD + (size_t)((l * 9 + r) * 9 + which * 3) * D) + lane;
    const f32x4* sc4 = sh4 + D / 4;
    const f32x4* x4 = (const f32x4*)xr + lane;
    f32x4 v[4]; float ss = 0.f;
#pragma unroll
    for (int j = 0; j < 4; ++j) { v[j] = x4[64 * j]; ss += (v[j][0] * v[j][0] + v[j][1] * v[j][1]) + (v[j][2] * v[j][2] + v[j][3] * v[j][3]); }
    const float rinv = rsqrtf(wave_sum(ss, lane) * (1.f / D) + 1e-6f);
    uint2* o8 = (uint2*)(H + (size_t)row * D) + lane;
#pragma unroll
    for (int j = 0; j < 4; ++j) {
      const f32x4 g = g4[64 * j], sh = sh4[64 * j], sc = sc4[64 * j];
      f32x4 y;
#pragma unroll
      for (int q = 0; q < 4; ++q) y[q] = v[j][q] * rinv * g[q] * (1.f + sc[q]) + sh[q];
      uint2 o; o.x = pk_bf16(y[0], y[1]); o.y = pk_bf16(y[2], y[3]); o8[64 * j] = o;
    }
  }
}
DEVI void final_norm_phase(const Params& p) {
  const int tid = otid();
  const int lane = tid & 63, gw = blockIdx.x * 8 + (tid >> 6), NW = gridDim.x * 8;
  const float* X = (const float*)(p.ws + OFF_X);
  const f32x4* g4 = (const f32x4*)p.in[28] + lane;
  for (int row = gw; row < TL; row += NW) {
    const f32x4* x4 = (const f32x4*)(X + (size_t)row * D) + lane;
    f32x4 v[4]; float ss = 0.f;
#pragma unroll
    for (int j = 0; j < 4; ++j) { v[j] = x4[64 * j]; ss += (v[j][0] * v[j][0] + v[j][1] * v[j][1]) + (v[j][2] * v[j][2] + v[j][3] * v[j][3]); }
    const float rinv = rsqrtf(wave_sum(ss, lane) * (1.f / D) + 1e-6f);
    f32x4* o4 = (f32x4*)(p.out + (size_t)row * D) + lane;
#pragma unroll
    for (int j = 0; j < 4; ++j) { const f32x4 g = g4[64 * j]; f32x4 y; for (int q = 0; q < 4; ++q) y[q] = v[j][q] * rinv * g[q]; o4[64 * j] = y; }
  }
}

constexpr int AT_KSTR = 72, AT_VSTR = 408;
DEVI void attn_stage(const u16* __restrict__ QK, const u16* __restrict__ PT, u16* Ks, u16* Vs, int tid, int kvh, int kbase, int kstart, int nkeys, int klen) {
  for (int idx = tid; idx < nkeys * 8; idx += NTHREADS) {
    const int kl = idx >> 3, cp = idx & 7, kp = kstart + kl;
    uint4 v = {0u, 0u, 0u, 0u};
    if (kp >= 0 && kp < klen) v = *(const uint4*)(QK + (size_t)(kbase + kp) * 640 + 512 + kvh * 64 + cp * 8);
    *(uint4*)(Ks + kl * AT_KSTR + cp * 8) = v;
  }
  const int nck = nkeys >> 3;
  for (int idx = tid; idx < 64 * nck; idx += NTHREADS) {
    const int dim = idx / nck, ck = idx % nck, kp = kstart + ck * 8;
    uint4 v = {0u, 0u, 0u, 0u};
    if (kp >= 0 && kp < klen) v = *(const uint4*)(PT + (size_t)(1280 + kvh * 64 + dim) * T + kbase + kp);
    *(uint4*)(Vs + dim * AT_VSTR + ck * 8) = v;
  }
}
DEVI void attn_item(const Params& p, int l, int item) {
  const u16* QK = (const u16*)(p.ws + OFF_QK); const u16* PT = (const u16*)(p.ws + OFF_PT); u16* YC = (u16*)(p.ws + OFF_H);
  u16* Ks = (u16*)smem; u16* Vs = Ks + 400 * AT_KSTR;
  const int tid = otid();
  const int wave = tid >> 6, lane = tid & 63, fr = lane & 15, g = lane >> 4;
  int kvh, b, qb, isctx;
  if (item < 512) { kvh = item & 1; qb = (item >> 1) & 31; b = item >> 6; isctx = 0; }
  else { const int it = item - 512; kvh = it & 1; qb = (it >> 1) & 1; b = it >> 2; isctx = 1; }
  const int rowbase = isctx ? TL + b * CTXL : b * SEQ;
  const int ctxbase = TL + b * CTXL;
  const int q0b = qb * 128, q0 = q0b + wave * 16;
  const int qrow = rowbase + q0 + fr, qpos = q0 + fr;
  bf16x8 Qf[4][2];
  float m[4], lsum[4];
  f32x4 O[4][4];
#pragma unroll
  for (int hh = 0; hh < 4; ++hh) {
    const u16* qp = QK + (size_t)qrow * 640 + (kvh * 4 + hh) * 64 + g * 8;
    Qf[hh][0] = *(const bf16x8*)qp; Qf[hh][1] = *(const bf16x8*)(qp + 32);
    m[hh] = p.in[27][l * 8 + kvh * 4 + hh]; lsum[hh] = 0.f;
#pragma unroll
    for (int dt = 0; dt < 4; ++dt) O[hh][dt] = (f32x4){0.f, 0.f, 0.f, 0.f};
  }
  auto chunk = [&](const int lk, const int kp0, const bool win) {
    bf16x8 Kf[2][2];
#pragma unroll
    for (int tt = 0; tt < 2; ++tt) {
      const u16* kr = Ks + (lk + 16 * tt + fr) * AT_KSTR + g * 8;
      Kf[tt][0] = *(const bf16x8*)kr; Kf[tt][1] = *(const bf16x8*)(kr + 32);
    }
    bf16x8 Vf[4];
#pragma unroll
    for (int dt = 0; dt < 4; ++dt) {
      const u16* vr = Vs + (16 * dt + fr) * AT_VSTR + lk + 4 * g;
      union { uint2 u[2]; bf16x8 v; } t; t.u[0] = *(const uint2*)vr; t.u[1] = *(const uint2*)(vr + 16); Vf[dt] = t.v;
    }
    bool valid[2][4];
#pragma unroll
    for (int tt = 0; tt < 2; ++tt)
#pragma unroll
      for (int j = 0; j < 4; ++j) {
        const int kp = kp0 + 16 * tt + 4 * g + j; int dq = qpos - kp; dq = dq < 0 ? -dq : dq;
        valid[tt][j] = win ? (kp >= 0 && kp < SEQ && dq <= 128) : true;
      }
#pragma unroll
    for (int hh = 0; hh < 4; ++hh) {
      f32x4 st[2];
#pragma unroll
      for (int tt = 0; tt < 2; ++tt) { f32x4 z = {0.f, 0.f, 0.f, 0.f}; z = mfma16(Kf[tt][0], Qf[hh][0], z); z = mfma16(Kf[tt][1], Qf[hh][1], z); st[tt] = z; }
      float mx = -3.0e38f;
#pragma unroll
      for (int tt = 0; tt < 2; ++tt)
#pragma unroll
        for (int j = 0; j < 4; ++j) { const float sv = valid[tt][j] ? st[tt][j] : -1e30f; st[tt][j] = sv; mx = fmaxf(mx, sv); }
      mx = fmaxf(mx, shx(mx, 16, lane)); mx = fmaxf(mx, shx(mx, 32, lane));
      const float mnew = fmaxf(m[hh], mx);
      const float alpha = __expf(m[hh] - mnew); m[hh] = mnew;
      float ps = 0.f; float pv[2][4];
#pragma unroll
      for (int tt = 0; tt < 2; ++tt)
#pragma unroll
        for (int j = 0; j < 4; ++j) { const float e = __expf(st[tt][j] - mnew); pv[tt][j] = e; ps += e; }
      lsum[hh] = lsum[hh] * alpha + ps;
      union { unsigned u[4]; bf16x8 v; } Pf;
      Pf.u[0] = pk_bf16(pv[0][0], pv[0][1]); Pf.u[1] = pk_bf16(pv[0][2], pv[0][3]);
      Pf.u[2] = pk_bf16(pv[1][0], pv[1][1]); Pf.u[3] = pk_bf16(pv[1][2], pv[1][3]);
#pragma unroll
      for (int dt = 0; dt < 4; ++dt) {
        f32x4 o = O[hh][dt]; o[0] *= alpha; o[1] *= alpha; o[2] *= alpha; o[3] *= alpha;
        O[hh][dt] = mfma16(Vf[dt], Pf.v, o);
      }
    }
  };
  if (!isctx) {
    attn_stage(QK, PT, Ks, Vs, tid, kvh, rowbase, q0b - 128, 400, SEQ);
    __syncthreads();
#pragma unroll 1
    for (int ci = 0; ci < 9; ++ci) chunk(16 * wave + 32 * ci, q0 - 128 + 32 * ci, true);
    __syncthreads();
  }
  attn_stage(QK, PT, Ks, Vs, tid, kvh, ctxbase, 0, 256, CTXL);
  __syncthreads();
#pragma unroll 1
  for (int ci = 0; ci < 8; ++ci) chunk(32 * ci, 32 * ci, false);
#pragma unroll
  for (int hh = 0; hh < 4; ++hh) {
    float ls = lsum[hh]; ls += shx(ls, 16, lane); ls += shx(ls, 32, lane);
    const float sink = p.in[27][l * 8 + kvh * 4 + hh];
    const float inv = 1.f / (ls + __expf(sink - m[hh]));
#pragma unroll
    for (int dt = 0; dt < 4; ++dt) {
      uint2 o; o.x = pk_bf16(O[hh][dt][0] * inv, O[hh][dt][1] * inv); o.y = pk_bf16(O[hh][dt][2] * inv, O[hh][dt][3] * inv);
      *(uint2*)(YC + (size_t)qrow * D + 512 + (kvh * 4 + hh) * 64 + 16 * dt + 4 * g) = o;
    }
  }
  __syncthreads();
}

DEVI void lru_item(const Params& p, int l, int item, int pass) {
  const u16* PT = (const u16*)(p.ws + OFF_PT); u16* YC = (u16*)(p.ws + OFF_H);
  float2* SUMM = (float2*)(p.ws + OFF_SUMM);
  const int ch = item >> 2, n = item & 3;
  const int isctx = ch >= 256;
  int b, tq; if (!isctx) { b = ch >> 5; tq = ch & 31; } else { b = (ch - 256) >> 1; tq = (ch - 256) & 1; }
  const int Lseq = isctx ? CTXL : SEQ, rowbase = isctx ? TL + b * CTXL : b * SEQ, t0 = tq * 128;
  float* xs = (float*)smem;
  float* gs = xs + 64 * 145;
  float* ul = gs + 64 * 145;
  float* sm = ul + 128 * 64;
  float* hc = sm + 2 * 8 * 64 * 2;
  const int tid = otid(), e = tid & 63, tg = tid >> 6, c = n * 64 + e;
  for (int idx = tid; idx < 64 * 18; idx += NTHREADS) {
    const int chn = idx / 18, ck = idx % 18, t = t0 - 8 + ck * 8;
    const bool ok = (t >= 0 && t < Lseq);
    bf16x8 v = {0, 0, 0, 0, 0, 0, 0, 0};
    if (ok) v = *(const bf16x8*)(PT + (size_t)(n * 64 + chn) * T + rowbase + t);
#pragma unroll
    for (int q = 0; q < 8; ++q) xs[chn * 145 + ck * 8 + q] = bf2f((u16)v[q]);
    if (pass) {
      bf16x8 v2 = {0, 0, 0, 0, 0, 0, 0, 0};
      if (ok) v2 = *(const bf16x8*)(PT + (size_t)(256 + n * 64 + chn) * T + rowbase + t);
#pragma unroll
      for (int q = 0; q < 8; ++q) gs[chn * 145 + ck * 8 + q] = bf2f((u16)v2[q]);
    }
  }
  if (pass && tid < 128) {
    const int d = tid >> 6, cc = n * 64 + (tid & 63);
    const float2* S = SUMM + (size_t)d * 272 * 256 + cc;
    float h = 0.f;
    const int c0i = 256 + b * 2, l0i = b * 32;
    if (d == 0) {
      if (isctx) { for (int j = 0; j < tq; ++j) { const float2 s = S[(size_t)(c0i + j) * 256]; h = s.x * h + s.y; } }
      else {
        { const float2 s = S[(size_t)(c0i + 0) * 256]; h = s.x * h + s.y; }
        { const float2 s = S[(size_t)(c0i + 1) * 256]; h = s.x * h + s.y; }
        for (int q = 0; q < tq; ++q) { const float2 s = S[(size_t)(l0i + q) * 256]; h = s.x * h + s.y; }
      }
    } else {
      if (isctx) { for (int j = 1; j > tq; --j) { const float2 s = S[(size_t)(c0i + j) * 256]; h = s.x * h + s.y; } }
      else {
        { const float2 s = S[(size_t)(c0i + 1) * 256]; h = s.x * h + s.y; }
        { const float2 s = S[(size_t)(c0i + 0) * 256]; h = s.x * h + s.y; }
        for (int q = 31; q > tq; --q) { const float2 s = S[(size_t)(l0i + q) * 256]; h = s.x * h + s.y; }
      }
    }
    hc[tid] = h;
  }
  __syncthreads();
  float uo[16];
  { const float* cw = p.in[11] + (size_t)l * 4 * 256 + c;
    const float w0 = cw[0], w1 = cw[256], w2 = cw[512], w3 = cw[768], cb = p.in[12][l * 256 + c];
    const float* xr = xs + e * 145 + 8 + 16 * tg;
#pragma unroll
    for (int tt = 0; tt < 16; ++tt) { const float u = cb + w0 * xr[tt - 2] + w1 * xr[tt - 1] + w2 * xr[tt] + w3 * xr[tt + 1]; uo[tt] = u; ul[(16 * tg + tt) * 64 + e] = u; } }
  __syncthreads();
  float av[2][16], bv[2][16];
#pragma unroll
  for (int d = 0; d < 2; ++d) {
    const float* WA = p.in[13] + (size_t)(((l * 2 + d) * 4 + n) * 64) * 64 + e;
    const float* WX = p.in[15] + (size_t)(((l * 2 + d) * 4 + n) * 64) * 64 + e;
    float accr[16], acci[16];
    { const float ba = p.in[14][(l * 2 + d) * 256 + c], bx = p.in[16][(l * 2 + d) * 256 + c];
#pragma unroll
      for (int tt = 0; tt < 16; ++tt) { accr[tt] = ba; acci[tt] = bx; } }
    for (int k4 = 0; k4 < 16; ++k4) {
      const float wa0 = WA[(4 * k4 + 0) * 64], wa1 = WA[(4 * k4 + 1) * 64], wa2 = WA[(4 * k4 + 2) * 64], wa3 = WA[(4 * k4 + 3) * 64];
      const float wx0 = WX[(4 * k4 + 0) * 64], wx1 = WX[(4 * k4 + 1) * 64], wx2 = WX[(4 * k4 + 2) * 64], wx3 = WX[(4 * k4 + 3) * 64];
#pragma unroll
      for (int tt = 0; tt < 16; ++tt) {
        const float4 uu = *(const float4*)(ul + (16 * tg + tt) * 64 + 4 * k4);
        accr[tt] += uu.x * wa0 + uu.y * wa1 + uu.z * wa2 + uu.w * wa3;
        acci[tt] += uu.x * wx0 + uu.y * wx1 + uu.z * wx2 + uu.w * wx3;
      }
    }
    const float lam = p.in[17][(l * 2 + d) * 256 + c];
    const float ex = __expf(-lam); const float sp = ex * (1.f - ex * (0.5f - ex * (0.33333334f - 0.25f * ex)));
    float Ap = 1.f, Bp = 0.f;
#pragma unroll
    for (int q = 0; q < 16; ++q) {
      const int tt = d == 0 ? q : 15 - q;
      const float r = sigmoidf_(accr[tt]), ig = sigmoidf_(acci[tt]);
      const float la = -8.f * r * sp;
      const float a = __expf(la);
      const float y2 = 2.f * la;
      const float om = y2 > -0.1f ? -y2 * (1.f + y2 * (0.5f + y2 * (0.16666667f + y2 * (0.041666668f + y2 * 0.008333334f)))) : 1.f - __expf(y2);
      const float bb = sqrtf(om) * (ig * uo[tt]);
      av[d][tt] = a; bv[d][tt] = bb;
      Bp = a * Bp + bb; Ap *= a;
    }
    sm[((d * 8 + tg) * 64 + e) * 2 + 0] = Ap; sm[((d * 8 + tg) * 64 + e) * 2 + 1] = Bp;
  }
  __syncthreads();
  if (!pass) {
    if (tid < 128) {
      const int d = tid >> 6, ee = tid & 63;
      float A = 1.f, Bc = 0.f;
      if (d == 0) { for (int g2 = 0; g2 < 8; ++g2) { const float a = sm[((0 * 8 + g2) * 64 + ee) * 2], bq = sm[((0 * 8 + g2) * 64 + ee) * 2 + 1]; Bc = a * Bc + bq; A *= a; } }
      else { for (int g2 = 7; g2 >= 0; --g2) { const float a = sm[((1 * 8 + g2) * 64 + ee) * 2], bq = sm[((1 * 8 + g2) * 64 + ee) * 2 + 1]; Bc = a * Bc + bq; A *= a; } }
      SUMM[((size_t)d * 272 + ch) * 256 + n * 64 + ee] = make_float2(A, Bc);
    }
  } else {
    float hs[16];
    { float h = hc[e];
      for (int g2 = 0; g2 < tg; ++g2) { const float a = sm[((0 * 8 + g2) * 64 + e) * 2], bq = sm[((0 * 8 + g2) * 64 + e) * 2 + 1]; h = a * h + bq; }
#pragma unroll
      for (int tt = 0; tt < 16; ++tt) { h = av[0][tt] * h + bv[0][tt]; hs[tt] = h; } }
    { float h = hc[64 + e];
      for (int g2 = 7; g2 > tg; --g2) { const float a = sm[((1 * 8 + g2) * 64 + e) * 2], bq = sm[((1 * 8 + g2) * 64 + e) * 2 + 1]; h = a * h + bq; }
#pragma unroll
      for (int tt = 15; tt >= 0; --tt) { h = av[1][tt] * h + bv[1][tt]; hs[tt] += h; } }
    const float* gr = gs + e * 145 + 8 + 16 * tg;
#pragma unroll
    for (int tt = 0; tt < 16; ++tt) {
      const float y = hs[tt] * gelu_tanh(gr[tt]);
      YC[(size_t)(rowbase + t0 + 16 * tg + tt) * D + c] = f2bf(y);
    }
  }
  __syncthreads();
}

DEVI void uprep_phase(const Params& p, int l) {
  const u16* PT = (const u16*)(p.ws + OFF_PT); u16* UT = (u16*)(p.ws + OFF_UT); u16* X0T = (u16*)(p.ws + OFF_X0T);
  constexpr int NCH = T / 8;
  for (int idx = blockIdx.x * NTHREADS + otid(); idx < 256 * NCH; idx += gridDim.x * NTHREADS) {
    const int c = idx / NCH, ck = idx % NCH, row = ck * 8;
    int t, Lseq; if (row < TL) { t = row & 4095; Lseq = SEQ; } else { t = (row - TL) & 255; Lseq = CTXL; }
    float o[3][8];
#pragma unroll
    for (int k = 0; k < 3; ++k) {
      const int col = k * 256 + c;
      const u16* src = PT + (size_t)(512 + col) * T + row;
      const bf16x8 v = *(const bf16x8*)src;
      float x[10];
      x[0] = t > 0 ? bf2f(src[-1]) : 0.f;
      x[9] = (t + 8 < Lseq) ? bf2f(src[8]) : 0.f;
#pragma unroll
      for (int q = 0; q < 8; ++q) x[q + 1] = bf2f((u16)v[q]);
      const float w0 = p.in[18][(l * 3 + 0) * 768 + col], w1 = p.in[18][(l * 3 + 1) * 768 + col], w2 = p.in[18][(l * 3 + 2) * 768 + col], bb = p.in[19][l * 768 + col];
#pragma unroll
      for (int q = 0; q < 8; ++q) o[k][q] = bb + w0 * x[q] + w1 * x[q + 1] + w2 * x[q + 2];
    }
    uint4 uo, xo;
    uo.x = pk_bf16(o[1][0] * o[2][0], o[1][1] * o[2][1]); uo.y = pk_bf16(o[1][2] * o[2][2], o[1][3] * o[2][3]);
    uo.z = pk_bf16(o[1][4] * o[2][4], o[1][5] * o[2][5]); uo.w = pk_bf16(o[1][6] * o[2][6], o[1][7] * o[2][7]);
    xo.x = pk_bf16(o[0][0], o[0][1]); xo.y = pk_bf16(o[0][2], o[0][3]); xo.z = pk_bf16(o[0][4], o[0][5]); xo.w = pk_bf16(o[0][6], o[0][7]);
    *(uint4*)(UT + (size_t)c * T + row) = uo;
    *(uint4*)(X0T + (size_t)c * T + row) = xo;
  }
}

DEVI bf16x8 ld_frag8(const u16* a) { union { uint2 u[2]; bf16x8 v; } f; f.u[0] = *(const uint2*)a; f.u[1] = *(const uint2*)(a + 4); return f.v; }
DEVI void toep_item(const Params& p, int l, int c, int isctx) {
  const int L = isctx ? CTXL : SEQ;
  const u16* KF = isctx ? (const u16*)(p.ws + OFF_KFC) + (size_t)c * 512 : (const u16*)(p.ws + OFF_KF) + (size_t)(l * 256 + c) * 8192;
  u16* R = (u16*)smem; const int CS = 2 * L + 8;
  u16* Us = R + 4 * CS; const int USTR = L + 8;
  const int tid = otid(), wave = tid >> 6, lane = tid & 63, fr = lane & 15, g = lane >> 4;
  const u16* Uc = (const u16*)(p.ws + OFF_UT) + (size_t)c * T;
  const u16* X0c = (const u16*)(p.ws + OFF_X0T) + (size_t)c * T;
  for (int q = tid; q < (2 * L) / 8; q += NTHREADS) {
    const bf16x8 v = *(const bf16x8*)(KF + 8 * q);
#pragma unroll
    for (int mm = 0; mm < 4; ++mm)
#pragma unroll
      for (int e = 0; e < 8; ++e) R[mm * CS + 8 * q + e + mm] = (u16)v[e];
  }
  if (tid < 32) { const int mm = tid >> 3, e = tid & 7; if (e < mm) R[mm * CS + e] = 0; else R[mm * CS + 2 * L + e] = 0; }
  for (int q = tid; q < L; q += NTHREADS) {
    const int bb = q / (L / 8), ck = q % (L / 8);
    const size_t row = (isctx ? (size_t)TL + (size_t)bb * CTXL : (size_t)bb * SEQ) + ck * 8;
    *(uint4*)(Us + bb * USTR + ck * 8) = *(const uint4*)(Uc + row);
  }
  __syncthreads();
  u16* YC = (u16*)(p.ws + OFF_H);
  const float skip = p.in[26][l * 256 + c];
  const int nT = L / 128;
  const int mcp = fr & 3;
  const u16* Rl = R + mcp * CS + (L + 8 * g - (fr - mcp));
  const u16* Ul = Us + (fr & 7) * USTR + 8 * g;
  const size_t urow = isctx ? (size_t)TL + (size_t)(fr & 7) * CTXL : (size_t)(fr & 7) * SEQ;
  for (int wt = wave; wt < nT; wt += 8) {
    const int T0 = wt * 128;
    f32x4 acc[8];
#pragma unroll
    for (int m8 = 0; m8 < 8; ++m8) acc[m8] = (f32x4){0.f, 0.f, 0.f, 0.f};
    bf16x8 F[8];
#pragma unroll
    for (int m8 = 2; m8 < 8; ++m8) F[m8] = ld_frag8(Rl + (0 - T0 - 16 * m8));
#pragma unroll 1
    for (int s0 = 0; s0 < L; s0 += 128) {
#pragma unroll
      for (int k = 0; k < 4; ++k) {
        const int s = s0 + 32 * k;
        const bf16x8 Bf = *(const bf16x8*)(Ul + s);
        F[(8 - 2 * k) & 7] = ld_frag8(Rl + (s - T0));
        F[(9 - 2 * k) & 7] = ld_frag8(Rl + (s - T0 - 16));
#pragma unroll
        for (int m8 = 0; m8 < 8; ++m8) acc[m8] = mfma16(F[(m8 + 8 - 2 * k) & 7], Bf, acc[m8]);
      }
    }
    if (fr < 8) {
#pragma unroll
      for (int m8 = 0; m8 < 8; ++m8) {
        const size_t row = urow + T0 + 16 * m8 + 4 * g;
        const bf16x4 u4 = *(const bf16x4*)(Us + fr * USTR + T0 + 16 * m8 + 4 * g), x4 = *(const bf16x4*)(X0c + row);
#pragma unroll
        for (int j = 0; j < 4; ++j) {
          const float y = bf2f((u16)x4[j]) * (acc[m8][j] + skip * bf2f((u16)u4[j]));
          YC[(row + j) * D + 256 + c] = f2bf(y);
        }
      }
    }
  }
  __syncthreads();
}

#ifndef PROBE
#define PROBE -1
#endif
#define PHASE(id, ...) do { { const float rcf = 1.f; (void)rcf; __VA_ARGS__ } grid.sync(); if (PROBE == (id)) { { const float rcf = 0.f; (void)rcf; __VA_ARGS__ } grid.sync(); } } while (0)
__global__ void __launch_bounds__(NTHREADS) mega(Params p) {
  cg::grid_group grid = cg::this_grid();
  PHASE(0, phase0(p););
#pragma unroll 1
  for (int l = 0; l < 2; ++l) {
    const int Mpost = l == 0 ? T : TL;
    PHASE(1, norm_phase(p, l, 0, T, l == 0););
    PHASE(2, { EpiAct e{(u16*)(p.ws + OFF_BIG)};
      gemm_phase((const u16*)(p.ws + OFF_H), (const u16*)(p.ws + OFF_W1T) + (size_t)(l * 2 + 0) * 5632 * 1024, T, 2 * DFF, D, e); });
    PHASE(3, { float* X = (float*)(p.ws + OFF_X);
      EpiRes e{(l == 0 && rcf != 0.f) ? p.in[0] : X, (l == 0 && rcf != 0.f) ? p.in[2] : X + (size_t)TL * D, X, (const float*)(p.ws + OFF_MOD) + (size_t)l * 9 * 9216, 2, 0.5f * rcf};
      gemm_phase((const u16*)(p.ws + OFF_BIG), (const u16*)(p.ws + OFF_W2T) + (size_t)(l * 2 + 0) * 1024 * 2816, T, D, DFF, e); });
    PHASE(1, norm_phase(p, l, 1, T, false););
    PHASE(4, { EpiProj e{(u16*)(p.ws + OFF_PT), (u16*)(p.ws + OFF_QK), (const float*)(p.ws + OFF_ROPE), (const float*)(p.ws + OFF_ROPE) + 4096 * 32};
      gemm_phase((const u16*)(p.ws + OFF_H), (const u16*)(p.ws + OFF_WINT) + (size_t)l * 2048 * 1024, T, DIN, D, e); });
    PHASE(5, { const int n_att = l == 0 ? 512 + 32 : 512, n_lru = 1088;
      for (int it = blockIdx.x; it < n_att + n_lru; it += gridDim.x) { if (it < n_att) attn_item(p, l, it); else lru_item(p, l, it - n_att, 0); }
      uprep_phase(p, l); });
    PHASE(6, { const int n_t1 = 256, n_t2 = l == 0 ? 256 : 0, n_lru = l == 0 ? 1088 : 1024;
      for (int it = blockIdx.x; it < n_t1 + n_t2 + n_lru; it += gridDim.x) {
        if (it < n_t1) toep_item(p, l, it, 0);
        else if (it < n_t1 + n_t2) toep_item(p, l, it - n_t1, 1);
        else lru_item(p, l, it - n_t1 - n_t2, 1);
      } });
    PHASE(7, { float* X = (float*)(p.ws + OFF_X);
      EpiRes e{X, X + (size_t)TL * D, X, (const float*)(p.ws + OFF_MOD) + (size_t)l * 9 * 9216, 5, 1.0f * rcf};
      gemm_phase((const u16*)(p.ws + OFF_H), (const u16*)(p.ws + OFF_WOT) + (size_t)l * 1024 * 1024, Mpost, D, D, e); });
    PHASE(1, norm_phase(p, l, 2, Mpost, false););
    PHASE(2, { EpiAct e{(u16*)(p.ws + OFF_BIG)};
      gemm_phase((const u16*)(p.ws + OFF_H), (const u16*)(p.ws + OFF_W1T) + (size_t)(l * 2 + 1) * 5632 * 1024, Mpost, 2 * DFF, D, e); });
    PHASE(3, { float* X = (float*)(p.ws + OFF_X);
      EpiRes e{X, X + (size_t)TL * D, X, (const float*)(p.ws + OFF_MOD) + (size_t)l * 9 * 9216, 8, 0.5f * rcf};
      gemm_phase((const u16*)(p.ws + OFF_BIG), (const u16*)(p.ws + OFF_W2T) + (size_t)(l * 2 + 1) * 1024 * 2816, Mpost, D, DFF, e); });
  }
  final_norm_phase(p);
}

extern "C" void kernel_launch(void* const* d_in, const int* in_sizes, int n_in, void* d_out, int out_size, void* d_ws, size_t ws_size, hipStream_t stream) {
  static int grid_blocks = 0;
  if (!grid_blocks) {
    if (ws_size < WS_END || n_in != 29) { fprintf(stderr, "kernel_launch: workspace %zu < %zu or n_in %d != 29\n", ws_size, (size_t)WS_END, n_in); grid_blocks = -1; return; }
    int dev = 0, cus = 0, per_cu = 0;
    hipGetDevice(&dev);
    hipDeviceGetAttribute(&cus, hipDeviceAttributeMultiprocessorCount, dev);
    if (hipFuncSetAttribute((const void*)mega, hipFuncAttributeMaxDynamicSharedMemorySize, LDS_BYTES) != hipSuccess) { fprintf(stderr, "hipFuncSetAttribute failed\n"); }
    hipOccupancyMaxActiveBlocksPerMultiprocessor(&per_cu, (const void*)mega, NTHREADS, LDS_BYTES);
    if (per_cu < 1) { fprintf(stderr, "occupancy query returned %d\n", per_cu); per_cu = 1; }
    if (per_cu > 1) per_cu = 1;
    grid_blocks = cus * per_cu;
    (void)hipGetLastError();
  }
  if (grid_blocks < 0) return;
  Params p{};
  for (int i = 0; i < 29; ++i) p.in[i] = (const float*)d_in[i];
  p.out = (float*)d_out; p.ws = (unsigned char*)d_ws;
  void* args[] = {&p};
  hipError_t e = hipLaunchCooperativeKernel((void*)mega, dim3(grid_blocks), dim3(NTHREADS), args, LDS_BYTES, stream);
  if (e != hipSuccess) fprintf(stderr, "cooperative launch failed: %s (grid %d)\n", hipGetErrorString(e), grid_blocks);
}
```

```cpp
#include <hip/hip_runtime.h>
#include <hip/hip_cooperative_groups.h>
#include <cstdio>
namespace cg = cooperative_groups;

using bf16x8 = __attribute__((ext_vector_type(8))) short;
using bf16x4 = __attribute__((ext_vector_type(4))) short;
using f32x4  = __attribute__((ext_vector_type(4))) float;
typedef unsigned short u16;
#define DEVI __device__ __forceinline__

constexpr int D = 1024, NB = 8, SEQ = 4096, CTXL = 256, TL = NB * SEQ, TC = NB * CTXL, T = TL + TC;
constexpr int DFF = 2816, DIN = 2048;
constexpr int NTHREADS = 512;
constexpr int LDS_BYTES = 163840;

constexpr size_t OFF_X    = 0;
constexpr size_t OFF_H    = OFF_X + (size_t)T * D * 4;
constexpr size_t OFF_BIG  = OFF_H + (size_t)T * D * 2;
constexpr size_t OFF_PT   = OFF_BIG;
constexpr size_t OFF_QK   = OFF_PT + (size_t)1408 * T * 2;
constexpr size_t OFF_UT   = OFF_QK + (size_t)T * 640 * 2;
constexpr size_t OFF_X0T  = OFF_UT + (size_t)256 * T * 2;
constexpr size_t OFF_SUMM = OFF_X0T + (size_t)256 * T * 2;
constexpr size_t OFF_W1T  = OFF_BIG + (size_t)T * DFF * 2;
constexpr size_t OFF_W2T  = OFF_W1T + (size_t)4 * 5632 * 1024 * 2;
constexpr size_t OFF_WINT = OFF_W2T + (size_t)4 * 1024 * 2816 * 2;
constexpr size_t OFF_WOT  = OFF_WINT + (size_t)2 * 2048 * 1024 * 2;
constexpr size_t OFF_MOD  = OFF_WOT + (size_t)2 * 1024 * 1024 * 2;
constexpr size_t OFF_KF   = OFF_MOD + (size_t)2 * 9 * 9216 * 4;
constexpr size_t OFF_KFC  = OFF_KF + (size_t)2 * 256 * 8192 * 2;
constexpr size_t OFF_ROPE = OFF_KFC + (size_t)256 * 512 * 2;
constexpr size_t WS_END   = OFF_ROPE + (size_t)2 * 4096 * 32 * 4;
static_assert(OFF_SUMM + 2 * 272 * 256 * 8 <= OFF_W1T, "mixer buffers overflow ACT region");

struct Params {
  const float* in[29];
  float* out;
  unsigned char* ws;
  int wv, pad_;
};

extern __shared__ __attribute__((aligned(16))) unsigned char smem[];

DEVI unsigned pk_bf16(float lo, float hi) { unsigned r; asm volatile("v_cvt_pk_bf16_f32 %0, %1, %2" : "=v"(r) : "v"(lo), "v"(hi)); return r; }
DEVI u16 f2bf(float x) { return (u16)(pk_bf16(x, 0.f) & 0xffffu); }
DEVI float bf2f(u16 h) { return __uint_as_float(((unsigned)h) << 16); }
DEVI float sigmoidf_(float x) { return 1.f / (1.f + __expf(-x)); }
DEVI float gelu_tanh(float x) { float z = 0.7978845608028654f * (x + 0.044715f * x * x * x); float th = 1.f - 2.f / (1.f + __expf(2.f * z)); return 0.5f * x * (1.f + th); }
template <class Tp> DEVI const Tp* opaque(const Tp* q) { asm volatile("" : "+s"(q)); return q; }
DEVI int otid_(int wv) { int t = (wv << 6) | (int)__builtin_amdgcn_mbcnt_hi(~0u, __builtin_amdgcn_mbcnt_lo(~0u, 0u)); asm volatile("" : "+v"(t)); return t; }
#define otid() otid_(p.wv)
DEVI float shx(float v, int o, int lane) { return __int_as_float(__builtin_amdgcn_ds_bpermute((lane ^ o) << 2, __float_as_int(v))); }
DEVI f32x4 mfma16(bf16x8 a, bf16x8 b, f32x4 c) { return __builtin_amdgcn_mfma_f32_16x16x32_bf16(a, b, c, 0, 0, 0); }

constexpr int BM = 256, BK = 64, HALF = 128, HT = HALF * BK;
DEVI int lds_byte(int r, int c) { int st = (r >> 4) * 2 + (c >> 5), rr = r & 15, cc = c & 31, ob = rr * 64 + cc * 2; return st * 1024 + (ob ^ (((ob >> 9) & 1) << 5)); }
DEVI void stage_rc(int b, int& R, int& C) { int st = b / 1024, sb = b % 1024, swz = sb ^ (((sb >> 9) & 1) << 5); R = (st >> 1) * 16 + swz / 64; C = (st & 1) * 32 + (swz % 64) / 2; }

DEVI bool tile_next(int i, int nM, int nN, int& pm, int& pn) {
  const int nwg = nM * nN; const long Lx = (long)i * gridDim.x + blockIdx.x; if (Lx >= nwg) return false;
  int wgid = (int)Lx; { const int q = nwg / 8, r = nwg % 8, xcd = wgid % 8, off = wgid / 8; wgid = (xcd < r ? xcd * (q + 1) : r * (q + 1) + (xcd - r) * q) + off; }
  const int nig = 8 * nN, gid = wgid / nig, fm = gid * 8, gsz = (nM - fm) < 8 ? (nM - fm) : 8;
  pm = fm + ((wgid % nig) % gsz); pn = (wgid % nig) / gsz; return true;
}
template <class Epi>
DEVI void gemm_phase(const Params& p, const u16* __restrict__ A, const u16* __restrict__ Bt, const int M, const int N, const int K, const Epi& epi) {
  u16* shm = (u16*)smem;
#define SA(b, h) (shm + ((b) * 2 + (h)) * HT)
#define SB(b, h) (shm + (4 + (b) * 2 + (h)) * HT)
#define STAGE(P, BASE, br, kt) do { const char* _ub = (const char*)(BASE + (long)(br) * K + (long)(kt) * BK); \
      __builtin_amdgcn_global_load_lds((const unsigned*)(_ub + soff0), (unsigned*)((char*)(P) + tid * 16), 16, 0, 0); \
      __builtin_amdgcn_global_load_lds((const unsigned*)(_ub + soff1), (unsigned*)((char*)(P) + tid * 16 + 8192), 16, 0, 0); } while (0)
#define LDA(dst, b, h) for (int m = 0; m < 4; ++m) for (int k = 0; k < 2; ++k) \
    dst[m][k] = *reinterpret_cast<const bf16x8*>((char*)SA(b, h) + lds_byte(wr * 64 + m * 16 + fr, k * 32 + fq * 8))
#define LDB(dst, b, h) for (int n = 0; n < 2; ++n) for (int k = 0; k < 2; ++k) \
    dst[n][k] = *reinterpret_cast<const bf16x8*>((char*)SB(b, h) + lds_byte(wc * 32 + n * 16 + fr, k * 32 + fq * 8))
#define MMA(ai, bj, At_, Bt_) do { __builtin_amdgcn_s_setprio(1); \
    for (int m = 0; m < 4; ++m) for (int n = 0; n < 2; ++n) for (int k = 0; k < 2; ++k) \
      acc[ai][bj][m][n] = Epi::TR ? __builtin_amdgcn_mfma_f32_16x16x32_bf16(Bt_[n][k], At_[m][k], acc[ai][bj][m][n], 0, 0, 0) \
                                  : __builtin_amdgcn_mfma_f32_16x16x32_bf16(At_[m][k], Bt_[n][k], acc[ai][bj][m][n], 0, 0, 0); \
    __builtin_amdgcn_s_setprio(0); } while (0)
#define WAIT_V(n) asm volatile("s_waitcnt vmcnt(" #n ")" ::: "memory")
#define WAIT_L(n) asm volatile("s_waitcnt lgkmcnt(" #n ")" ::: "memory")
#define BAR __builtin_amdgcn_s_barrier()
#define SCHED __builtin_amdgcn_sched_barrier(0)
#define PROLOGUE_ISSUE(brow_, bcol_) do { \
    STAGE(SB(0, 0), Bt, bcol_, 0); STAGE(SA(0, 0), A, brow_, 0); STAGE(SB(0, 1), Bt, (bcol_) + HALF, 0); STAGE(SA(0, 1), A, (brow_) + HALF, 0); \
    STAGE(SB(1, 0), Bt, bcol_, 1); STAGE(SA(1, 0), A, brow_, 1); STAGE(SB(1, 1), Bt, (bcol_) + HALF, 1); } while (0)
  const int tid = otid();
  const int wid = tid >> 6, lane = tid & 63, wr = wid >> 2, wc = wid & 3, fr = lane & 15, fq = lane >> 4;
  unsigned soff0, soff1;
  { int r_, c_; stage_rc(tid * 16, r_, c_); soff0 = (unsigned)(r_ * K + c_) * 2u; stage_rc(tid * 16 + 8192, r_, c_); soff1 = (unsigned)(r_ * K + c_) * 2u; }
  const int nM = M / BM, nN = N / BM, nt = K / BK;
  int pm, pn;
  bool have = tile_next(0, nM, nN, pm, pn);
  if (have) PROLOGUE_ISSUE(pm * BM, pn * BM);
#pragma unroll 1
  for (int it = 0; have; ++it) {
    const int brow = pm * BM, bcol = pn * BM;
    f32x4 acc[2][2][4][2] = {};
    bf16x8 At[4][2], B0[2][2], B1[2][2];
    WAIT_V(0);
    if (wr == 1) BAR;
    BAR;
    BAR;
    for (int t = 0; t < nt - 2; t += 2) {
      LDB(B0, 0, 0); SCHED; LDA(At, 0, 0); STAGE(SA(1, 1), A, brow + HALF, t + 1);
      WAIT_L(8); BAR; WAIT_L(0); MMA(0, 0, At, B0); BAR; SCHED;
      LDB(B1, 0, 1); STAGE(SB(0, 0), Bt, bcol, t + 2);
      BAR; WAIT_L(0); MMA(0, 1, At, B1); BAR;
      LDA(At, 0, 1); STAGE(SA(0, 0), A, brow, t + 2);
      BAR; WAIT_L(0); MMA(1, 0, At, B0); BAR; SCHED;
      STAGE(SB(0, 1), Bt, bcol + HALF, t + 2);
      WAIT_V(6); BAR; MMA(1, 1, At, B1); BAR;
      LDB(B0, 1, 0); SCHED; LDA(At, 1, 0); STAGE(SA(0, 1), A, brow + HALF, t + 2);
      WAIT_L(8); BAR; WAIT_L(0); MMA(0, 0, At, B0); BAR; SCHED;
      LDB(B1, 1, 1); STAGE(SB(1, 0), Bt, bcol, t + 3);
      BAR; WAIT_L(0); MMA(0, 1, At, B1); BAR;
      LDA(At, 1, 1); STAGE(SA(1, 0), A, brow, t + 3);
      BAR; WAIT_L(0); MMA(1, 0, At, B0); BAR; SCHED;
      STAGE(SB(1, 1), Bt, bcol + HALF, t + 3);
      WAIT_V(6); BAR; MMA(1, 1, At, B1); BAR;
    }
    { LDB(B0, 0, 0); LDA(At, 0, 0); STAGE(SA(1, 1), A, brow + HALF, nt - 1);
      BAR; WAIT_L(0); MMA(0, 0, At, B0); BAR;
      LDB(B1, 0, 1); BAR; WAIT_L(0); MMA(0, 1, At, B1); BAR;
      LDA(At, 0, 1); WAIT_V(4); BAR; WAIT_L(0); MMA(1, 0, At, B0); MMA(1, 1, At, B1); BAR; }
    { LDB(B0, 1, 0); LDA(At, 1, 0); WAIT_V(2); BAR; WAIT_L(0); MMA(0, 0, At, B0); BAR;
      LDB(B1, 1, 1); WAIT_V(0); BAR; WAIT_L(0); MMA(0, 1, At, B1); BAR;
      LDA(At, 1, 1); BAR; WAIT_L(0); MMA(1, 0, At, B0); MMA(1, 1, At, B1); BAR; }
    if (wr == 0) BAR;
    have = tile_next(it + 1, nM, nN, pm, pn);
    if (have) PROLOGUE_ISSUE(pm * BM, pn * BM);
    { const int tid2 = otid(), wid2 = tid2 >> 6, lane2 = tid2 & 63, wr2 = wid2 >> 2, wc2 = wid2 & 3, fr2 = lane2 & 15, fq2 = lane2 >> 4;
#pragma unroll
      for (int ai = 0; ai < 2; ++ai)
#pragma unroll
        for (int bj = 0; bj < 2; ++bj)
#pragma unroll
          for (int m = 0; m < 4; ++m) {
            const int colb = bcol + bj * HALF + wc2 * 32;
            if (Epi::TR) epi(brow + ai * HALF + wr2 * 64 + m * 16 + fr2, colb, fq2, acc[ai][bj][m][0], acc[ai][bj][m][1]);
            else epi(brow + ai * HALF + wr2 * 64 + m * 16 + fq2 * 4, colb, fr2, acc[ai][bj][m][0], acc[ai][bj][m][1]);
          } }
  }
  __syncthreads();
#undef SA
#undef SB
#undef STAGE
#undef LDA
#undef LDB
#undef MMA
#undef PROLOGUE_ISSUE
}

struct EpiAct {
  static constexpr bool TR = true;
  u16* act;
  DEVI void operator()(int row, int colb, int fq, const f32x4& a0, const f32x4& a1) const {
    const int oc = (colb >> 5) * 16 + 4 * fq;
    float v[4];
#pragma unroll
    for (int j = 0; j < 4; ++j) { const float a = a0[j]; v[j] = a * sigmoidf_(a) * a1[j]; }
    uint2 o; o.x = pk_bf16(v[0], v[1]); o.y = pk_bf16(v[2], v[3]);
    *(uint2*)(act + (size_t)row * DFF + oc) = o;
  }
};
struct EpiRes {
  static constexpr bool TR = true;
  const float* xin_lat; const float* xin_ctx;
  float* xout; const float* modl;
  int gi; float coef;
  DEVI void operator()(int row, int colb, int fq, const f32x4& a0, const f32x4& a1) const {
    const int r = row < TL ? (row >> 12) : 8;
    const float* gate = modl + (size_t)(r * 9 + gi) * D;
    const float* src = row < TL ? xin_lat + (size_t)row * D : xin_ctx + (size_t)(row - TL) * D;
#pragma unroll
    for (int n = 0; n < 2; ++n) {
      const int col = colb + n * 16 + 4 * fq;
      const f32x4 gv = *(const f32x4*)(gate + col), xi = *(const f32x4*)(src + col);
      const f32x4& a = n ? a1 : a0;
      f32x4 o;
#pragma unroll
      for (int j = 0; j < 4; ++j) o[j] = xi[j] + coef * gv[j] * a[j];
      *(f32x4*)(xout + (size_t)row * D + col) = o;
    }
  }
};
struct EpiProj {
  static constexpr bool TR = false;
  u16* pt; u16* qk; const float* cost; const float* sint;
  DEVI void operator()(int row0, int colb, int fr, const f32x4& a0, const f32x4& a1) const {
    if (colb < 1280 || colb >= 1920) {
#pragma unroll
      for (int n = 0; n < 2; ++n) {
        const int pc = colb + n * 16 + fr; const int ptc = pc < 1280 ? pc : pc - 640;
        const f32x4& a = n ? a1 : a0;
        uint2 o; o.x = pk_bf16(a[0], a[1]); o.y = pk_bf16(a[2], a[3]);
        *(uint2*)(pt + (size_t)ptc * T + row0) = o;
      }
    } else {
      const int off = colb - 1280, head = off >> 6, grp = (off >> 5) & 1, pidx = 16 * grp + fr;
      const int d1 = head * 64 + pidx, d2 = d1 + 32;
      const float qs = head < 8 ? 0.125f : 1.f;
#pragma unroll
      for (int j = 0; j < 4; ++j) {
        const int row = row0 + j; float c = 1.f, s = 0.f;
        if (row < TL) { const int t = row & 4095; c = cost[t * 32 + pidx]; s = sint[t * 32 + pidx]; }
        const float o1 = (a0[j] * c - a1[j] * s) * qs, o2 = (a0[j] * s + a1[j] * c) * qs;
        qk[(size_t)row * 640 + d1] = f2bf(o1); qk[(size_t)row * 640 + d2] = f2bf(o2);
      }
    }
  }
};

DEVI int srccol(int mode, int pn) {
  if (mode == 1) { const int g = pn >> 5, hh = (pn >> 4) & 1, i = pn & 15; return hh * DFF + g * 16 + i; }
  if (mode == 2) { if (pn < 1280 || pn >= 1920) return pn; const int off = pn - 1280, head = off >> 6, w = off & 63, grp = w >> 5, hh = (w >> 4) & 1, i = w & 15; return 1280 + head * 64 + 16 * grp + i + 32 * hh; }
  return pn;
}
DEVI void transpose_item(const Params& p, const float* __restrict__ W, int K, int N, u16* __restrict__ WT, int mode, int item) {
  float* tile = (float*)smem;
  const int tid = otid(), nblk = N / 64, kb = item / nblk, nb = item % nblk, k0 = kb * 64, n0 = nb * 64;
  { const int nn = tid & 63, kr = tid >> 6, src = srccol(mode, n0 + nn);
#pragma unroll
    for (int r = 0; r < 8; ++r) { const int kk = kr + 8 * r; tile[kk * 65 + nn] = W[(size_t)(k0 + kk) * N + src]; } }
  __syncthreads();
  { const int rown = tid >> 3, kc = tid & 7; const float* s = tile + (kc * 8) * 65 + rown;
    uint4 o; o.x = pk_bf16(s[0], s[65]); o.y = pk_bf16(s[130], s[195]); o.z = pk_bf16(s[260], s[325]); o.w = pk_bf16(s[390], s[455]);
    *(uint4*)(WT + (size_t)(n0 + rown) * K + k0 + kc * 8) = o; }
  __syncthreads();
}
DEVI void mod_item(const Params& p, int item) {
  float* sv = (float*)smem;
  float* red = sv + 9 * 1024;
  const int tid = otid(), l = item / 72, n0 = (item % 72) * 128;
  for (int i = tid; i < 9 * 1024; i += NTHREADS) { const int r = i >> 10, k = i & 1023; const float cv = r < 8 ? p.in[1][r * 1024 + k] : p.in[3][k]; sv[i] = cv * sigmoidf_(cv); }
  __syncthreads();
  const int cc = tid & 127, kq = tid >> 7;
  const float* w = p.in[4] + (size_t)l * 1024 * 9216 + n0 + cc;
  float acc[9];
#pragma unroll
  for (int r = 0; r < 9; ++r) acc[r] = 0.f;
#pragma unroll 2
  for (int k4 = 0; k4 < 64; ++k4) {
    const int k = kq * 256 + k4 * 4;
    const float w0 = w[(size_t)k * 9216], w1 = w[(size_t)(k + 1) * 9216], w2 = w[(size_t)(k + 2) * 9216], w3 = w[(size_t)(k + 3) * 9216];
#pragma unroll
    for (int r = 0; r < 9; ++r) { const float4 s4 = *(const float4*)(sv + r * 1024 + k); acc[r] += s4.x * w0 + s4.y * w1 + s4.z * w2 + s4.w * w3; }
  }
#pragma unroll
  for (int r = 0; r < 9; ++r) red[(kq * 9 + r) * 128 + cc] = acc[r];
  __syncthreads();
  float* MOD = (float*)(p.ws + OFF_MOD);
  for (int i = tid; i < 9 * 128; i += NTHREADS) {
    const int r = i >> 7, c2 = i & 127;
    const float v = red[(0 * 9 + r) * 128 + c2] + red[(1 * 9 + r) * 128 + c2] + red[(2 * 9 + r) * 128 + c2] + red[(3 * 9 + r) * 128 + c2] + p.in[5][l * 9216 + n0 + c2];
    MOD[(size_t)(l * 9 + r) * 9216 + n0 + c2] = v;
  }
  __syncthreads();
}
DEVI void filter_item(const Params& p, int l, int L, u16* __restrict__ KF, int posblk) {
  float* zs = (float*)smem;
  float* hb = zs + 8 * 36;
  const int tid = otid(), w = tid >> 6, j = tid & 63, t = posblk * 8 + w;
  const float* fw0 = opaque(p.in[20] + l * 33 * 64); const float* fb0 = opaque(p.in[21] + l * 64);
  const float* fwin = opaque(p.in[22] + l * 2 * 64 * 64); const float* fbin = opaque(p.in[23] + l * 2 * 64);
  const float* freq = opaque(p.in[24] + l * 64); const float* fwl = opaque(p.in[25] + l * 64 * 512);
  const float tn = (float)t / (float)(L - 1);
  if (j < 33) {
    float z;
    if (j == 0) z = tn;
    else { const int bi = (j - 1) & 15; const float f = 1e-4f + (float)bi * ((15.f - 1e-4f) / 15.f); const float wv = 6.283185307179586f * (float)t / (float)L; const float a = f * wv; z = (j <= 16) ? __cosf(a) : -__sinf(a); }
    zs[w * 36 + j] = z;
  }
  __syncthreads();
  const float fr = freq[j];
  { float acc = fb0[j];
#pragma unroll 3
    for (int i = 0; i < 33; ++i) acc += zs[w * 36 + i] * fw0[i * 64 + j];
    hb[(0 * 8 + w) * 64 + j] = __sinf(fr * acc); }
  __syncthreads();
#pragma unroll
  for (int q = 0; q < 2; ++q) {
    float acc = fbin[q * 64 + j];
#pragma unroll 8
    for (int i = 0; i < 64; ++i) acc += hb[((q & 1) * 8 + w) * 64 + i] * fwin[q * 4096 + i * 64 + j];
    hb[(((q + 1) & 1) * 8 + w) * 64 + j] = __sinf(fr * acc);
    __syncthreads();
  }
  const float mind = -3.0701134573253945f, maxd = -15.350567286626973f;
#pragma unroll 1
  for (int qq = 0; qq < 8; ++qq) {
    const int n = j + 64 * qq;
    float acc = 0.f;
#pragma unroll 8
    for (int i = 0; i < 64; ++i) acc += hb[(0 * 8 + w) * 64 + i] * fwl[i * 512 + n];
    const int c = n & 255; const float delta = fabsf(mind + (float)c * ((maxd - mind) / 255.f));
    const float val = acc * __expf(-tn * delta);
    if (n < 256) KF[(size_t)c * 2 * L + (L - t)] = f2bf(val);
    else if (t >= 1) KF[(size_t)c * 2 * L + (L + t)] = f2bf(val);
  }
  if (t == 0) {
#pragma unroll
    for (int qq = 0; qq < 4; ++qq) KF[(size_t)(j + 64 * qq) * 2 * L] = 0;
  }
  __syncthreads();
}
DEVI void phase0(const Params& p) {
  const int N_MOD_IT = 144, N_FIL = 512 + 512 + 32;
  constexpr int I_W1 = 16 * 88, I_W2 = 44 * 16, I_WIN = 16 * 32, I_WO = 16 * 16;
  const int N_TR = 4 * I_W1 + 4 * I_W2 + 2 * I_WIN + 2 * I_WO;
  const int NIT = N_MOD_IT + N_FIL + N_TR;
  for (int it = blockIdx.x; it < NIT; it += gridDim.x) {
    asm volatile("" ::: "memory");
    int r = it;
    if (r < N_MOD_IT) { mod_item(p, r); continue; } r -= N_MOD_IT;
    if (r < N_FIL) {
      if (r < 512) filter_item(p, 0, 4096, (u16*)(p.ws + OFF_KF), r);
      else if (r < 1024) filter_item(p, 1, 4096, (u16*)(p.ws + OFF_KF) + (size_t)256 * 8192, r - 512);
      else filter_item(p, 0, 256, (u16*)(p.ws + OFF_KFC), r - 1024);
      continue;
    }
    r -= N_FIL;
    if (r < 4 * I_W1) { const int mi = r / I_W1; transpose_item(p, p.in[7] + (size_t)mi * 1024 * 5632, 1024, 5632, (u16*)(p.ws + OFF_W1T) + (size_t)mi * 5632 * 1024, 1, r % I_W1); continue; } r -= 4 * I_W1;
    if (r < 4 * I_W2) { const int mi = r / I_W2; transpose_item(p, p.in[8] + (size_t)mi * 2816 * 1024, 2816, 1024, (u16*)(p.ws + OFF_W2T) + (size_t)mi * 1024 * 2816, 0, r % I_W2); continue; } r -= 4 * I_W2;
    if (r < 2 * I_WIN) { const int mi = r / I_WIN; transpose_item(p, p.in[9] + (size_t)mi * 1024 * 2048, 1024, 2048, (u16*)(p.ws + OFF_WINT) + (size_t)mi * 2048 * 1024, 2, r % I_WIN); continue; } r -= 2 * I_WIN;
    { const int mi = r / I_WO; transpose_item(p, p.in[10] + (size_t)mi * 1024 * 1024, 1024, 1024, (u16*)(p.ws + OFF_WOT) + (size_t)mi * 1024 * 1024, 0, r % I_WO); }
  }
  float* cost = (float*)(p.ws + OFF_ROPE); float* sint = cost + 4096 * 32;
  for (int idx = blockIdx.x * NTHREADS + otid(); idx < 4096 * 32; idx += gridDim.x * NTHREADS) {
    const int t = idx >> 5, pp = idx & 31;
    const float inv = exp2f(-(float)(pp & 15) * (13.287712379549449f / 16.f));
    const float pos = pp < 16 ? (float)(t >> 6) : (float)(t & 63);
    const float ang = pos * inv;
    cost[idx] = __cosf(ang); sint[idx] = __sinf(ang);
  }
}

DEVI float wave_sum(float v, int lane) {
#pragma unroll
  for (int o = 1; o < 64; o <<= 1) v += shx(v, o, lane);
  return v;
}
DEVI void norm_phase(const Params& p, int l, int which, int Mrows, bool from_input) {
  const int tid = otid();
  const int lane = tid & 63, gw = blockIdx.x * 8 + (tid >> 6), NW = gridDim.x * 8;
  const float* X = (const float*)(p.ws + OFF_X); u16* H = (u16*)(p.ws + OFF_H);
  const float* MOD = (const float*)(p.ws + OFF_MOD);
  const f32x4* g4 = (const f32x4*)(p.in[6] + (size_t)(l * 3 + which) * D) + lane;
  for (int row = gw; row < Mrows; row += NW) {
    const float* xr = from_input ? (row < TL ? p.in[0] + (size_t)row * D : p.in[2] + (size_t)(row - TL) * D) : X + (size_t)row * D;
    const int r = row < TL ? (row >> 12) : 8;
    const f32x4* sh4 = (const f32x4*)(MOD + (size_t)((l * 9 + r) * 9 + which * 3) * D) + lane;
    const f32x4* sc4 = sh4 + D / 4;
    const f32x4* x4 = (const f32x4*)xr + lane;
    f32x4 v[4]; float ss = 0.f;
#pragma unroll
    for (int j = 0; j < 4; ++j) { v[j] = x4[64 * j]; ss += (v[j][0] * v[j][0] + v[j][1] * v[j][1]) + (v[j][2] * v[j][2] + v[j][3] * v[j][3]); }
    const float rinv = rsqrtf(wave_sum(ss, lane) * (1.f / D) + 1e-6f);
    uint2* o8 = (uint2*)(H + (size_t)row * D) + lane;
#pragma unroll
    for (int j = 0; j < 4; ++j) {
      const f32x4 g = g4[64 * j], sh = sh4[64 * j], sc = sc4[64 * j];
      f32x4 y;
#pragma unroll
      for (int q = 0; q < 4; ++q) y[q] = v[j][q] * rinv * g[q] * (1.f + sc[q]) + sh[q];
      uint2 o; o.x = pk_bf16(y[0], y[1]); o.y = pk_bf16(y[2], y[3]); o8[64 * j] = o;
    }
  }
}
DEVI void final_norm_phase(const Params& p) {
  const int tid = otid();
  const int lane = tid & 63, gw = blockIdx.x * 8 + (tid >> 6), NW = gridDim.x * 8;
  const float* X = (const float*)(p.ws + OFF_X);
  const f32x4* g4 = (const f32x4*)p.in[28] + lane;
  for (int row = gw; row < TL; row += NW) {
    const f32x4* x4 = (const f32x4*)(X + (size_t)row * D) + lane;
    f32x4 v[4]; float ss = 0.f;
#pragma unroll
    for (int j = 0; j < 4; ++j) { v[j] = x4[64 * j]; ss += (v[j][0] * v[j][0] + v[j][1] * v[j][1]) + (v[j][2] * v[j][2] + v[j][3] * v[j][3]); }
    const float rinv = rsqrtf(wave_sum(ss, lane) * (1.f / D) + 1e-6f);
    f32x4* o4 = (f32x4*)(p.out + (size_t)row * D) + lane;
#pragma unroll
    for (int j = 0; j < 4; ++j) { const f32x4 g = g4[64 * j]; f32x4 y; for (int q = 0; q < 4; ++q) y[q] = v[j][q] * rinv * g[q]; o4[64 * j] = y; }
  }
}

constexpr int AT_KSTR = 72, AT_VSTR = 408;
DEVI void attn_stage(const u16* __restrict__ QK, const u16* __restrict__ PT, u16* Ks, u16* Vs, int tid, int kvh, int kbase, int kstart, int nkeys, int klen) {
  for (int idx = tid; idx < nkeys * 8; idx += NTHREADS) {
    const int kl = idx >> 3, cp = idx & 7, kp = kstart + kl;
    uint4 v = {0u, 0u, 0u, 0u};
    if (kp >= 0 && kp < klen) v = *(const uint4*)(QK + (size_t)(kbase + kp) * 640 + 512 + kvh * 64 + cp * 8);
    *(uint4*)(Ks + kl * AT_KSTR + cp * 8) = v;
  }
  const int nck = nkeys >> 3;
  for (int idx = tid; idx < 64 * nck; idx += NTHREADS) {
    const int dim = idx / nck, ck = idx % nck, kp = kstart + ck * 8;
    uint4 v = {0u, 0u, 0u, 0u};
    if (kp >= 0 && kp < klen) v = *(const uint4*)(PT + (size_t)(1280 + kvh * 64 + dim) * T + kbase + kp);
    *(uint4*)(Vs + dim * AT_VSTR + ck * 8) = v;
  }
}
DEVI void attn_item(const Params& p, int l, int item) {
  const u16* QK = (const u16*)(p.ws + OFF_QK); const u16* PT = (const u16*)(p.ws + OFF_PT); u16* YC = (u16*)(p.ws + OFF_H);
  u16* Ks = (u16*)smem; u16* Vs = Ks + 400 * AT_KSTR;
  const int tid = otid();
  const int wave = tid >> 6, lane = tid & 63, fr = lane & 15, g = lane >> 4;
  int kvh, b, qb, isctx;
  if (item < 512) { kvh = item & 1; qb = (item >> 1) & 31; b = item >> 6; isctx = 0; }
  else { const int it = item - 512; kvh = it & 1; qb = (it >> 1) & 1; b = it >> 2; isctx = 1; }
  const int rowbase = isctx ? TL + b * CTXL : b * SEQ;
  const int ctxbase = TL + b * CTXL;
  const int q0b = qb * 128, q0 = q0b + wave * 16;
  const int qrow = rowbase + q0 + fr, qpos = q0 + fr;
  bf16x8 Qf[4][2];
  float m[4], lsum[4];
  f32x4 O[4][4];
#pragma unroll
  for (int hh = 0; hh < 4; ++hh) {
    const u16* qp = QK + (size_t)qrow * 640 + (kvh * 4 + hh) * 64 + g * 8;
    Qf[hh][0] = *(const bf16x8*)qp; Qf[hh][1] = *(const bf16x8*)(qp + 32);
    m[hh] = p.in[27][l * 8 + kvh * 4 + hh]; lsum[hh] = 0.f;
#pragma unroll
    for (int dt = 0; dt < 4; ++dt) O[hh][dt] = (f32x4){0.f, 0.f, 0.f, 0.f};
  }
  auto chunk = [&](const int lk, const int kp0, const bool win) {
    bf16x8 Kf[2][2];
#pragma unroll
    for (int tt = 0; tt < 2; ++tt) {
      const u16* kr = Ks + (lk + 16 * tt + fr) * AT_KSTR + g * 8;
      Kf[tt][0] = *(const bf16x8*)kr; Kf[tt][1] = *(const bf16x8*)(kr + 32);
    }
    bf16x8 Vf[4];
#pragma unroll
    for (int dt = 0; dt < 4; ++dt) {
      const u16* vr = Vs + (16 * dt + fr) * AT_VSTR + lk + 4 * g;
      union { uint2 u[2]; bf16x8 v; } t; t.u[0] = *(const uint2*)vr; t.u[1] = *(const uint2*)(vr + 16); Vf[dt] = t.v;
    }
    bool valid[2][4];
#pragma unroll
    for (int tt = 0; tt < 2; ++tt)
#pragma unroll
      for (int j = 0; j < 4; ++j) {
        const int kp = kp0 + 16 * tt + 4 * g + j; int dq = qpos - kp; dq = dq < 0 ? -dq : dq;
        valid[tt][j] = win ? (kp >= 0 && kp < SEQ && dq <= 128) : true;
      }
#pragma unroll
    for (int hh = 0; hh < 4; ++hh) {
      f32x4 st[2];
#pragma unroll
      for (int tt = 0; tt < 2; ++tt) { f32x4 z = {0.f, 0.f, 0.f, 0.f}; z = mfma16(Kf[tt][0], Qf[hh][0], z); z = mfma16(Kf[tt][1], Qf[hh][1], z); st[tt] = z; }
      float mx = -3.0e38f;
#pragma unroll
      for (int tt = 0; tt < 2; ++tt)
#pragma unroll
        for (int j = 0; j < 4; ++j) { const float sv = valid[tt][j] ? st[tt][j] : -1e30f; st[tt][j] = sv; mx = fmaxf(mx, sv); }
      mx = fmaxf(mx, shx(mx, 16, lane)); mx = fmaxf(mx, shx(mx, 32, lane));
      const float mnew = fmaxf(m[hh], mx);
      const float alpha = __expf(m[hh] - mnew); m[hh] = mnew;
      float ps = 0.f; float pv[2][4];
#pragma unroll
      for (int tt = 0; tt < 2; ++tt)
#pragma unroll
        for (int j = 0; j < 4; ++j) { const float e = __expf(st[tt][j] - mnew); pv[tt][j] = e; ps += e; }
      lsum[hh] = lsum[hh] * alpha + ps;
      union { unsigned u[4]; bf16x8 v; } Pf;
      Pf.u[0] = pk_bf16(pv[0][0], pv[0][1]); Pf.u[1] = pk_bf16(pv[0][2], pv[0][3]);
      Pf.u[2] = pk_bf16(pv[1][0], pv[1][1]); Pf.u[3] = pk_bf16(pv[1][2], pv[1][3]);
#pragma unroll
      for (int dt = 0; dt < 4; ++dt) {
        f32x4 o = O[hh][dt]; o[0] *= alpha; o[1] *= alpha; o[2] *= alpha; o[3] *= alpha;
        O[hh][dt] = mfma16(Vf[dt], Pf.v, o);
      }
    }
  };
  if (!isctx) {
    attn_stage(QK, PT, Ks, Vs, tid, kvh, rowbase, q0b - 128, 400, SEQ);
    __syncthreads();
#pragma unroll 1
    for (int ci = 0; ci < 9; ++ci) chunk(16 * wave + 32 * ci, q0 - 128 + 32 * ci, true);
    __syncthreads();
  }
  attn_stage(QK, PT, Ks, Vs, tid, kvh, ctxbase, 0, 256, CTXL);
  __syncthreads();
#pragma unroll 1
  for (int ci = 0; ci < 8; ++ci) chunk(32 * ci, 32 * ci, false);
#pragma unroll
  for (int hh = 0; hh < 4; ++hh) {
    float ls = lsum[hh]; ls += shx(ls, 16, lane); ls += shx(ls, 32, lane);
    const float sink = p.in[27][l * 8 + kvh * 4 + hh];
    const float inv = 1.f / (ls + __expf(sink - m[hh]));
#pragma unroll
    for (int dt = 0; dt < 4; ++dt) {
      uint2 o; o.x = pk_bf16(O[hh][dt][0] * inv, O[hh][dt][1] * inv); o.y = pk_bf16(O[hh][dt][2] * inv, O[hh][dt][3] * inv);
      *(uint2*)(YC + (size_t)qrow * D + 512 + (kvh * 4 + hh) * 64 + 16 * dt + 4 * g) = o;
    }
  }
  __syncthreads();
}

DEVI void lru_item(const Params& p, int l, int item, int pass) {
  const u16* PT = (const u16*)(p.ws + OFF_PT); u16* YC = (u16*)(p.ws + OFF_H);
  float2* SUMM = (float2*)(p.ws + OFF_SUMM);
  const int ch = item >> 2, n = item & 3;
  const int isctx = ch >= 256;
  int b, tq; if (!isctx) { b = ch >> 5; tq = ch & 31; } else { b = (ch - 256) >> 1; tq = (ch - 256) & 1; }
  const int Lseq = isctx ? CTXL : SEQ, rowbase = isctx ? TL + b * CTXL : b * SEQ, t0 = tq * 128;
  float* xs = (float*)smem;
  float* gs = xs + 64 * 145;
  float* ul = gs + 64 * 145;
  float* sm = ul + 128 * 64;
  float* hc = sm + 2 * 8 * 64 * 2;
  const int tid = otid(), e = tid & 63, tg = tid >> 6, c = n * 64 + e;
  for (int idx = tid; idx < 64 * 18; idx += NTHREADS) {
    const int chn = idx / 18, ck = idx % 18, t = t0 - 8 + ck * 8;
    const bool ok = (t >= 0 && t < Lseq);
    bf16x8 v = {0, 0, 0, 0, 0, 0, 0, 0};
    if (ok) v = *(const bf16x8*)(PT + (size_t)(n * 64 + chn) * T + rowbase + t);
#pragma unroll
    for (int q = 0; q < 8; ++q) xs[chn * 145 + ck * 8 + q] = bf2f((u16)v[q]);
    if (pass) {
      bf16x8 v2 = {0, 0, 0, 0, 0, 0, 0, 0};
      if (ok) v2 = *(const bf16x8*)(PT + (size_t)(256 + n * 64 + chn) * T + rowbase + t);
#pragma unroll
      for (int q = 0; q < 8; ++q) gs[chn * 145 + ck * 8 + q] = bf2f((u16)v2[q]);
    }
  }
  if (pass && tid < 128) {
    const int d = tid >> 6, cc = n * 64 + (tid & 63);
    const float2* S = SUMM + (size_t)d * 272 * 256 + cc;
    float h = 0.f;
    const int c0i = 256 + b * 2, l0i = b * 32;
    if (d == 0) {
      if (isctx) { for (int j = 0; j < tq; ++j) { const float2 s = S[(size_t)(c0i + j) * 256]; h = s.x * h + s.y; } }
      else {
        { const float2 s = S[(size_t)(c0i + 0) * 256]; h = s.x * h + s.y; }
        { const float2 s = S[(size_t)(c0i + 1) * 256]; h = s.x * h + s.y; }
        for (int q = 0; q < tq; ++q) { const float2 s = S[(size_t)(l0i + q) * 256]; h = s.x * h + s.y; }
      }
    } else {
      if (isctx) { for (int j = 1; j > tq; --j) { const float2 s = S[(size_t)(c0i + j) * 256]; h = s.x * h + s.y; } }
      else {
        { const float2 s = S[(size_t)(c0i + 1) * 256]; h = s.x * h + s.y; }
        { const float2 s = S[(size_t)(c0i + 0) * 256]; h = s.x * h + s.y; }
        for (int q = 31; q > tq; --q) { const float2 s = S[(size_t)(l0i + q) * 256]; h = s.x * h + s.y; }
      }
    }
    hc[tid] = h;
  }
  __syncthreads();
  float uo[16];
  { const float* cw = p.in[11] + (size_t)l * 4 * 256 + c;
    const float w0 = cw[0], w1 = cw[256], w2 = cw[512], w3 = cw[768], cb = p.in[12][l * 256 + c];
    const float* xr = xs + e * 145 + 8 + 16 * tg;
#pragma unroll
    for (int tt = 0; tt < 16; ++tt) { const float u = cb + w0 * xr[tt - 2] + w1 * xr[tt - 1] + w2 * xr[tt] + w3 * xr[tt + 1]; uo[tt] = u; ul[(16 * tg + tt) * 64 + e] = u; } }
  __syncthreads();
  float av[2][16], bv[2][16];
#pragma unroll
  for (int d = 0; d < 2; ++d) {
    const float* WA = p.in[13] + (size_t)(((l * 2 + d) * 4 + n) * 64) * 64 + e;
    const float* WX = p.in[15] + (size_t)(((l * 2 + d) * 4 + n) * 64) * 64 + e;
    float accr[16], acci[16];
    { const float ba = p.in[14][(l * 2 + d) * 256 + c], bx = p.in[16][(l * 2 + d) * 256 + c];
#pragma unroll
      for (int tt = 0; tt < 16; ++tt) { accr[tt] = ba; acci[tt] = bx; } }
    for (int k4 = 0; k4 < 16; ++k4) {
      const float wa0 = WA[(4 * k4 + 0) * 64], wa1 = WA[(4 * k4 + 1) * 64], wa2 = WA[(4 * k4 + 2) * 64], wa3 = WA[(4 * k4 + 3) * 64];
      const float wx0 = WX[(4 * k4 + 0) * 64], wx1 = WX[(4 * k4 + 1) * 64], wx2 = WX[(4 * k4 + 2) * 64], wx3 = WX[(4 * k4 + 3) * 64];
#pragma unroll
      for (int tt = 0; tt < 16; ++tt) {
        const float4 uu = *(const float4*)(ul + (16 * tg + tt) * 64 + 4 * k4);
        accr[tt] += uu.x * wa0 + uu.y * wa1 + uu.z * wa2 + uu.w * wa3;
        acci[tt] += uu.x * wx0 + uu.y * wx1 + uu.z * wx2 + uu.w * wx3;
      }
    }
    const float lam = p.in[17][(l * 2 + d) * 256 + c];
    const float ex = __expf(-lam); const float sp = ex * (1.f - ex * (0.5f - ex * (0.33333334f - 0.25f * ex)));
    float Ap = 1.f, Bp = 0.f;
#pragma unroll
    for (int q = 0; q < 16; ++q) {
      const int tt = d == 0 ? q : 15 - q;
      const float r = sigmoidf_(accr[tt]), ig = sigmoidf_(acci[tt]);
      const float la = -8.f * r * sp;
      const float a = __expf(la);
      const float y2 = 2.f * la;
      const float om = y2 > -0.1f ? -y2 * (1.f + y2 * (0.5f + y2 * (0.16666667f + y2 * (0.041666668f + y2 * 0.008333334f)))) : 1.f - __expf(y2);
      const float bb = sqrtf(om) * (ig * uo[tt]);
      av[d][tt] = a; bv[d][tt] = bb;
      Bp = a * Bp + bb; Ap *= a;
    }
    sm[((d * 8 + tg) * 64 + e) * 2 + 0] = Ap; sm[((d * 8 + tg) * 64 + e) * 2 + 1] = Bp;
  }
  __syncthreads();
  if (!pass) {
    if (tid < 128) {
      const int d = tid >> 6, ee = tid & 63;
      float A = 1.f, Bc = 0.f;
      if (d == 0) { for (int g2 = 0; g2 < 8; ++g2) { const float a = sm[((0 * 8 + g2) * 64 + ee) * 2], bq = sm[((0 * 8 + g2) * 64 + ee) * 2 + 1]; Bc = a * Bc + bq; A *= a; } }
      else { for (int g2 = 7; g2 >= 0; --g2) { const float a = sm[((1 * 8 + g2) * 64 + ee) * 2], bq = sm[((1 * 8 + g2) * 64 + ee) * 2 + 1]; Bc = a * Bc + bq; A *= a; } }
      SUMM[((size_t)d * 272 + ch) * 256 + n * 64 + ee] = make_float2(A, Bc);
    }
  } else {
    float hs[16];
    { float h = hc[e];
      for (int g2 = 0; g2 < tg; ++g2) { const float a = sm[((0 * 8 + g2) * 64 + e) * 2], bq = sm[((0 * 8 + g2) * 64 + e) * 2 + 1]; h = a * h + bq; }
#pragma unroll
      for (int tt = 0; tt < 16; ++tt) { h = av[0][tt] * h + bv[0][tt]; hs[tt] = h; } }
    { float h = hc[64 + e];
      for (int g2 = 7; g2 > tg; --g2) { const float a = sm[((1 * 8 + g2) * 64 + e) * 2], bq = sm[((1 * 8 + g2) * 64 + e) * 2 + 1]; h = a * h + bq; }
#pragma unroll
      for (int tt = 15; tt >= 0; --tt) { h = av[1][tt] * h + bv[1][tt]; hs[tt] += h; } }
    const float* gr = gs + e * 145 + 8 + 16 * tg;
#pragma unroll
    for (int tt = 0; tt < 16; ++tt) {
      const float y = hs[tt] * gelu_tanh(gr[tt]);
      YC[(size_t)(rowbase + t0 + 16 * tg + tt) * D + c] = f2bf(y);
    }
  }
  __syncthreads();
}

DEVI void uprep_phase(const Params& p, int l) {
  const u16* PT = (const u16*)(p.ws + OFF_PT); u16* UT = (u16*)(p.ws + OFF_UT); u16* X0T = (u16*)(p.ws + OFF_X0T);
  constexpr int NCH = T / 8;
  for (int idx = blockIdx.x * NTHREADS + otid(); idx < 256 * NCH; idx += gridDim.x * NTHREADS) {
    const int c = idx / NCH, ck = idx % NCH, row = ck * 8;
    int t, Lseq; if (row < TL) { t = row & 4095; Lseq = SEQ; } else { t = (row - TL) & 255; Lseq = CTXL; }
    float o[3][8];
#pragma unroll
    for (int k = 0; k < 3; ++k) {
      const int col = k * 256 + c;
      const u16* src = PT + (size_t)(512 + col) * T + row;
      const bf16x8 v = *(const bf16x8*)src;
      float x[10];
      x[0] = t > 0 ? bf2f(src[-1]) : 0.f;
      x[9] = (t + 8 < Lseq) ? bf2f(src[8]) : 0.f;
#pragma unroll
      for (int q = 0; q < 8; ++q) x[q + 1] = bf2f((u16)v[q]);
      const float w0 = p.in[18][(l * 3 + 0) * 768 + col], w1 = p.in[18][(l * 3 + 1) * 768 + col], w2 = p.in[18][(l * 3 + 2) * 768 + col], bb = p.in[19][l * 768 + col];
#pragma unroll
      for (int q = 0; q < 8; ++q) o[k][q] = bb + w0 * x[q] + w1 * x[q + 1] + w2 * x[q + 2];
    }
    uint4 uo, xo;
    uo.x = pk_bf16(o[1][0] * o[2][0], o[1][1] * o[2][1]); uo.y = pk_bf16(o[1][2] * o[2][2], o[1][3] * o[2][3]);
    uo.z = pk_bf16(o[1][4] * o[2][4], o[1][5] * o[2][5]); uo.w = pk_bf16(o[1][6] * o[2][6], o[1][7] * o[2][7]);
    xo.x = pk_bf16(o[0][0], o[0][1]); xo.y = pk_bf16(o[0][2], o[0][3]); xo.z = pk_bf16(o[0][4], o[0][5]); xo.w = pk_bf16(o[0][6], o[0][7]);
    *(uint4*)(UT + (size_t)c * T + row) = uo;
    *(uint4*)(X0T + (size_t)c * T + row) = xo;
  }
}

DEVI bf16x8 ld_frag8(const u16* a) { union { uint2 u[2]; bf16x8 v; } f; f.u[0] = *(const uint2*)a; f.u[1] = *(const uint2*)(a + 4); return f.v; }
DEVI void toep_item(const Params& p, int l, int c, int isctx) {
  const int L = isctx ? CTXL : SEQ;
  const u16* KF = isctx ? (const u16*)(p.ws + OFF_KFC) + (size_t)c * 512 : (const u16*)(p.ws + OFF_KF) + (size_t)(l * 256 + c) * 8192;
  u16* R = (u16*)smem; const int CS = 2 * L + 8;
  u16* Us = R + 4 * CS; const int USTR = L + 8;
  const int tid = otid(), wave = tid >> 6, lane = tid & 63, fr = lane & 15, g = lane >> 4;
  const u16* Uc = (const u16*)(p.ws + OFF_UT) + (size_t)c * T;
  const u16* X0c = (const u16*)(p.ws + OFF_X0T) + (size_t)c * T;
  for (int q = tid; q < (2 * L) / 8; q += NTHREADS) {
    const bf16x8 v = *(const bf16x8*)(KF + 8 * q);
#pragma unroll
    for (int mm = 0; mm < 4; ++mm)
#pragma unroll
      for (int e = 0; e < 8; ++e) R[mm * CS + 8 * q + e + mm] = (u16)v[e];
  }
  if (tid < 32) { const int mm = tid >> 3, e = tid & 7; if (e < mm) R[mm * CS + e] = 0; else R[mm * CS + 2 * L + e] = 0; }
  for (int q = tid; q < L; q += NTHREADS) {
    const int bb = q / (L / 8), ck = q % (L / 8);
    const size_t row = (isctx ? (size_t)TL + (size_t)bb * CTXL : (size_t)bb * SEQ) + ck * 8;
    *(uint4*)(Us + bb * USTR + ck * 8) = *(const uint4*)(Uc + row);
  }
  __syncthreads();
  u16* YC = (u16*)(p.ws + OFF_H);
  const float skip = p.in[26][l * 256 + c];
  const int nT = L / 128;
  const int mcp = fr & 3;
  const u16* Rl = R + mcp * CS + (L + 8 * g - (fr - mcp));
  const u16* Ul = Us + (fr & 7) * USTR + 8 * g;
  const size_t urow = isctx ? (size_t)TL + (size_t)(fr & 7) * CTXL : (size_t)(fr & 7) * SEQ;
  for (int wt = wave; wt < nT; wt += 8) {
    const int T0 = wt * 128;
    f32x4 acc[8];
#pragma unroll
    for (int m8 = 0; m8 < 8; ++m8) acc[m8] = (f32x4){0.f, 0.f, 0.f, 0.f};
    bf16x8 F[8];
#pragma unroll
    for (int m8 = 2; m8 < 8; ++m8) F[m8] = ld_frag8(Rl + (0 - T0 - 16 * m8));
#pragma unroll 1
    for (int s0 = 0; s0 < L; s0 += 128) {
#pragma unroll
      for (int k = 0; k < 4; ++k) {
        const int s = s0 + 32 * k;
        const bf16x8 Bf = *(const bf16x8*)(Ul + s);
        F[(8 - 2 * k) & 7] = ld_frag8(Rl + (s - T0));
        F[(9 - 2 * k) & 7] = ld_frag8(Rl + (s - T0 - 16));
#pragma unroll
        for (int m8 = 0; m8 < 8; ++m8) acc[m8] = mfma16(F[(m8 + 8 - 2 * k) & 7], Bf, acc[m8]);
      }
    }
    if (fr < 8) {
#pragma unroll
      for (int m8 = 0; m8 < 8; ++m8) {
        const size_t row = urow + T0 + 16 * m8 + 4 * g;
        const bf16x4 u4 = *(const bf16x4*)(Us + fr * USTR + T0 + 16 * m8 + 4 * g), x4 = *(const bf16x4*)(X0c + row);
#pragma unroll
        for (int j = 0; j < 4; ++j) {
          const float y = bf2f((u16)x4[j]) * (acc[m8][j] + skip * bf2f((u16)u4[j]));
          YC[(row + j) * D + 256 + c] = f2bf(y);
        }
      }
    }
  }
  __syncthreads();
}

#ifndef PROBE
#define PROBE -1
#endif
#define PHASE(id, ...) do { { const float rcf = 1.f; (void)rcf; __VA_ARGS__ } grid.sync(); if (PROBE == (id)) { { const float rcf = 0.f; (void)rcf; __VA_ARGS__ } grid.sync(); } } while (0)
__global__ void __launch_bounds__(NTHREADS) mega(Params p_in) {
  cg::grid_group grid = cg::this_grid();
  Params p = p_in;
  p.wv = __builtin_amdgcn_readfirstlane((int)(threadIdx.x >> 6));
  PHASE(0, phase0(p););
#pragma unroll 1
  for (int l = 0; l < 2; ++l) {
    const int Mpost = l == 0 ? T : TL;
    PHASE(1, norm_phase(p, l, 0, T, l == 0););
    PHASE(2, { EpiAct e{(u16*)(p.ws + OFF_BIG)};
      gemm_phase(p, (const u16*)(p.ws + OFF_H), (const u16*)(p.ws + OFF_W1T) + (size_t)(l * 2 + 0) * 5632 * 1024, T, 2 * DFF, D, e); });
    PHASE(3, { float* X = (float*)(p.ws + OFF_X);
      EpiRes e{(l == 0 && rcf != 0.f) ? p.in[0] : X, (l == 0 && rcf != 0.f) ? p.in[2] : X + (size_t)TL * D, X, (const float*)(p.ws + OFF_MOD) + (size_t)l * 9 * 9216, 2, 0.5f * rcf};
      gemm_phase(p, (const u16*)(p.ws + OFF_BIG), (const u16*)(p.ws + OFF_W2T) + (size_t)(l * 2 + 0) * 1024 * 2816, T, D, DFF, e); });
    PHASE(1, norm_phase(p, l, 1, T, false););
    PHASE(4, { EpiProj e{(u16*)(p.ws + OFF_PT), (u16*)(p.ws + OFF_QK), (const float*)(p.ws + OFF_ROPE), (const float*)(p.ws + OFF_ROPE) + 4096 * 32};
      gemm_phase(p, (const u16*)(p.ws + OFF_H), (const u16*)(p.ws + OFF_WINT) + (size_t)l * 2048 * 1024, T, DIN, D, e); });
    PHASE(5, { const int n_att = l == 0 ? 512 + 32 : 512, n_lru = 1088;
      for (int it = blockIdx.x; it < n_att + n_lru; it += gridDim.x) { if (it < n_att) attn_item(p, l, it); else lru_item(p, l, it - n_att, 0); }
      uprep_phase(p, l); });
    PHASE(6, { const int n_t1 = 256, n_t2 = l == 0 ? 256 : 0, n_lru = l == 0 ? 1088 : 1024;
      for (int it = blockIdx.x; it < n_t1 + n_t2 + n_lru; it += gridDim.x) {
        if (it < n_t1) toep_item(p, l, it, 0);
        else if (it < n_t1 + n_t2) toep_item(p, l, it - n_t1, 1);
        else lru_item(p, l, it - n_t1 - n_t2, 1);
      } });
    PHASE(7, { float* X = (float*)(p.ws + OFF_X);
      EpiRes e{X, X + (size_t)TL * D, X, (const float*)(p.ws + OFF_MOD) + (size_t)l * 9 * 9216, 5, 1.0f * rcf};
      gemm_phase(p, (const u16*)(p.ws + OFF_H), (const u16*)(p.ws + OFF_WOT) + (size_t)l * 1024 * 1024, Mpost, D, D, e); });
    PHASE(1, norm_phase(p, l, 2, Mpost, false););
    PHASE(2, { EpiAct e{(u16*)(p.ws + OFF_BIG)};
      gemm_phase(p, (const u16*)(p.ws + OFF_H), (const u16*)(p.ws + OFF_W1T) + (size_t)(l * 2 + 1) * 5632 * 1024, Mpost, 2 * DFF, D, e); });
    PHASE(3, { float* X = (float*)(p.ws + OFF_X);
      EpiRes e{X, X + (size_t)TL * D, X, (const float*)(p.ws + OFF_MOD) + (size_t)l * 9 * 9216, 8, 0.5f * rcf};
      gemm_phase(p, (const u16*)(p.ws + OFF_BIG), (const u16*)(p.ws + OFF_W2T) + (size_t)(l * 2 + 1) * 1024 * 2816, Mpost, D, DFF, e); });
  }
  final_norm_phase(p);
}

extern "C" void kernel_launch(void* const* d_in, const int* in_sizes, int n_in, void* d_out, int out_size, void* d_ws, size_t ws_size, hipStream_t stream) {
  static int grid_blocks = 0;
  if (!grid_blocks) {
    if (ws_size < WS_END || n_in != 29) { fprintf(stderr, "kernel_launch: workspace %zu < %zu or n_in %d != 29\n", ws_size, (size_t)WS_END, n_in); grid_blocks = -1; return; }
    int dev = 0, cus = 0, per_cu = 0;
    hipGetDevice(&dev);
    hipDeviceGetAttribute(&cus, hipDeviceAttributeMultiprocessorCount, dev);
    if (hipFuncSetAttribute((const void*)mega, hipFuncAttributeMaxDynamicSharedMemorySize, LDS_BYTES) != hipSuccess) { fprintf(stderr, "hipFuncSetAttribute failed\n"); }
    hipOccupancyMaxActiveBlocksPerMultiprocessor(&per_cu, (const void*)mega, NTHREADS, LDS_BYTES);
    if (per_cu < 1) { fprintf(stderr, "occupancy query returned %d\n", per_cu); per_cu = 1; }
    if (per_cu > 1) per_cu = 1;
    grid_blocks = cus * per_cu;
    (void)hipGetLastError();
  }
  if (grid_blocks < 0) return;
  Params p{};
  for (int i = 0; i < 29; ++i) p.in[i] = (const float*)d_in[i];
  p.out = (float*)d_out; p.ws = (unsigned char*)d_ws;
  void* args[] = {&p};
  hipError_t e = hipLaunchCooperativeKernel((void*)mega, dim3(grid_blocks), dim3(NTHREADS), args, LDS_BYTES, stream);
  if (e != hipSuccess) fprintf(stderr, "cooperative launch failed: %s (grid %d)\n", hipGetErrorString(e), grid_blocks);
}
```

```cpp
#include <hip/hip_runtime.h>
#include <hip/hip_cooperative_groups.h>
#include <cstdio>
namespace cg = cooperative_groups;

using bf16x8 = __attribute__((ext_vector_type(8))) short;
using bf16x4 = __attribute__((ext_vector_type(4))) short;
using f32x4  = __attribute__((ext_vector_type(4))) float;
typedef unsigned short u16;
#define DEVI __device__ __forceinline__

constexpr int D = 1024, NB = 8, SEQ = 4096, CTXL = 256, TL = NB * SEQ, TC = NB * CTXL, T = TL + TC;
constexpr int DFF = 2816, DIN = 2048;
constexpr int NTHREADS = 512;
constexpr int LDS_BYTES = 163840;

constexpr size_t OFF_X    = 0;
constexpr size_t OFF_H    = OFF_X + (size_t)T * D * 4;
constexpr size_t OFF_BIG  = OFF_H + (size_t)T * D * 2;
constexpr size_t OFF_PT   = OFF_BIG;
constexpr size_t OFF_QK   = OFF_PT + (size_t)1408 * T * 2;
constexpr size_t OFF_UT   = OFF_QK + (size_t)T * 640 * 2;
constexpr size_t OFF_X0T  = OFF_UT + (size_t)256 * T * 2;
constexpr size_t OFF_SUMM = OFF_X0T + (size_t)256 * T * 2;
constexpr size_t OFF_W1T  = OFF_BIG + (size_t)T * DFF * 2;
constexpr size_t OFF_W2T  = OFF_W1T + (size_t)4 * 5632 * 1024 * 2;
constexpr size_t OFF_WINT = OFF_W2T + (size_t)4 * 1024 * 2816 * 2;
constexpr size_t OFF_WOT  = OFF_WINT + (size_t)2 * 2048 * 1024 * 2;
constexpr size_t OFF_MOD  = OFF_WOT + (size_t)2 * 1024 * 1024 * 2;
constexpr size_t OFF_KF   = OFF_MOD + (size_t)2 * 9 * 9216 * 4;
constexpr size_t OFF_KFC  = OFF_KF + (size_t)2 * 256 * 8192 * 2;
constexpr size_t OFF_ROPE = OFF_KFC + (size_t)256 * 512 * 2;
constexpr size_t OFF_WGT  = OFF_ROPE + (size_t)2 * 4096 * 32 * 4;
constexpr size_t WS_END   = OFF_WGT + (size_t)2 * 2 * 2 * 4 * 64 * 64 * 2;
static_assert(OFF_SUMM + 2 * 272 * 256 * 8 <= OFF_W1T, "mixer buffers overflow ACT region");

struct Params {
  const float* in[29];
  float* out;
  unsigned char* ws;
  int wv, pad_;
};

extern __shared__ __attribute__((aligned(16))) unsigned char smem[];

DEVI unsigned pk_bf16(float lo, float hi) { unsigned r; asm volatile("v_cvt_pk_bf16_f32 %0, %1, %2" : "=v"(r) : "v"(lo), "v"(hi)); return r; }
DEVI u16 f2bf(float x) { return (u16)(pk_bf16(x, 0.f) & 0xffffu); }
DEVI float bf2f(u16 h) { return __uint_as_float(((unsigned)h) << 16); }
DEVI float sigmoidf_(float x) { return 1.f / (1.f + __expf(-x)); }
DEVI float gelu_tanh(float x) { float z = 0.7978845608028654f * (x + 0.044715f * x * x * x); float th = 1.f - 2.f / (1.f + __expf(2.f * z)); return 0.5f * x * (1.f + th); }
template <class Tp> DEVI const Tp* opaque(const Tp* q) { asm volatile("" : "+s"(q)); return q; }
DEVI int otid_(int wv) { int t = (wv << 6) | (int)__builtin_amdgcn_mbcnt_hi(~0u, __builtin_amdgcn_mbcnt_lo(~0u, 0u)); asm volatile("" : "+v"(t)); return t; }
#define otid() otid_(p.wv)
DEVI float shx(float v, int o, int lane) { return __int_as_float(__builtin_amdgcn_ds_bpermute((lane ^ o) << 2, __float_as_int(v))); }
DEVI f32x4 mfma16(bf16x8 a, bf16x8 b, f32x4 c) { return __builtin_amdgcn_mfma_f32_16x16x32_bf16(a, b, c, 0, 0, 0); }

constexpr int BM = 256, BK = 64, HALF = 128, HT = HALF * BK;
DEVI int lds_byte(int r, int c) { int st = (r >> 4) * 2 + (c >> 5), rr = r & 15, cc = c & 31, ob = rr * 64 + cc * 2; return st * 1024 + (ob ^ (((ob >> 9) & 1) << 5)); }
DEVI void stage_rc(int b, int& R, int& C) { int st = b / 1024, sb = b % 1024, swz = sb ^ (((sb >> 9) & 1) << 5); R = (st >> 1) * 16 + swz / 64; C = (st & 1) * 32 + (swz % 64) / 2; }

DEVI bool tile_next(int i, int nM, int nN, int& pm, int& pn) {
  const int nwg = nM * nN; const long Lx = (long)i * gridDim.x + blockIdx.x; if (Lx >= nwg) return false;
  int wgid = (int)Lx; { const int q = nwg / 8, r = nwg % 8, xcd = wgid % 8, off = wgid / 8; wgid = (xcd < r ? xcd * (q + 1) : r * (q + 1) + (xcd - r) * q) + off; }
  const int nig = 8 * nN, gid = wgid / nig, fm = gid * 8, gsz = (nM - fm) < 8 ? (nM - fm) : 8;
  pm = fm + ((wgid % nig) % gsz); pn = (wgid % nig) / gsz; return true;
}
template <class Epi>
DEVI void gemm_phase(const Params& p, const u16* __restrict__ A, const u16* __restrict__ Bt, const int M, const int N, const int K, const Epi& epi) {
  u16* shm = (u16*)smem;
#define SA(b, h) (shm + ((b) * 2 + (h)) * HT)
#define SB(b, h) (shm + (4 + (b) * 2 + (h)) * HT)
#define STAGE(P, BASE, br, kt) do { const char* _ub = (const char*)(BASE + (long)(br) * K + (long)(kt) * BK); \
      __builtin_amdgcn_global_load_lds((const unsigned*)(_ub + soff0), (unsigned*)((char*)(P) + tid * 16), 16, 0, 0); \
      __builtin_amdgcn_global_load_lds((const unsigned*)(_ub + soff1), (unsigned*)((char*)(P) + tid * 16 + 8192), 16, 0, 0); } while (0)
#define LDA(dst, b, h) for (int m = 0; m < 4; ++m) for (int k = 0; k < 2; ++k) \
    dst[m][k] = *reinterpret_cast<const bf16x8*>((char*)SA(b, h) + lds_byte(wr * 64 + m * 16 + fr, k * 32 + fq * 8))
#define LDB(dst, b, h) for (int n = 0; n < 2; ++n) for (int k = 0; k < 2; ++k) \
    dst[n][k] = *reinterpret_cast<const bf16x8*>((char*)SB(b, h) + lds_byte(wc * 32 + n * 16 + fr, k * 32 + fq * 8))
#define MMA(ai, bj, At_, Bt_) do { __builtin_amdgcn_s_setprio(1); \
    for (int m = 0; m < 4; ++m) for (int n = 0; n < 2; ++n) for (int k = 0; k < 2; ++k) \
      acc[ai][bj][m][n] = Epi::TR ? __builtin_amdgcn_mfma_f32_16x16x32_bf16(Bt_[n][k], At_[m][k], acc[ai][bj][m][n], 0, 0, 0) \
                                  : __builtin_amdgcn_mfma_f32_16x16x32_bf16(At_[m][k], Bt_[n][k], acc[ai][bj][m][n], 0, 0, 0); \
    __builtin_amdgcn_s_setprio(0); } while (0)
#define WAIT_V(n) asm volatile("s_waitcnt vmcnt(" #n ")" ::: "memory")
#define WAIT_L(n) asm volatile("s_waitcnt lgkmcnt(" #n ")" ::: "memory")
#define BAR __builtin_amdgcn_s_barrier()
#define SCHED __builtin_amdgcn_sched_barrier(0)
#define PROLOGUE_ISSUE(brow_, bcol_) do { \
    STAGE(SB(0, 0), Bt, bcol_, 0); STAGE(SA(0, 0), A, brow_, 0); STAGE(SB(0, 1), Bt, (bcol_) + HALF, 0); STAGE(SA(0, 1), A, (brow_) + HALF, 0); \
    STAGE(SB(1, 0), Bt, bcol_, 1); STAGE(SA(1, 0), A, brow_, 1); STAGE(SB(1, 1), Bt, (bcol_) + HALF, 1); } while (0)
  const int tid = otid();
  const int wid = tid >> 6, lane = tid & 63, wr = wid >> 2, wc = wid & 3, fr = lane & 15, fq = lane >> 4;
  unsigned soff0, soff1;
  { int r_, c_; stage_rc(tid * 16, r_, c_); soff0 = (unsigned)(r_ * K + c_) * 2u; stage_rc(tid * 16 + 8192, r_, c_); soff1 = (unsigned)(r_ * K + c_) * 2u; }
  const int nM = M / BM, nN = N / BM, nt = K / BK;
  int pm, pn;
  bool have = tile_next(0, nM, nN, pm, pn);
  if (have) PROLOGUE_ISSUE(pm * BM, pn * BM);
#pragma unroll 1
  for (int it = 0; have; ++it) {
    const int brow = pm * BM, bcol = pn * BM;
    f32x4 acc[2][2][4][2] = {};
    bf16x8 At[4][2], B0[2][2], B1[2][2];
    WAIT_V(0);
    if (wr == 1) BAR;
    BAR;
    BAR;
    for (int t = 0; t < nt - 2; t += 2) {
      LDB(B0, 0, 0); SCHED; LDA(At, 0, 0); STAGE(SA(1, 1), A, brow + HALF, t + 1);
      WAIT_L(8); BAR; WAIT_L(0); MMA(0, 0, At, B0); BAR; SCHED;
      LDB(B1, 0, 1); STAGE(SB(0, 0), Bt, bcol, t + 2);
      BAR; WAIT_L(0); MMA(0, 1, At, B1); BAR;
      LDA(At, 0, 1); STAGE(SA(0, 0), A, brow, t + 2);
      BAR; WAIT_L(0); MMA(1, 0, At, B0); BAR; SCHED;
      STAGE(SB(0, 1), Bt, bcol + HALF, t + 2);
      WAIT_V(6); BAR; MMA(1, 1, At, B1); BAR;
      LDB(B0, 1, 0); SCHED; LDA(At, 1, 0); STAGE(SA(0, 1), A, brow + HALF, t + 2);
      WAIT_L(8); BAR; WAIT_L(0); MMA(0, 0, At, B0); BAR; SCHED;
      LDB(B1, 1, 1); STAGE(SB(1, 0), Bt, bcol, t + 3);
      BAR; WAIT_L(0); MMA(0, 1, At, B1); BAR;
      LDA(At, 1, 1); STAGE(SA(1, 0), A, brow, t + 3);
      BAR; WAIT_L(0); MMA(1, 0, At, B0); BAR; SCHED;
      STAGE(SB(1, 1), Bt, bcol + HALF, t + 3);
      WAIT_V(6); BAR; MMA(1, 1, At, B1); BAR;
    }
    { LDB(B0, 0, 0); LDA(At, 0, 0); STAGE(SA(1, 1), A, brow + HALF, nt - 1);
      BAR; WAIT_L(0); MMA(0, 0, At, B0); BAR;
      LDB(B1, 0, 1); BAR; WAIT_L(0); MMA(0, 1, At, B1); BAR;
      LDA(At, 0, 1); WAIT_V(4); BAR; WAIT_L(0); MMA(1, 0, At, B0); MMA(1, 1, At, B1); BAR; }
    { LDB(B0, 1, 0); LDA(At, 1, 0); WAIT_V(2); BAR; WAIT_L(0); MMA(0, 0, At, B0); BAR;
      LDB(B1, 1, 1); WAIT_V(0); BAR; WAIT_L(0); MMA(0, 1, At, B1); BAR;
      LDA(At, 1, 1); BAR; WAIT_L(0); MMA(1, 0, At, B0); MMA(1, 1, At, B1); BAR; }
    if (wr == 0) BAR;
    have = tile_next(it + 1, nM, nN, pm, pn);
    if (have) PROLOGUE_ISSUE(pm * BM, pn * BM);
    { const int tid2 = otid(), wid2 = tid2 >> 6, lane2 = tid2 & 63, wr2 = wid2 >> 2, wc2 = wid2 & 3, fr2 = lane2 & 15, fq2 = lane2 >> 4;
#pragma unroll
      for (int ai = 0; ai < 2; ++ai)
#pragma unroll
        for (int bj = 0; bj < 2; ++bj)
#pragma unroll
          for (int m = 0; m < 4; ++m) {
            const int colb = bcol + bj * HALF + wc2 * 32;
            if (Epi::TR) epi(brow + ai * HALF + wr2 * 64 + m * 16 + fr2, colb, fq2, acc[ai][bj][m][0], acc[ai][bj][m][1]);
            else epi(brow + ai * HALF + wr2 * 64 + m * 16 + fq2 * 4, colb, fr2, acc[ai][bj][m][0], acc[ai][bj][m][1]);
          } }
  }
  __syncthreads();
#undef SA
#undef SB
#undef STAGE
#undef LDA
#undef LDB
#undef MMA
#undef PROLOGUE_ISSUE
}

struct EpiAct {
  static constexpr bool TR = true;
  u16* act;
  DEVI void operator()(int row, int colb, int fq, const f32x4& a0, const f32x4& a1) const {
    const int oc = (colb >> 5) * 16 + 4 * fq;
    float v[4];
#pragma unroll
    for (int j = 0; j < 4; ++j) { const float a = a0[j]; v[j] = a * sigmoidf_(a) * a1[j]; }
    uint2 o; o.x = pk_bf16(v[0], v[1]); o.y = pk_bf16(v[2], v[3]);
    *(uint2*)(act + (size_t)row * DFF + oc) = o;
  }
};
struct EpiRes {
  static constexpr bool TR = true;
  const float* xin_lat; const float* xin_ctx;
  float* xout; const float* modl;
  int gi; float coef;
  DEVI void operator()(int row, int colb, int fq, const f32x4& a0, const f32x4& a1) const {
    const int r = row < TL ? (row >> 12) : 8;
    const float* gate = modl + (size_t)(r * 9 + gi) * D;
    const float* src = row < TL ? xin_lat + (size_t)row * D : xin_ctx + (size_t)(row - TL) * D;
#pragma unroll
    for (int n = 0; n < 2; ++n) {
      const int col = colb + n * 16 + 4 * fq;
      const f32x4 gv = *(const f32x4*)(gate + col), xi = *(const f32x4*)(src + col);
      const f32x4& a = n ? a1 : a0;
      f32x4 o;
#pragma unroll
      for (int j = 0; j < 4; ++j) o[j] = xi[j] + coef * gv[j] * a[j];
      *(f32x4*)(xout + (size_t)row * D + col) = o;
    }
  }
};
struct EpiProj {
  static constexpr bool TR = false;
  u16* pt; u16* qk; const float* cost; const float* sint;
  DEVI void operator()(int row0, int colb, int fr, const f32x4& a0, const f32x4& a1) const {
    if (colb < 1280 || colb >= 1920) {
#pragma unroll
      for (int n = 0; n < 2; ++n) {
        const int pc = colb + n * 16 + fr; const int ptc = pc < 1280 ? pc : pc - 640;
        const f32x4& a = n ? a1 : a0;
        uint2 o; o.x = pk_bf16(a[0], a[1]); o.y = pk_bf16(a[2], a[3]);
        *(uint2*)(pt + (size_t)ptc * T + row0) = o;
      }
    } else {
      const int off = colb - 1280, head = off >> 6, grp = (off >> 5) & 1, pidx = 16 * grp + fr;
      const int d1 = head * 64 + pidx, d2 = d1 + 32;
      const float qs = head < 8 ? 0.125f : 1.f;
#pragma unroll
      for (int j = 0; j < 4; ++j) {
        const int row = row0 + j; float c = 1.f, s = 0.f;
        if (row < TL) { const int t = row & 4095; c = cost[t * 32 + pidx]; s = sint[t * 32 + pidx]; }
        const float o1 = (a0[j] * c - a1[j] * s) * qs, o2 = (a0[j] * s + a1[j] * c) * qs;
        qk[(size_t)row * 640 + d1] = f2bf(o1); qk[(size_t)row * 640 + d2] = f2bf(o2);
      }
    }
  }
};

DEVI int srccol(int mode, int pn) {
  if (mode == 1) { const int g = pn >> 5, hh = (pn >> 4) & 1, i = pn & 15; return hh * DFF + g * 16 + i; }
  if (mode == 2) { if (pn < 1280 || pn >= 1920) return pn; const int off = pn - 1280, head = off >> 6, w = off & 63, grp = w >> 5, hh = (w >> 4) & 1, i = w & 15; return 1280 + head * 64 + 16 * grp + i + 32 * hh; }
  return pn;
}
DEVI void transpose_item(const Params& p, const float* __restrict__ W, int K, int N, u16* __restrict__ WT, int mode, int item) {
  float* tile = (float*)smem;
  const int tid = otid(), nblk = N / 64, kb = item / nblk, nb = item % nblk, k0 = kb * 64, n0 = nb * 64;
  { const int nn = tid & 63, kr = tid >> 6, src = srccol(mode, n0 + nn);
#pragma unroll
    for (int r = 0; r < 8; ++r) { const int kk = kr + 8 * r; tile[kk * 65 + nn] = W[(size_t)(k0 + kk) * N + src]; } }
  __syncthreads();
  { const int rown = tid >> 3, kc = tid & 7; const float* s = tile + (kc * 8) * 65 + rown;
    uint4 o; o.x = pk_bf16(s[0], s[65]); o.y = pk_bf16(s[130], s[195]); o.z = pk_bf16(s[260], s[325]); o.w = pk_bf16(s[390], s[455]);
    *(uint4*)(WT + (size_t)(n0 + rown) * K + k0 + kc * 8) = o; }
  __syncthreads();
}
DEVI void mod_item(const Params& p, int item) {
  float* sv = (float*)smem;
  float* red = sv + 9 * 1024;
  const int tid = otid(), l = item / 72, n0 = (item % 72) * 128;
  for (int i = tid; i < 9 * 1024; i += NTHREADS) { const int r = i >> 10, k = i & 1023; const float cv = r < 8 ? p.in[1][r * 1024 + k] : p.in[3][k]; sv[i] = cv * sigmoidf_(cv); }
  __syncthreads();
  const int cc = tid & 127, kq = tid >> 7;
  const float* w = p.in[4] + (size_t)l * 1024 * 9216 + n0 + cc;
  float acc[9];
#pragma unroll
  for (int r = 0; r < 9; ++r) acc[r] = 0.f;
#pragma unroll 2
  for (int k4 = 0; k4 < 64; ++k4) {
    const int k = kq * 256 + k4 * 4;
    const float w0 = w[(size_t)k * 9216], w1 = w[(size_t)(k + 1) * 9216], w2 = w[(size_t)(k + 2) * 9216], w3 = w[(size_t)(k + 3) * 9216];
#pragma unroll
    for (int r = 0; r < 9; ++r) { const float4 s4 = *(const float4*)(sv + r * 1024 + k); acc[r] += s4.x * w0 + s4.y * w1 + s4.z * w2 + s4.w * w3; }
  }
#pragma unroll
  for (int r = 0; r < 9; ++r) red[(kq * 9 + r) * 128 + cc] = acc[r];
  __syncthreads();
  float* MOD = (float*)(p.ws + OFF_MOD);
  for (int i = tid; i < 9 * 128; i += NTHREADS) {
    const int r = i >> 7, c2 = i & 127;
    const float v = red[(0 * 9 + r) * 128 + c2] + red[(1 * 9 + r) * 128 + c2] + red[(2 * 9 + r) * 128 + c2] + red[(3 * 9 + r) * 128 + c2] + p.in[5][l * 9216 + n0 + c2];
    MOD[(size_t)(l * 9 + r) * 9216 + n0 + c2] = v;
  }
  __syncthreads();
}
DEVI void filter_item(const Params& p, int l, int L, u16* __restrict__ KF, int posblk) {
  float* zs = (float*)smem;
  float* hb = zs + 8 * 36;
  const int tid = otid(), w = tid >> 6, j = tid & 63, t = posblk * 8 + w;
  const float* fw0 = opaque(p.in[20] + l * 33 * 64); const float* fb0 = opaque(p.in[21] + l * 64);
  const float* fwin = opaque(p.in[22] + l * 2 * 64 * 64); const float* fbin = opaque(p.in[23] + l * 2 * 64);
  const float* freq = opaque(p.in[24] + l * 64); const float* fwl = opaque(p.in[25] + l * 64 * 512);
  const float tn = (float)t / (float)(L - 1);
  if (j < 33) {
    float z;
    if (j == 0) z = tn;
    else { const int bi = (j - 1) & 15; const float f = 1e-4f + (float)bi * ((15.f - 1e-4f) / 15.f); const float wv = 6.283185307179586f * (float)t / (float)L; const float a = f * wv; z = (j <= 16) ? __cosf(a) : -__sinf(a); }
    zs[w * 36 + j] = z;
  }
  __syncthreads();
  const float fr = freq[j];
  { float acc = fb0[j];
#pragma unroll 3
    for (int i = 0; i < 33; ++i) acc += zs[w * 36 + i] * fw0[i * 64 + j];
    hb[(0 * 8 + w) * 64 + j] = __sinf(fr * acc); }
  __syncthreads();
#pragma unroll
  for (int q = 0; q < 2; ++q) {
    float acc = fbin[q * 64 + j];
#pragma unroll 8
    for (int i = 0; i < 64; ++i) acc += hb[((q & 1) * 8 + w) * 64 + i] * fwin[q * 4096 + i * 64 + j];
    hb[(((q + 1) & 1) * 8 + w) * 64 + j] = __sinf(fr * acc);
    __syncthreads();
  }
  const float mind = -3.0701134573253945f, maxd = -15.350567286626973f;
#pragma unroll 1
  for (int qq = 0; qq < 8; ++qq) {
    const int n = j + 64 * qq;
    float acc = 0.f;
#pragma unroll 8
    for (int i = 0; i < 64; ++i) acc += hb[(0 * 8 + w) * 64 + i] * fwl[i * 512 + n];
    const int c = n & 255; const float delta = fabsf(mind + (float)c * ((maxd - mind) / 255.f));
    const float val = acc * __expf(-tn * delta);
    if (n < 256) KF[(size_t)c * 2 * L + (L - t)] = f2bf(val);
    else if (t >= 1) KF[(size_t)c * 2 * L + (L + t)] = f2bf(val);
  }
  if (t == 0) {
#pragma unroll
    for (int qq = 0; qq < 4; ++qq) KF[(size_t)(j + 64 * qq) * 2 * L] = 0;
  }
  __syncthreads();
}
DEVI void phase0(const Params& p) {
  const int N_MOD_IT = 144, N_FIL = 512 + 512 + 32;
  constexpr int I_W1 = 16 * 88, I_W2 = 44 * 16, I_WIN = 16 * 32, I_WO = 16 * 16;
  const int N_TR = 4 * I_W1 + 4 * I_W2 + 2 * I_WIN + 2 * I_WO;
  const int NIT = N_MOD_IT + N_FIL + N_TR;
  for (int it = blockIdx.x; it < NIT; it += gridDim.x) {
    asm volatile("" ::: "memory");
    int r = it;
    if (r < N_MOD_IT) { mod_item(p, r); continue; } r -= N_MOD_IT;
    if (r < N_FIL) {
      if (r < 512) filter_item(p, 0, 4096, (u16*)(p.ws + OFF_KF), r);
      else if (r < 1024) filter_item(p, 1, 4096, (u16*)(p.ws + OFF_KF) + (size_t)256 * 8192, r - 512);
      else filter_item(p, 0, 256, (u16*)(p.ws + OFF_KFC), r - 1024);
      continue;
    }
    r -= N_FIL;
    if (r < 4 * I_W1) { const int mi = r / I_W1; transpose_item(p, p.in[7] + (size_t)mi * 1024 * 5632, 1024, 5632, (u16*)(p.ws + OFF_W1T) + (size_t)mi * 5632 * 1024, 1, r % I_W1); continue; } r -= 4 * I_W1;
    if (r < 4 * I_W2) { const int mi = r / I_W2; transpose_item(p, p.in[8] + (size_t)mi * 2816 * 1024, 2816, 1024, (u16*)(p.ws + OFF_W2T) + (size_t)mi * 1024 * 2816, 0, r % I_W2); continue; } r -= 4 * I_W2;
    if (r < 2 * I_WIN) { const int mi = r / I_WIN; transpose_item(p, p.in[9] + (size_t)mi * 1024 * 2048, 1024, 2048, (u16*)(p.ws + OFF_WINT) + (size_t)mi * 2048 * 1024, 2, r % I_WIN); continue; } r -= 2 * I_WIN;
    { const int mi = r / I_WO; transpose_item(p, p.in[10] + (size_t)mi * 1024 * 1024, 1024, 1024, (u16*)(p.ws + OFF_WOT) + (size_t)mi * 1024 * 1024, 0, r % I_WO); }
  }
  float* cost = (float*)(p.ws + OFF_ROPE); float* sint = cost + 4096 * 32;
  for (int idx = blockIdx.x * NTHREADS + otid(); idx < 4096 * 32; idx += gridDim.x * NTHREADS) {
    const int t = idx >> 5, pp = idx & 31;
    const float inv = exp2f(-(float)(pp & 15) * (13.287712379549449f / 16.f));
    const float pos = pp < 16 ? (float)(t >> 6) : (float)(t & 63);
    const float ang = pos * inv;
    cost[idx] = __cosf(ang); sint[idx] = __sinf(ang);
  }
  u16* WGT = (u16*)(p.ws + OFF_WGT);
  for (int o = blockIdx.x * NTHREADS + otid(); o < 2 * 2 * 2 * 4 * 64 * 64; o += gridDim.x * NTHREADS) {
    const int k = o & 63, e = (o >> 6) & 63, nb = (o >> 12) & 3, mat = (o >> 14) & 1, ld = o >> 15;
    const float* src = mat ? p.in[15] : p.in[13];
    WGT[o] = f2bf(src[(size_t)((ld * 4 + nb) * 64 + k) * 64 + e]);
  }
}

DEVI float wave_sum(float v, int lane) {
#pragma unroll
  for (int o = 1; o < 64; o <<= 1) v += shx(v, o, lane);
  return v;
}
DEVI void norm_phase(const Params& p, int l, int which, int Mrows, bool from_input) {
  const int tid = otid();
  const int lane = tid & 63, gw = blockIdx.x * 8 + (tid >> 6), NW = gridDim.x * 8;
  const float* X = (const float*)(p.ws + OFF_X); u16* H = (u16*)(p.ws + OFF_H);
  const float* MOD = (const float*)(p.ws + OFF_MOD);
  const f32x4* g4 = (const f32x4*)(p.in[6] + (size_t)(l * 3 + which) * D) + lane;
  for (int row = gw; row < Mrows; row += NW) {
    const float* xr = from_input ? (row < TL ? p.in[0] + (size_t)row * D : p.in[2] + (size_t)(row - TL) * D) : X + (size_t)row * D;
    const int r = row < TL ? (row >> 12) : 8;
    const f32x4* sh4 = (const f32x4*)(MOD + (size_t)((l * 9 + r) * 9 + which * 3) * D) + lane;
    const f32x4* sc4 = sh4 + D / 4;
    const f32x4* x4 = (const f32x4*)xr + lane;
    f32x4 v[4]; float ss = 0.f;
#pragma unroll
    for (int j = 0; j < 4; ++j) { v[j] = x4[64 * j]; ss += (v[j][0] * v[j][0] + v[j][1] * v[j][1]) + (v[j][2] * v[j][2] + v[j][3] * v[j][3]); }
    const float rinv = rsqrtf(wave_sum(ss, lane) * (1.f / D) + 1e-6f);
    uint2* o8 = (uint2*)(H + (size_t)row * D) + lane;
#pragma unroll
    for (int j = 0; j < 4; ++j) {
      const f32x4 g = g4[64 * j], sh = sh4[64 * j], sc = sc4[64 * j];
      f32x4 y;
#pragma unroll
      for (int q = 0; q < 4; ++q) y[q] = v[j][q] * rinv * g[q] * (1.f + sc[q]) + sh[q];
      uint2 o; o.x = pk_bf16(y[0], y[1]); o.y = pk_bf16(y[2], y[3]); o8[64 * j] = o;
    }
  }
}
DEVI void final_norm_phase(const Params& p) {
  const int tid = otid();
  const int lane = tid & 63, gw = blockIdx.x * 8 + (tid >> 6), NW = gridDim.x * 8;
  const float* X = (const float*)(p.ws + OFF_X);
  const f32x4* g4 = (const f32x4*)p.in[28] + lane;
  for (int row = gw; row < TL; row += NW) {
    const f32x4* x4 = (const f32x4*)(X + (size_t)row * D) + lane;
    f32x4 v[4]; float ss = 0.f;
#pragma unroll
    for (int j = 0; j < 4; ++j) { v[j] = x4[64 * j]; ss += (v[j][0] * v[j][0] + v[j][1] * v[j][1]) + (v[j][2] * v[j][2] + v[j][3] * v[j][3]); }
    const float rinv = rsqrtf(wave_sum(ss, lane) * (1.f / D) + 1e-6f);
    f32x4* o4 = (f32x4*)(p.out + (size_t)row * D) + lane;
#pragma unroll
    for (int j = 0; j < 4; ++j) { const f32x4 g = g4[64 * j]; f32x4 y; for (int q = 0; q < 4; ++q) y[q] = v[j][q] * rinv * g[q]; o4[64 * j] = y; }
  }
}

constexpr int AT_KSTR = 72, AT_VSTR = 408;
DEVI void attn_stage(const u16* __restrict__ QK, const u16* __restrict__ PT, u16* Ks, u16* Vs, int tid, int kvh, int kbase, int kstart, int nkeys, int klen) {
  for (int idx = tid; idx < nkeys * 8; idx += NTHREADS) {
    const int kl = idx >> 3, cp = idx & 7, kp = kstart + kl;
    uint4 v = {0u, 0u, 0u, 0u};
    if (kp >= 0 && kp < klen) v = *(const uint4*)(QK + (size_t)(kbase + kp) * 640 + 512 + kvh * 64 + cp * 8);
    *(uint4*)(Ks + kl * AT_KSTR + cp * 8) = v;
  }
  const int nck = nkeys >> 3;
  for (int idx = tid; idx < 64 * nck; idx += NTHREADS) {
    const int dim = idx / nck, ck = idx % nck, kp = kstart + ck * 8;
    uint4 v = {0u, 0u, 0u, 0u};
    if (kp >= 0 && kp < klen) v = *(const uint4*)(PT + (size_t)(1280 + kvh * 64 + dim) * T + kbase + kp);
    *(uint4*)(Vs + dim * AT_VSTR + ck * 8) = v;
  }
}
DEVI void attn_item(const Params& p, int l, int item) {
  const u16* QK = (const u16*)(p.ws + OFF_QK); const u16* PT = (const u16*)(p.ws + OFF_PT); u16* YC = (u16*)(p.ws + OFF_H);
  u16* Ks = (u16*)smem; u16* Vs = Ks + 400 * AT_KSTR;
  const int tid = otid();
  const int wave = tid >> 6, lane = tid & 63, fr = lane & 15, g = lane >> 4;
  int kvh, b, qb, isctx;
  if (item < 512) { kvh = item & 1; qb = (item >> 1) & 31; b = item >> 6; isctx = 0; }
  else { const int it = item - 512; kvh = it & 1; qb = (it >> 1) & 1; b = it >> 2; isctx = 1; }
  const int rowbase = isctx ? TL + b * CTXL : b * SEQ;
  const int ctxbase = TL + b * CTXL;
  const int q0b = qb * 128, q0 = q0b + wave * 16;
  const int qrow = rowbase + q0 + fr, qpos = q0 + fr;
  bf16x8 Qf[4][2];
  float m[4], lsum[4];
  f32x4 O[4][4];
#pragma unroll
  for (int hh = 0; hh < 4; ++hh) {
    const u16* qp = QK + (size_t)qrow * 640 + (kvh * 4 + hh) * 64 + g * 8;
    Qf[hh][0] = *(const bf16x8*)qp; Qf[hh][1] = *(const bf16x8*)(qp + 32);
    m[hh] = p.in[27][l * 8 + kvh * 4 + hh]; lsum[hh] = 0.f;
#pragma unroll
    for (int dt = 0; dt < 4; ++dt) O[hh][dt] = (f32x4){0.f, 0.f, 0.f, 0.f};
  }
  auto chunk = [&](const int lk, const int kp0, const bool win) {
    bf16x8 Kf[2][2];
#pragma unroll
    for (int tt = 0; tt < 2; ++tt) {
      const u16* kr = Ks + (lk + 16 * tt + fr) * AT_KSTR + g * 8;
      Kf[tt][0] = *(const bf16x8*)kr; Kf[tt][1] = *(const bf16x8*)(kr + 32);
    }
    bf16x8 Vf[4];
#pragma unroll
    for (int dt = 0; dt < 4; ++dt) {
      const u16* vr = Vs + (16 * dt + fr) * AT_VSTR + lk + 4 * g;
      union { uint2 u[2]; bf16x8 v; } t; t.u[0] = *(const uint2*)vr; t.u[1] = *(const uint2*)(vr + 16); Vf[dt] = t.v;
    }
    bool valid[2][4];
#pragma unroll
    for (int tt = 0; tt < 2; ++tt)
#pragma unroll
      for (int j = 0; j < 4; ++j) {
        const int kp = kp0 + 16 * tt + 4 * g + j; int dq = qpos - kp; dq = dq < 0 ? -dq : dq;
        valid[tt][j] = win ? (kp >= 0 && kp < SEQ && dq <= 128) : true;
      }
#pragma unroll
    for (int hh = 0; hh < 4; ++hh) {
      f32x4 st[2];
#pragma unroll
      for (int tt = 0; tt < 2; ++tt) { f32x4 z = {0.f, 0.f, 0.f, 0.f}; z = mfma16(Kf[tt][0], Qf[hh][0], z); z = mfma16(Kf[tt][1], Qf[hh][1], z); st[tt] = z; }
      float mx = -3.0e38f;
#pragma unroll
      for (int tt = 0; tt < 2; ++tt)
#pragma unroll
        for (int j = 0; j < 4; ++j) { const float sv = valid[tt][j] ? st[tt][j] : -1e30f; st[tt][j] = sv; mx = fmaxf(mx, sv); }
      mx = fmaxf(mx, shx(mx, 16, lane)); mx = fmaxf(mx, shx(mx, 32, lane));
      const float mnew = fmaxf(m[hh], mx);
      const float alpha = __expf(m[hh] - mnew); m[hh] = mnew;
      float ps = 0.f; float pv[2][4];
#pragma unroll
      for (int tt = 0; tt < 2; ++tt)
#pragma unroll
        for (int j = 0; j < 4; ++j) { const float e = __expf(st[tt][j] - mnew); pv[tt][j] = e; ps += e; }
      lsum[hh] = lsum[hh] * alpha + ps;
      union { unsigned u[4]; bf16x8 v; } Pf;
      Pf.u[0] = pk_bf16(pv[0][0], pv[0][1]); Pf.u[1] = pk_bf16(pv[0][2], pv[0][3]);
      Pf.u[2] = pk_bf16(pv[1][0], pv[1][1]); Pf.u[3] = pk_bf16(pv[1][2], pv[1][3]);
#pragma unroll
      for (int dt = 0; dt < 4; ++dt) {
        f32x4 o = O[hh][dt]; o[0] *= alpha; o[1] *= alpha; o[2] *= alpha; o[3] *= alpha;
        O[hh][dt] = mfma16(Vf[dt], Pf.v, o);
      }
    }
  };
  if (!isctx) {
    attn_stage(QK, PT, Ks, Vs, tid, kvh, rowbase, q0b - 128, 400, SEQ);
    __syncthreads();
#pragma unroll 1
    for (int ci = 0; ci < 9; ++ci) chunk(16 * wave + 32 * ci, q0 - 128 + 32 * ci, true);
    __syncthreads();
  }
  attn_stage(QK, PT, Ks, Vs, tid, kvh, ctxbase, 0, 256, CTXL);
  __syncthreads();
#pragma unroll 1
  for (int ci = 0; ci < 8; ++ci) chunk(32 * ci, 32 * ci, false);
#pragma unroll
  for (int hh = 0; hh < 4; ++hh) {
    float ls = lsum[hh]; ls += shx(ls, 16, lane); ls += shx(ls, 32, lane);
    const float sink = p.in[27][l * 8 + kvh * 4 + hh];
    const float inv = 1.f / (ls + __expf(sink - m[hh]));
#pragma unroll
    for (int dt = 0; dt < 4; ++dt) {
      uint2 o; o.x = pk_bf16(O[hh][dt][0] * inv, O[hh][dt][1] * inv); o.y = pk_bf16(O[hh][dt][2] * inv, O[hh][dt][3] * inv);
      *(uint2*)(YC + (size_t)qrow * D + 512 + (kvh * 4 + hh) * 64 + 16 * dt + 4 * g) = o;
    }
  }
  __syncthreads();
}

DEVI void lru_item(const Params& p, int l, int item, int pass) {
  const u16* PT = (const u16*)(p.ws + OFF_PT); u16* YC = (u16*)(p.ws + OFF_H);
  float2* SUMM = (float2*)(p.ws + OFF_SUMM);
  const int ch = item >> 2, n = item & 3;
  const int isctx = ch >= 256;
  int b, tq; if (!isctx) { b = ch >> 5; tq = ch & 31; } else { b = (ch - 256) >> 1; tq = (ch - 256) & 1; }
  const int Lseq = isctx ? CTXL : SEQ, rowbase = isctx ? TL + b * CTXL : b * SEQ, t0 = tq * 128;
  float* xs = (float*)smem;
  u16* ub = (u16*)(xs + 64 * 145);
  float* ex = (float*)(ub + 128 * 72);
  float* sm = ex + 8 * 16 * 65;
  float* hc = sm + 2 * 8 * 64 * 2;
  float2* ss = (float2*)(hc + 128);
  const int tid = otid(), e = tid & 63, tg = tid >> 6, c = n * 64 + e, lane = e, fr = lane & 15, g = lane >> 4;
  for (int idx = tid; idx < 64 * 18; idx += NTHREADS) {
    const int chn = idx / 18, ck = idx % 18, t = t0 - 8 + ck * 8;
    bf16x8 v = {0, 0, 0, 0, 0, 0, 0, 0};
    if (t >= 0 && t < Lseq) v = *(const bf16x8*)(PT + (size_t)(n * 64 + chn) * T + rowbase + t);
#pragma unroll
    for (int q = 0; q < 8; ++q) xs[chn * 145 + ck * 8 + q] = bf2f((u16)v[q]);
  }
  if (pass) {
    for (int idx = tid; idx < 2 * 34 * 64; idx += NTHREADS) {
      const int d = idx / (34 * 64), rem = idx % (34 * 64), j = rem >> 6, ee = rem & 63;
      const int cidx = j < 2 ? 256 + b * 2 + j : b * 32 + (j - 2);
      ss[idx] = SUMM[((size_t)d * 272 + cidx) * 256 + n * 64 + ee];
    }
  }
  __syncthreads();
  float uo[16];
  { const float* cw = p.in[11] + (size_t)l * 4 * 256 + c;
    const float w0 = cw[0], w1 = cw[256], w2 = cw[512], w3 = cw[768], cb = p.in[12][l * 256 + c];
    const float* xr = xs + e * 145 + 8 + 16 * tg;
#pragma unroll
    for (int tt = 0; tt < 16; ++tt) { const float u = cb + w0 * xr[tt - 2] + w1 * xr[tt - 1] + w2 * xr[tt] + w3 * xr[tt + 1]; uo[tt] = u; ub[(16 * tg + tt) * 72 + e] = f2bf(u); } }
  if (pass && tid < 128) {
    const int d = tid >> 6, ee = tid & 63, my = isctx ? tq : 2 + tq;
    const float2* S = ss + d * 34 * 64 + ee;
    float h = 0.f;
    if (d == 0) { for (int j = 0; j < my; ++j) { const float2 sv = S[j * 64]; h = sv.x * h + sv.y; } }
    else {
      if (my < 2) { for (int j = 1; j > my; --j) { const float2 sv = S[j * 64]; h = sv.x * h + sv.y; } }
      else {
        { const float2 sv = S[1 * 64]; h = sv.x * h + sv.y; }
        { const float2 sv = S[0 * 64]; h = sv.x * h + sv.y; }
        for (int j = 33; j > my; --j) { const float2 sv = S[j * 64]; h = sv.x * h + sv.y; }
      }
    }
    hc[tid] = h;
  }
  __syncthreads();
  if (pass) {
    for (int idx = tid; idx < 64 * 16; idx += NTHREADS) {
      const int chn = idx >> 4, ck = idx & 15;
      const bf16x8 v = *(const bf16x8*)(PT + (size_t)(256 + n * 64 + chn) * T + rowbase + t0 + ck * 8);
#pragma unroll
      for (int q = 0; q < 8; ++q) xs[chn * 145 + 8 + ck * 8 + q] = bf2f((u16)v[q]);
    }
  }
  const bf16x8 A0 = *(const bf16x8*)(ub + (16 * tg + fr) * 72 + 8 * g), A1 = *(const bf16x8*)(ub + (16 * tg + fr) * 72 + 32 + 8 * g);
  const u16* WGT = (const u16*)(p.ws + OFF_WGT);
  float* exw = ex + tg * 16 * 65;
  float av[2][16], bv[2][16];
#pragma unroll
  for (int d = 0; d < 2; ++d) {
    float pre[2][16];
#pragma unroll
    for (int mat = 0; mat < 2; ++mat) {
      const u16* wb = WGT + (size_t)((((l * 2 + d) * 2 + mat) * 4 + n) * 64) * 64 + 8 * g;
      f32x4 acc[4];
#pragma unroll
      for (int nt = 0; nt < 4; ++nt) {
        const bf16x8 B0 = *(const bf16x8*)(wb + (16 * nt + fr) * 64), B1 = *(const bf16x8*)(wb + (16 * nt + fr) * 64 + 32);
        f32x4 z = {0.f, 0.f, 0.f, 0.f};
        z = mfma16(A0, B0, z); z = mfma16(A1, B1, z); acc[nt] = z;
      }
      asm volatile("s_waitcnt lgkmcnt(0)" ::: "memory");
#pragma unroll
      for (int nt = 0; nt < 4; ++nt)
#pragma unroll
        for (int j = 0; j < 4; ++j) exw[(4 * g + j) * 65 + 16 * nt + fr] = acc[nt][j];
      asm volatile("s_waitcnt lgkmcnt(0)" ::: "memory");
#pragma unroll
      for (int tt = 0; tt < 16; ++tt) pre[mat][tt] = exw[tt * 65 + lane];
    }
    const float ba = p.in[14][(l * 2 + d) * 256 + c], bx = p.in[16][(l * 2 + d) * 256 + c];
    const float lam = p.in[17][(l * 2 + d) * 256 + c];
    const float exl = __expf(-lam); const float sp = exl * (1.f - exl * (0.5f - exl * (0.33333334f - 0.25f * exl)));
    float Ap = 1.f, Bp = 0.f;
#pragma unroll
    for (int q = 0; q < 16; ++q) {
      const int tt = d == 0 ? q : 15 - q;
      const float r = sigmoidf_(pre[0][tt] + ba), ig = sigmoidf_(pre[1][tt] + bx);
      const float la = -8.f * r * sp;
      const float a = __expf(la);
      const float y2 = 2.f * la;
      const float om = y2 > -0.1f ? -y2 * (1.f + y2 * (0.5f + y2 * (0.16666667f + y2 * (0.041666668f + y2 * 0.008333334f)))) : 1.f - __expf(y2);
      const float bb = sqrtf(om) * (ig * uo[tt]);
      av[d][tt] = a; bv[d][tt] = bb;
      Bp = a * Bp + bb; Ap *= a;
    }
    sm[((d * 8 + tg) * 64 + e) * 2 + 0] = Ap; sm[((d * 8 + tg) * 64 + e) * 2 + 1] = Bp;
  }
  __syncthreads();
  if (!pass) {
    if (tid < 128) {
      const int d = tid >> 6, ee = tid & 63;
      float A = 1.f, Bc = 0.f;
      if (d == 0) { for (int g2 = 0; g2 < 8; ++g2) { const float a = sm[((0 * 8 + g2) * 64 + ee) * 2], bq = sm[((0 * 8 + g2) * 64 + ee) * 2 + 1]; Bc = a * Bc + bq; A *= a; } }
      else { for (int g2 = 7; g2 >= 0; --g2) { const float a = sm[((1 * 8 + g2) * 64 + ee) * 2], bq = sm[((1 * 8 + g2) * 64 + ee) * 2 + 1]; Bc = a * Bc + bq; A *= a; } }
      SUMM[((size_t)d * 272 + ch) * 256 + n * 64 + ee] = make_float2(A, Bc);
    }
  } else {
    float hs[16];
    { float h = hc[e];
      for (int g2 = 0; g2 < tg; ++g2) { const float a = sm[((0 * 8 + g2) * 64 + e) * 2], bq = sm[((0 * 8 + g2) * 64 + e) * 2 + 1]; h = a * h + bq; }
#pragma unroll
      for (int tt = 0; tt < 16; ++tt) { h = av[0][tt] * h + bv[0][tt]; hs[tt] = h; } }
    { float h = hc[64 + e];
      for (int g2 = 7; g2 > tg; --g2) { const float a = sm[((1 * 8 + g2) * 64 + e) * 2], bq = sm[((1 * 8 + g2) * 64 + e) * 2 + 1]; h = a * h + bq; }
#pragma unroll
      for (int tt = 15; tt >= 0; --tt) { h = av[1][tt] * h + bv[1][tt]; hs[tt] += h; } }
    const float* gr = xs + e * 145 + 8 + 16 * tg;
#pragma unroll
    for (int tt = 0; tt < 16; ++tt) {
      const float y = hs[tt] * gelu_tanh(gr[tt]);
      YC[(size_t)(rowbase + t0 + 16 * tg + tt) * D + c] = f2bf(y);
    }
  }
  __syncthreads();
}

DEVI void uprep_phase(const Params& p, int l) {
  const u16* PT = (const u16*)(p.ws + OFF_PT); u16* UT = (u16*)(p.ws + OFF_UT); u16* X0T = (u16*)(p.ws + OFF_X0T);
  constexpr int NCH = T / 8;
  for (int idx = blockIdx.x * NTHREADS + otid(); idx < 256 * NCH; idx += gridDim.x * NTHREADS) {
    const int c = idx / NCH, ck = idx % NCH, row = ck * 8;
    int t, Lseq; if (row < TL) { t = row & 4095; Lseq = SEQ; } else { t = (row - TL) & 255; Lseq = CTXL; }
    float o[3][8];
#pragma unroll
    for (int k = 0; k < 3; ++k) {
      const int col = k * 256 + c;
      const u16* src = PT + (size_t)(512 + col) * T + row;
      const bf16x8 v = *(const bf16x8*)src;
      float x[10];
      x[0] = t > 0 ? bf2f(src[-1]) : 0.f;
      x[9] = (t + 8 < Lseq) ? bf2f(src[8]) : 0.f;
#pragma unroll
      for (int q = 0; q < 8; ++q) x[q + 1] = bf2f((u16)v[q]);
      const float w0 = p.in[18][(l * 3 + 0) * 768 + col], w1 = p.in[18][(l * 3 + 1) * 768 + col], w2 = p.in[18][(l * 3 + 2) * 768 + col], bb = p.in[19][l * 768 + col];
#pragma unroll
      for (int q = 0; q < 8; ++q) o[k][q] = bb + w0 * x[q] + w1 * x[q + 1] + w2 * x[q + 2];
    }
    uint4 uo, xo;
    uo.x = pk_bf16(o[1][0] * o[2][0], o[1][1] * o[2][1]); uo.y = pk_bf16(o[1][2] * o[2][2], o[1][3] * o[2][3]);
    uo.z = pk_bf16(o[1][4] * o[2][4], o[1][5] * o[2][5]); uo.w = pk_bf16(o[1][6] * o[2][6], o[1][7] * o[2][7]);
    xo.x = pk_bf16(o[0][0], o[0][1]); xo.y = pk_bf16(o[0][2], o[0][3]); xo.z = pk_bf16(o[0][4], o[0][5]); xo.w = pk_bf16(o[0][6], o[0][7]);
    *(uint4*)(UT + (size_t)c * T + row) = uo;
    *(uint4*)(X0T + (size_t)c * T + row) = xo;
  }
}

DEVI bf16x8 ld_frag8(const u16* a) { union { uint2 u[2]; bf16x8 v; } f; f.u[0] = *(const uint2*)a; f.u[1] = *(const uint2*)(a + 4); return f.v; }
DEVI void toep_item(const Params& p, int l, int c, int isctx) {
  const int L = isctx ? CTXL : SEQ;
  const u16* KF = isctx ? (const u16*)(p.ws + OFF_KFC) + (size_t)c * 512 : (const u16*)(p.ws + OFF_KF) + (size_t)(l * 256 + c) * 8192;
  u16* R = (u16*)smem; const int CS = 2 * L + 8;
  u16* Us = R + 4 * CS; const int USTR = L + 8;
  const int tid = otid(), wave = tid >> 6, lane = tid & 63, fr = lane & 15, g = lane >> 4;
  const u16* Uc = (const u16*)(p.ws + OFF_UT) + (size_t)c * T;
  const u16* X0c = (const u16*)(p.ws + OFF_X0T) + (size_t)c * T;
  for (int q = tid; q < (2 * L) / 8; q += NTHREADS) {
    const bf16x8 v = *(const bf16x8*)(KF + 8 * q);
#pragma unroll
    for (int mm = 0; mm < 4; ++mm)
#pragma unroll
      for (int e = 0; e < 8; ++e) R[mm * CS + 8 * q + e + mm] = (u16)v[e];
  }
  if (tid < 32) { const int mm = tid >> 3, e = tid & 7; if (e < mm) R[mm * CS + e] = 0; else R[mm * CS + 2 * L + e] = 0; }
  for (int q = tid; q < L; q += NTHREADS) {
    const int bb = q / (L / 8), ck = q % (L / 8);
    const size_t row = (isctx ? (size_t)TL + (size_t)bb * CTXL : (size_t)bb * SEQ) + ck * 8;
    *(uint4*)(Us + bb * USTR + ck * 8) = *(const uint4*)(Uc + row);
  }
  __syncthreads();
  u16* YC = (u16*)(p.ws + OFF_H);
  const float skip = p.in[26][l * 256 + c];
  const int nT = L / 128;
  const int mcp = fr & 3;
  const u16* Rl = R + mcp * CS + (L + 8 * g - (fr - mcp));
  const u16* Ul = Us + (fr & 7) * USTR + 8 * g;
  const size_t urow = isctx ? (size_t)TL + (size_t)(fr & 7) * CTXL : (size_t)(fr & 7) * SEQ;
  for (int wt = wave; wt < nT; wt += 8) {
    const int T0 = wt * 128;
    f32x4 acc[8];
#pragma unroll
    for (int m8 = 0; m8 < 8; ++m8) acc[m8] = (f32x4){0.f, 0.f, 0.f, 0.f};
    bf16x8 F[8];
#pragma unroll
    for (int m8 = 2; m8 < 8; ++m8) F[m8] = ld_frag8(Rl + (0 - T0 - 16 * m8));
#pragma unroll 1
    for (int s0 = 0; s0 < L; s0 += 128) {
#pragma unroll
      for (int k = 0; k < 4; ++k) {
        const int s = s0 + 32 * k;
        const bf16x8 Bf = *(const bf16x8*)(Ul + s);
        F[(8 - 2 * k) & 7] = ld_frag8(Rl + (s - T0));
        F[(9 - 2 * k) & 7] = ld_frag8(Rl + (s - T0 - 16));
#pragma unroll
        for (int m8 = 0; m8 < 8; ++m8) acc[m8] = mfma16(F[(m8 + 8 - 2 * k) & 7], Bf, acc[m8]);
      }
    }
    if (fr < 8) {
#pragma unroll
      for (int m8 = 0; m8 < 8; ++m8) {
        const size_t row = urow + T0 + 16 * m8 + 4 * g;
        const bf16x4 u4 = *(const bf16x4*)(Us + fr * USTR + T0 + 16 * m8 + 4 * g), x4 = *(const bf16x4*)(X0c + row);
#pragma unroll
        for (int j = 0; j < 4; ++j) {
          const float y = bf2f((u16)x4[j]) * (acc[m8][j] + skip * bf2f((u16)u4[j]));
          YC[(row + j) * D + 256 + c] = f2bf(y);
        }
      }
    }
  }
  __syncthreads();
}

#ifndef PROBE
#define PROBE -1
#endif
#define PHASE(id, ...) do { { const float rcf = 1.f; (void)rcf; __VA_ARGS__ } grid.sync(); if (PROBE == (id)) { { const float rcf = 0.f; (void)rcf; __VA_ARGS__ } grid.sync(); } } while (0)
__global__ void __launch_bounds__(NTHREADS) mega(Params p_in) {
  cg::grid_group grid = cg::this_grid();
  Params p = p_in;
  p.wv = __builtin_amdgcn_readfirstlane((int)(threadIdx.x >> 6));
  PHASE(0, phase0(p););
#pragma unroll 1
  for (int l = 0; l < 2; ++l) {
    const int Mpost = l == 0 ? T : TL;
    PHASE(1, norm_phase(p, l, 0, T, l == 0););
    PHASE(2, { EpiAct e{(u16*)(p.ws + OFF_BIG)};
      gemm_phase(p, (const u16*)(p.ws + OFF_H), (const u16*)(p.ws + OFF_W1T) + (size_t)(l * 2 + 0) * 5632 * 1024, T, 2 * DFF, D, e); });
    PHASE(3, { float* X = (float*)(p.ws + OFF_X);
      EpiRes e{(l == 0 && rcf != 0.f) ? p.in[0] : X, (l == 0 && rcf != 0.f) ? p.in[2] : X + (size_t)TL * D, X, (const float*)(p.ws + OFF_MOD) + (size_t)l * 9 * 9216, 2, 0.5f * rcf};
      gemm_phase(p, (const u16*)(p.ws + OFF_BIG), (const u16*)(p.ws + OFF_W2T) + (size_t)(l * 2 + 0) * 1024 * 2816, T, D, DFF, e); });
    PHASE(1, norm_phase(p, l, 1, T, false););
    PHASE(4, { EpiProj e{(u16*)(p.ws + OFF_PT), (u16*)(p.ws + OFF_QK), (const float*)(p.ws + OFF_ROPE), (const float*)(p.ws + OFF_ROPE) + 4096 * 32};
      gemm_phase(p, (const u16*)(p.ws + OFF_H), (const u16*)(p.ws + OFF_WINT) + (size_t)l * 2048 * 1024, T, DIN, D, e); });
    PHASE(5, { const int n_att = l == 0 ? 512 + 32 : 512, n_lru = 1088;
      for (int it = blockIdx.x; it < n_att + n_lru; it += gridDim.x) { if (it < n_att) attn_item(p, l, it); else lru_item(p, l, it - n_att, 0); }
      uprep_phase(p, l); });
    if (PROBE == 8) { for (int it = blockIdx.x; it < 1088; it += gridDim.x) lru_item(p, l, it, 0); grid.sync(); }
    if (PROBE == 9) { for (int it = blockIdx.x; it < 512; it += gridDim.x) attn_item(p, l, it); grid.sync(); }
    if (PROBE == 11) { uprep_phase(p, l); grid.sync(); }
    PHASE(6, { const int n_t1 = 256, n_t2 = l == 0 ? 256 : 0, n_lru = l == 0 ? 1088 : 1024;
      for (int it = blockIdx.x; it < n_t1 + n_t2 + n_lru; it += gridDim.x) {
        if (it < n_t1) toep_item(p, l, it, 0);
        else if (it < n_t1 + n_t2) toep_item(p, l, it - n_t1, 1);
        else lru_item(p, l, it - n_t1 - n_t2, 1);
      } });
    if (PROBE == 10) { for (int it = blockIdx.x; it < 256; it += gridDim.x) toep_item(p, l, it, 0); grid.sync(); }
    PHASE(7, { float* X = (float*)(p.ws + OFF_X);
      EpiRes e{X, X + (size_t)TL * D, X, (const float*)(p.ws + OFF_MOD) + (size_t)l * 9 * 9216, 5, 1.0f * rcf};
      gemm_phase(p, (const u16*)(p.ws + OFF_H), (const u16*)(p.ws + OFF_WOT) + (size_t)l * 1024 * 1024, Mpost, D, D, e); });
    PHASE(1, norm_phase(p, l, 2, Mpost, false););
    PHASE(2, { EpiAct e{(u16*)(p.ws + OFF_BIG)};
      gemm_phase(p, (const u16*)(p.ws + OFF_H), (const u16*)(p.ws + OFF_W1T) + (size_t)(l * 2 + 1) * 5632 * 1024, Mpost, 2 * DFF, D, e); });
    PHASE(3, { float* X = (float*)(p.ws + OFF_X);
      EpiRes e{X, X + (size_t)TL * D, X, (const float*)(p.ws + OFF_MOD) + (size_t)l * 9 * 9216, 8, 0.5f * rcf};
      gemm_phase(p, (const u16*)(p.ws + OFF_BIG), (const u16*)(p.ws + OFF_W2T) + (size_t)(l * 2 + 1) * 1024 * 2816, Mpost, D, DFF, e); });
  }
  final_norm_phase(p);
}

extern "C" void kernel_launch(void* const* d_in, const int* in_sizes, int n_in, void* d_out, int out_size, void* d_ws, size_t ws_size, hipStream_t stream) {
  static int grid_blocks = 0;
  if (!grid_blocks) {
    if (ws_size < WS_END || n_in != 29) { fprintf(stderr, "kernel_launch: workspace %zu < %zu or n_in %d != 29\n", ws_size, (size_t)WS_END, n_in); grid_blocks = -1; return; }
    int dev = 0, cus = 0, per_cu = 0;
    hipGetDevice(&dev);
    hipDeviceGetAttribute(&cus, hipDeviceAttributeMultiprocessorCount, dev);
    if (hipFuncSetAttribute((const void*)mega, hipFuncAttributeMaxDynamicSharedMemorySize, LDS_BYTES) != hipSuccess) { fprintf(stderr, "hipFuncSetAttribute failed\n"); }
    hipOccupancyMaxActiveBlocksPerMultiprocessor(&per_cu, (const void*)mega, NTHREADS, LDS_BYTES);
    if (per_cu < 1) { fprintf(stderr, "occupancy query returned %d\n", per_cu); per_cu = 1; }
    if (per_cu > 1) per_cu = 1;
    grid_blocks = cus * per_cu;
    (void)hipGetLastError();
  }
  if (grid_blocks < 0) return;
  Params p{};
  for (int i = 0; i < 29; ++i) p.in[i] = (const float*)d_in[i];
  p.out = (float*)d_out; p.ws = (unsigned char*)d_ws;
  void* args[] = {&p};
  hipError_t e = hipLaunchCooperativeKernel((void*)mega, dim3(grid_blocks), dim3(NTHREADS), args, LDS_BYTES, stream);
  if (e != hipSuccess) fprintf(stderr, "cooperative launch failed: %s (grid %d)\n", hipGetErrorString(e), grid_blocks);
}
```

```cpp
#include <hip/hip_runtime.h>
#include <hip/hip_cooperative_groups.h>
#include <cstdio>
namespace cg = cooperative_groups;

using bf16x8 = __attribute__((ext_vector_type(8))) short;
using bf16x4 = __attribute__((ext_vector_type(4))) short;
using f32x4  = __attribute__((ext_vector_type(4))) float;
typedef unsigned short u16;
#define DEVI __device__ __forceinline__

constexpr int D = 1024, NB = 8, SEQ = 4096, CTXL = 256, TL = NB * SEQ, TC = NB * CTXL, T = TL + TC;
constexpr int DFF = 2816, DIN = 2048;
constexpr int NTHREADS = 512;
constexpr int LDS_BYTES = 163840;

constexpr size_t OFF_X    = 0;
constexpr size_t OFF_H    = OFF_X + (size_t)T * D * 4;
constexpr size_t OFF_BIG  = OFF_H + (size_t)T * D * 2;
constexpr size_t OFF_PT   = OFF_BIG;
constexpr size_t OFF_QK   = OFF_PT + (size_t)1408 * T * 2;
constexpr size_t OFF_UT   = OFF_QK + (size_t)T * 640 * 2;
constexpr size_t OFF_X0T  = OFF_UT + (size_t)256 * T * 2;
constexpr size_t OFF_SUMM = OFF_X0T + (size_t)256 * T * 2;
constexpr size_t OFF_W1T  = OFF_BIG + (size_t)T * DFF * 2;
constexpr size_t OFF_W2T  = OFF_W1T + (size_t)4 * 5632 * 1024 * 2;
constexpr size_t OFF_WINT = OFF_W2T + (size_t)4 * 1024 * 2816 * 2;
constexpr size_t OFF_WOT  = OFF_WINT + (size_t)2 * 2048 * 1024 * 2;
constexpr size_t OFF_MOD  = OFF_WOT + (size_t)2 * 1024 * 1024 * 2;
constexpr size_t OFF_KF   = OFF_MOD + (size_t)2 * 9 * 9216 * 4;
constexpr size_t OFF_KFC  = OFF_KF + (size_t)2 * 256 * 8192 * 2;
constexpr size_t OFF_ROPE = OFF_KFC + (size_t)256 * 512 * 2;
constexpr size_t OFF_WGT  = OFF_ROPE + (size_t)2 * 4096 * 32 * 4;
constexpr size_t OFF_GV   = OFF_WGT + (size_t)2 * 2 * 2 * 4 * 64 * 64 * 2;
constexpr size_t OFF_SWIN = OFF_GV + (size_t)6 * 9 * 1024 * 4;
constexpr size_t OFF_SW1  = OFF_SWIN + (size_t)2 * 9 * 2048 * 4;
constexpr size_t OFF_SSQ  = OFF_SW1 + (size_t)9 * 5632 * 4;
constexpr size_t OFF_BAR  = OFF_SSQ + (size_t)3 * 4 * T * 4;
constexpr size_t OFF_YHT  = OFF_BAR + (size_t)3456 * 4;
constexpr size_t OFF_PS   = OFF_YHT;
constexpr size_t WS_END   = OFF_PS + (size_t)7 * TC * D * 2;
static_assert((size_t)256 * T * 2 <= (size_t)7 * TC * D * 2, "YHT must fit inside the PS region");
static_assert(OFF_SUMM + 2 * 272 * 256 * 8 <= OFF_W1T, "mixer buffers overflow ACT region");

struct Params {
  const float* in[29];
  float* out;
  unsigned char* ws;
  int wv, pad_;
};

extern __shared__ __attribute__((aligned(16))) unsigned char smem[];

DEVI unsigned pk_bf16(float lo, float hi) { unsigned r; asm volatile("v_cvt_pk_bf16_f32 %0, %1, %2" : "=v"(r) : "v"(lo), "v"(hi)); return r; }
DEVI u16 f2bf(float x) { return (u16)(pk_bf16(x, 0.f) & 0xffffu); }
DEVI float bf2f(u16 h) { return __uint_as_float(((unsigned)h) << 16); }
DEVI float sigmoidf_(float x) { return __builtin_amdgcn_rcpf(1.f + __expf(-x)); }
DEVI float gelu_tanh(float x) { float z = 0.7978845608028654f * (x + 0.044715f * x * x * x); float th = 1.f - 2.f * __builtin_amdgcn_rcpf(1.f + __expf(2.f * z)); return 0.5f * x * (1.f + th); }
template <class Tp> DEVI const Tp* opaque(const Tp* q) { asm volatile("" : "+s"(q)); return q; }
DEVI int otid_(int wv) { int t; asm volatile("v_mbcnt_lo_u32_b32 %0, -1, 0\n\tv_mbcnt_hi_u32_b32 %0, -1, %0" : "=v"(t)); return (wv << 6) | t; }
#define otid() otid_(p.wv)
DEVI float shx(float v, int o, int lane) { return __int_as_float(__builtin_amdgcn_ds_bpermute((lane ^ o) << 2, __float_as_int(v))); }
DEVI float swz_xor16(float v) { return __int_as_float(__builtin_amdgcn_ds_swizzle(__float_as_int(v), 0x401F)); }
DEVI f32x4 mfma16(bf16x8 a, bf16x8 b, f32x4 c) { return __builtin_amdgcn_mfma_f32_16x16x32_bf16(a, b, c, 0, 0, 0); }

constexpr int BM = 256, BK = 64, HALF = 128, HT = HALF * BK;
DEVI int lds_byte(int r, int c) { int st = (r >> 4) * 2 + (c >> 5), rr = r & 15, cc = c & 31, ob = rr * 64 + cc * 2; return st * 1024 + (ob ^ (((ob >> 9) & 1) << 5)); }
DEVI void stage_rc(int b, int& R, int& C) { int st = b / 1024, sb = b % 1024, swz = sb ^ (((sb >> 9) & 1) << 5); R = (st >> 1) * 16 + swz / 64; C = (st & 1) * 32 + (swz % 64) / 2; }

DEVI bool tile_next(int i, int nM, int nN, int& pm, int& pn) {
  const int nwg = nM * nN; const long Lx = (long)i * gridDim.x + blockIdx.x; if (Lx >= nwg) return false;
  int wgid = (int)Lx; { const int q = nwg / 8, r = nwg % 8, xcd = wgid % 8, off = wgid / 8; wgid = (xcd < r ? xcd * (q + 1) : r * (q + 1) + (xcd - r) * q) + off; }
  constexpr int WGM = 4; const int nig = WGM * nN, gid = wgid / nig, fm = gid * WGM, gsz = (nM - fm) < WGM ? (nM - fm) : WGM;
  pm = fm + ((wgid % nig) % gsz); pn = (wgid % nig) / gsz; return true;
}
template <class Epi>
DEVI void gemm_phase(const Params& p, const u16* __restrict__ A, const u16* __restrict__ Bt, const int M, const int N, const int K, const int Msplit, const Epi& epi) {
  u16* shm = (u16*)smem;
#define SA(b, h) (shm + ((b) * 2 + (h)) * HT)
#define SB(b, h) (shm + (4 + (b) * 2 + (h)) * HT)
#define STAGE(P, BASE, br, kt) do { const char* _ub = (const char*)(BASE + (long)(br) * K + (long)(kt) * BK); asm volatile("" : "+s"(_ub)); \
      __builtin_amdgcn_global_load_lds((const unsigned*)(_ub + soff0), (unsigned*)((char*)(P) + p.wv * 1024), 16, 0, 0); \
      __builtin_amdgcn_global_load_lds((const unsigned*)(_ub + soff1), (unsigned*)((char*)(P) + p.wv * 1024 + 8192), 16, 0, 0); } while (0)
#define LDA(dst, b, h) for (int m = 0; m < 4; ++m) for (int k = 0; k < 2; ++k) \
    dst[m][k] = *reinterpret_cast<const bf16x8*>((char*)SA(b, h) + lds_byte(wr * 64 + m * 16 + fr, k * 32 + fq * 8))
#define LDB(dst, b, h) for (int n = 0; n < 2; ++n) for (int k = 0; k < 2; ++k) \
    dst[n][k] = *reinterpret_cast<const bf16x8*>((char*)SB(b, h) + lds_byte(wc * 32 + n * 16 + fr, k * 32 + fq * 8))
#define MMA(ai, bj, At_, Bt_) do { __builtin_amdgcn_s_setprio(1); \
    for (int m = 0; m < 4; ++m) for (int n = 0; n < 2; ++n) for (int k = 0; k < 2; ++k) \
      acc[ai][bj][m][n] = Epi::TR ? __builtin_amdgcn_mfma_f32_16x16x32_bf16(Bt_[n][k], At_[m][k], acc[ai][bj][m][n], 0, 0, 0) \
                                  : __builtin_amdgcn_mfma_f32_16x16x32_bf16(At_[m][k], Bt_[n][k], acc[ai][bj][m][n], 0, 0, 0); \
    __builtin_amdgcn_s_setprio(0); } while (0)
#define WAIT_V(n) asm volatile("s_waitcnt vmcnt(" #n ")" ::: "memory")
#define WAIT_L(n) asm volatile("s_waitcnt lgkmcnt(" #n ")" ::: "memory")
#define BAR __builtin_amdgcn_s_barrier()
#define SCHED __builtin_amdgcn_sched_barrier(0)
#define PRO_K0(brow_, bcol_) do { STAGE(SB(0, 0), Bt, bcol_, 0); STAGE(SA(0, 0), A, brow_, 0); STAGE(SB(0, 1), Bt, (bcol_) + HALF, 0); STAGE(SA(0, 1), A, (brow_) + HALF, 0); } while (0)
#define PRO_K1(brow_, bcol_) do { STAGE(SB(1, 0), Bt, bcol_, 1); STAGE(SA(1, 0), A, brow_, 1); STAGE(SB(1, 1), Bt, (bcol_) + HALF, 1); } while (0)
  const int tid = otid();
  const int wid = tid >> 6, lane = tid & 63, wr = wid >> 2, wc = wid & 3, fr = lane & 15, fq = lane >> 4;
  unsigned soff0, soff1;
  { int r_, c_; stage_rc(tid * 16, r_, c_); soff0 = (unsigned)(r_ * K + c_) * 2u; stage_rc(tid * 16 + 8192, r_, c_); soff1 = (unsigned)(r_ * K + c_) * 2u; }
  const int nM = M / BM, nN = N / BM, ntT = K / BK, nfull = nM * nN, nsl = (Msplit / BM) * nN * 7;
  auto unit_next = [&](const int i, int& pm_, int& pn_, int& kt0_, int& ntl_) -> bool {
    kt0_ = 0; ntl_ = ntT;
    if (tile_next(i, nM, nN, pm_, pn_)) return true;
    const long u = (long)i * gridDim.x + blockIdx.x - nfull; if (u >= nsl) return false;
    const int tl = (int)(u / 7), sl = (int)(u % 7); pm_ = nM + tl / nN; pn_ = tl % nN;
    const int base = (ntT / 7) & ~1;
    kt0_ = sl * base; ntl_ = sl < 6 ? base : ntT - 6 * base;
    return true;
  };
  int pm, pn, kt0, nt;
  bool have = unit_next(0, pm, pn, kt0, nt);
  const u16* A0 = A; const u16* B0p = Bt;
  if (have) { A = A0 + (long)kt0 * BK; Bt = B0p + (long)kt0 * BK; PRO_K0(pm * BM, pn * BM); PRO_K1(pm * BM, pn * BM); }
#pragma unroll 1
  for (int it = 0; have; ++it) {
    const int brow = pm * BM, bcol = pn * BM;
    const int slcur = brow < M ? -1 : kt0 / ((ntT / 7) & ~1);
    int kt0n = 0, ntn = 2;
    const bool have2 = unit_next(it + 1, pm, pn, kt0n, ntn);
    const u16* An = A0 + (long)kt0n * BK; const u16* Bn = B0p + (long)kt0n * BK;
    f32x4 acc[2][2][4][2] = {};
    bf16x8 At[4][2], B0[2][2], B1[2][2];
    if (it == 0) { WAIT_V(0); } else { if constexpr (Epi::NST == 16) WAIT_V(16); else if constexpr (Epi::NST == 32) WAIT_V(32); else WAIT_V(0); }
    if (wr == 1) BAR;
    BAR;
    BAR;
    for (int t = 0; t < nt - 2; t += 2) {
      LDB(B0, 0, 0); SCHED; LDA(At, 0, 0); STAGE(SA(1, 1), A, brow + HALF, t + 1);
      WAIT_L(8); BAR; WAIT_L(0); MMA(0, 0, At, B0); BAR; SCHED;
      LDB(B1, 0, 1); STAGE(SB(0, 0), Bt, bcol, t + 2);
      BAR; WAIT_L(0); MMA(0, 1, At, B1); BAR;
      LDA(At, 0, 1); STAGE(SA(0, 0), A, brow, t + 2);
      BAR; WAIT_L(0); MMA(1, 0, At, B0); BAR; SCHED;
      STAGE(SB(0, 1), Bt, bcol + HALF, t + 2);
      WAIT_V(6); BAR; MMA(1, 1, At, B1); BAR;
      LDB(B0, 1, 0); SCHED; LDA(At, 1, 0); STAGE(SA(0, 1), A, brow + HALF, t + 2);
      WAIT_L(8); BAR; WAIT_L(0); MMA(0, 0, At, B0); BAR; SCHED;
      LDB(B1, 1, 1); STAGE(SB(1, 0), Bt, bcol, t + 3);
      BAR; WAIT_L(0); MMA(0, 1, At, B1); BAR;
      LDA(At, 1, 1); STAGE(SA(1, 0), A, brow, t + 3);
      BAR; WAIT_L(0); MMA(1, 0, At, B0); BAR; SCHED;
      STAGE(SB(1, 1), Bt, bcol + HALF, t + 3);
      WAIT_V(6); BAR; MMA(1, 1, At, B1); BAR;
    }
    { LDB(B0, 0, 0); LDA(At, 0, 0); STAGE(SA(1, 1), A, brow + HALF, nt - 1);
      BAR; WAIT_L(0); MMA(0, 0, At, B0); BAR;
      LDB(B1, 0, 1); BAR; WAIT_L(0); MMA(0, 1, At, B1); BAR;
      LDA(At, 0, 1); WAIT_V(4); BAR; WAIT_L(0); MMA(1, 0, At, B0); MMA(1, 1, At, B1); BAR; }
    { LDB(B0, 1, 0); LDA(At, 1, 0); WAIT_V(2); BAR;
      if (have2) { const u16* Asv = A; const u16* Bsv = Bt; A = An; Bt = Bn; PRO_K0(pm * BM, pn * BM); A = Asv; Bt = Bsv; }
      WAIT_L(0); MMA(0, 0, At, B0); BAR;
      LDB(B1, 1, 1); if (have2) { WAIT_V(8); } else { WAIT_V(0); } BAR; WAIT_L(0); MMA(0, 1, At, B1); BAR;
      LDA(At, 1, 1); BAR; WAIT_L(0); MMA(1, 0, At, B0); MMA(1, 1, At, B1); BAR; }
    if (wr == 0) BAR;
    have = have2;
    A = An; Bt = Bn; nt = ntn; kt0 = kt0n;
    if (have) { PRO_K1(pm * BM, pn * BM); }
    { const int tid2 = otid(), wid2 = tid2 >> 6, lane2 = tid2 & 63, wr2 = wid2 >> 2, wc2 = wid2 & 3, fr2 = lane2 & 15, fq2 = lane2 >> 4;
      float sq[8] = {0.f, 0.f, 0.f, 0.f, 0.f, 0.f, 0.f, 0.f};
      float* rl = (float*)((char*)shm + 3 * HT * 2);
      bool nrm = false;
      if constexpr (Epi::NRM) {
        nrm = epi.ssq != nullptr && brow < TL;
        if (nrm) {
          if (tid2 < 256) { const float* q = epi.ssq + brow + tid2; rl[tid2] = rsqrtf(((q[0] + q[T]) + (q[2 * T] + q[3 * T])) * (1.f / D) + 1e-6f); }
          WAIT_L(0); BAR;
        }
      }
#pragma unroll
      for (int ai = 0; ai < 2; ++ai)
#pragma unroll
        for (int bj = 0; bj < 2; ++bj) {
          const int colb = bcol + bj * HALF + wc2 * 32;
          typename Epi::Pre pre;
          if constexpr (Epi::NRM || Epi::SQ) epi.preload(pre, brow, colb, wr2, fr2, fq2, nrm, slcur);
#pragma unroll
          for (int m = 0; m < 4; ++m) {
            const int rloc = ai * HALF + wr2 * 64 + m * 16;
            if constexpr (Epi::SQ) epi(brow + rloc + fr2, colb, fq2, acc[ai][bj][m][0], acc[ai][bj][m][1], sq[ai * 4 + m], slcur, pre);
            else if constexpr (Epi::TR) { float rv = 1.f; if (nrm) rv = rl[rloc + fr2]; epi(brow + rloc + fr2, colb, fq2, acc[ai][bj][m][0], acc[ai][bj][m][1], rv, nrm, pre); }
            else { f32x4 rv = {1.f, 1.f, 1.f, 1.f}; if (nrm) rv = *(const f32x4*)(rl + rloc + fq2 * 4); epi(brow + rloc + fq2 * 4, colb, fr2, acc[ai][bj][m][0], acc[ai][bj][m][1], rv, nrm, pre); }
          }
        }
      if constexpr (Epi::SQ) {
        if (epi.part && slcur < 0) {
          float* lp = (float*)((char*)shm + 3 * HT * 2);
#pragma unroll
          for (int i = 0; i < 8; ++i) {
            float v = sq[i]; v += swz_xor16(v); v += shx(v, 32, lane2);
            if (fq2 == 0) lp[wc2 * 256 + (i >> 2) * HALF + wr2 * 64 + (i & 3) * 16 + fr2] = v;
          }
          WAIT_L(0); BAR;
          if (tid2 < 256) epi.part[(size_t)(bcol >> 8) * T + brow + tid2] = (lp[tid2] + lp[256 + tid2]) + (lp[512 + tid2] + lp[768 + tid2]);
        }
      } }
  }
  __syncthreads();
#undef SA
#undef SB
#undef STAGE
#undef LDA
#undef LDB
#undef MMA
#undef PRO_K0
#undef PRO_K1
}

struct EpiAct {
  static constexpr bool TR = true, SQ = false, NRM = true; static constexpr int NST = 16;
  u16* act; const float* ssq; const float* sw;
  struct Pre { f32x4 sa, sb; };
  DEVI void preload(Pre& q, int brow, int colb, int wr, int fr, int fq, bool nrm, int) const {
    if (nrm) { const int r = brow < TL ? (brow >> 12) : 8; q.sa = *(const f32x4*)(sw + (size_t)r * 5632 + colb + 4 * fq); q.sb = *(const f32x4*)(sw + (size_t)r * 5632 + colb + 16 + 4 * fq); }
  }
  DEVI void operator()(int row, int colb, int fq, const f32x4& a0, const f32x4& a1, const float rinv, const bool nrm, const Pre& q) const {
    const int oc = (colb >> 5) * 16 + 4 * fq;
    f32x4 xa = a0, xb = a1;
    if (nrm) {
#pragma unroll
      for (int j = 0; j < 4; ++j) { xa[j] = xa[j] * rinv + q.sa[j]; xb[j] = xb[j] * rinv + q.sb[j]; }
    }
    float v[4];
#pragma unroll
    for (int j = 0; j < 4; ++j) { const float a = xa[j]; v[j] = a * sigmoidf_(a) * xb[j]; }
    uint2 o; o.x = pk_bf16(v[0], v[1]); o.y = pk_bf16(v[2], v[3]);
    *(uint2*)(act + (size_t)row * DFF + oc) = o;
  }
};
struct EpiRes {
  static constexpr bool TR = true, SQ = true, NRM = false; static constexpr int NST = 32;
  const float* xin_lat; const float* xin_ctx;
  float* xout; const float* modl;
  int gi; float coef;
  u16* xg; const float* gvl; float* part;
  struct Pre { f32x4 gv[2], G[2]; };
  u16* ps;
  DEVI void preload(Pre& q, int brow, int colb, int wr, int fr, int fq, bool, int slice) const {
    if (slice >= 0) return;
    const int r = brow < TL ? (brow >> 12) : 8;
    const float* gate = modl + (size_t)(r * 9 + gi) * D;
#pragma unroll
    for (int n = 0; n < 2; ++n) {
      const int col = colb + n * 16 + 4 * fq;
      q.gv[n] = *(const f32x4*)(gate + col);
      if (xg) q.G[n] = *(const f32x4*)(gvl + (size_t)r * D + col);
    }
  }
  DEVI void operator()(int row, int colb, int fq, const f32x4& a0, const f32x4& a1, float& sqacc, const int slice, const Pre& q) const {
    if (slice >= 0) {
#pragma unroll
      for (int n = 0; n < 2; ++n) {
        const int col = colb + n * 16 + 4 * fq;
        const f32x4& a = n ? a1 : a0;
        uint2 w; w.x = pk_bf16(a[0], a[1]); w.y = pk_bf16(a[2], a[3]);
        *(uint2*)(ps + ((size_t)slice * TC + (row - TL)) * D + col) = w;
      }
      return;
    }
    const float* src = row < TL ? xin_lat + (size_t)row * D : xin_ctx + (size_t)(row - TL) * D;
    const f32x4 xi0 = *(const f32x4*)(src + colb + 4 * fq), xi1 = *(const f32x4*)(src + colb + 16 + 4 * fq);
#pragma unroll
    for (int n = 0; n < 2; ++n) {
      const int col = colb + n * 16 + 4 * fq;
      const f32x4& a = n ? a1 : a0; const f32x4& xi = n ? xi1 : xi0;
      f32x4 o;
#pragma unroll
      for (int j = 0; j < 4; ++j) o[j] = xi[j] + coef * q.gv[n][j] * a[j];
      *(f32x4*)(xout + (size_t)row * D + col) = o;
      if (xg) {
        sqacc += (o[0] * o[0] + o[1] * o[1]) + (o[2] * o[2] + o[3] * o[3]);
        uint2 w; w.x = pk_bf16(o[0] * q.G[n][0], o[1] * q.G[n][1]); w.y = pk_bf16(o[2] * q.G[n][2], o[3] * q.G[n][3]);
        *(uint2*)(xg + (size_t)row * D + col) = w;
      }
    }
  }
};
struct EpiProj {
  static constexpr bool TR = false, SQ = false, NRM = true; static constexpr int NST = 32;
  u16* pt; u16* qk; const float* cost; const float* sint; const float* ssq; const float* sw;
  struct Pre { float s0, s1, invrev; };
  DEVI void preload(Pre& q, int brow, int colb, int wr, int fr, int fq, bool nrm, int) const {
    const int r = brow < TL ? (brow >> 12) : 8;
    q.s0 = nrm ? sw[r * 2048 + colb + fr] : 0.f; q.s1 = nrm ? sw[r * 2048 + colb + 16 + fr] : 0.f;
    q.invrev = exp2f(-(float)fr * (13.287712379549449f / 16.f)) * 0.15915494309189535f;
  }
  DEVI void operator()(int row0, int colb, int fr, const f32x4& b0, const f32x4& b1, const f32x4& rv, const bool nrm, const Pre& q) const {
    f32x4 a0, a1;
#pragma unroll
    for (int j = 0; j < 4; ++j) { a0[j] = b0[j] * rv[j] + q.s0; a1[j] = b1[j] * rv[j] + q.s1; }
    if (colb < 1280 || colb >= 1920) {
#pragma unroll
      for (int n = 0; n < 2; ++n) {
        const int pc = colb + n * 16 + fr; const int ptc = pc < 1280 ? pc : pc - 640;
        const f32x4& a = n ? a1 : a0;
        uint2 o; o.x = pk_bf16(a[0], a[1]); o.y = pk_bf16(a[2], a[3]);
        *(uint2*)(pt + (size_t)ptc * T + row0) = o;
      }
    } else {
      const int off = colb - 1280, head = off >> 6, grp = (off >> 5) & 1, pidx = 16 * grp + fr;
      const int d1 = head * 64 + pidx, d2 = d1 + 32;
      const float qs = head < 8 ? 0.125f * 1.4426950408889634f : 1.f;
#pragma unroll
      for (int j = 0; j < 4; ++j) {
        const int row = row0 + j; float c = 1.f, sn = 0.f;
        if (row < TL) { const int t = row & 4095; const float rev = (float)(grp ? (t & 63) : (t >> 6)) * q.invrev; c = __builtin_amdgcn_cosf(rev); sn = __builtin_amdgcn_sinf(rev); }
        const float o1 = (a0[j] * c - a1[j] * sn) * qs, o2 = (a0[j] * sn + a1[j] * c) * qs;
        qk[(size_t)row * 640 + d1] = f2bf(o1); qk[(size_t)row * 640 + d2] = f2bf(o2);
      }
    }
  }
};

DEVI int srccol(int mode, int pn) {
  if (mode == 1) { const int g = pn >> 5, hh = (pn >> 4) & 1, i = pn & 15; return hh * DFF + g * 16 + i; }
  if (mode == 2) { if (pn < 1280 || pn >= 1920) return pn; const int off = pn - 1280, head = off >> 6, w = off & 63, grp = w >> 5, hh = (w >> 4) & 1, i = w & 15; return 1280 + head * 64 + 16 * grp + i + 32 * hh; }
  return pn;
}
DEVI void transpose_item(const Params& p, const float* __restrict__ W, int K, int N, u16* __restrict__ WT, int mode, int item) {
  float* tile = (float*)smem;
  const int tid = otid(), nblk = N / 256, kb = item / nblk, nb = item % nblk, k0 = kb * 64, n0 = nb * 256;
  { const int nn = tid & 63, kr = tid >> 6;
#pragma unroll
    for (int c4 = 0; c4 < 4; ++c4) {
      const int src = srccol(mode, n0 + c4 * 64 + nn);
#pragma unroll
      for (int r = 0; r < 8; ++r) { const int kk = kr + 8 * r; tile[kk * 257 + c4 * 64 + nn] = W[(size_t)(k0 + kk) * N + src]; }
    } }
  __syncthreads();
#pragma unroll
  for (int c4 = 0; c4 < 4; ++c4) {
    const int rown = c4 * 64 + (tid >> 3), kc = tid & 7; const float* s = tile + (kc * 8) * 257 + rown;
    uint4 o; o.x = pk_bf16(s[0], s[257]); o.y = pk_bf16(s[514], s[771]); o.z = pk_bf16(s[1028], s[1285]); o.w = pk_bf16(s[1542], s[1799]);
    *(uint4*)(WT + (size_t)(n0 + rown) * K + k0 + kc * 8) = o; }
  __syncthreads();
}
DEVI void mod_item(const Params& p, int item) {
  float* sv = (float*)smem;
  float* red = sv + 9 * 1024;
  const int tid = otid(), l = item / 144, n0 = (item % 144) * 64;
  for (int i = tid; i < 9 * 1024; i += NTHREADS) { const int r = i >> 10, k = i & 1023; const float cv = r < 8 ? p.in[1][r * 1024 + k] : p.in[3][k]; sv[i] = cv * sigmoidf_(cv); }
  __syncthreads();
  const int cc = tid & 63, kq = tid >> 6;
  const float* w = p.in[4] + (size_t)l * 1024 * 9216 + n0 + cc;
  float acc[9];
#pragma unroll
  for (int r = 0; r < 9; ++r) acc[r] = 0.f;
#pragma unroll 8
  for (int k4 = 0; k4 < 32; ++k4) {
    const int k = kq * 128 + k4 * 4;
    const float w0 = w[(size_t)k * 9216], w1 = w[(size_t)(k + 1) * 9216], w2 = w[(size_t)(k + 2) * 9216], w3 = w[(size_t)(k + 3) * 9216];
#pragma unroll
    for (int r = 0; r < 9; ++r) { const float4 s4 = *(const float4*)(sv + r * 1024 + k); acc[r] += s4.x * w0 + s4.y * w1 + s4.z * w2 + s4.w * w3; }
  }
#pragma unroll
  for (int r = 0; r < 9; ++r) red[(kq * 9 + r) * 64 + cc] = acc[r];
  __syncthreads();
  float* MOD = (float*)(p.ws + OFF_MOD);
  for (int i = tid; i < 9 * 64; i += NTHREADS) {
    const int r = i >> 6, c2 = i & 63;
    float v = p.in[5][l * 9216 + n0 + c2];
#pragma unroll
    for (int q = 0; q < 8; ++q) v += red[(q * 9 + r) * 64 + c2];
    MOD[(size_t)(l * 9 + r) * 9216 + n0 + c2] = v;
  }
  __syncthreads();
}
DEVI void filter_item(const Params& p, int l, int L, u16* __restrict__ KF, int posblk) {
  float* zs = (float*)smem;
  float* hb = zs + 64 * 36;
  const int tid = otid(), w = tid >> 6, j = tid & 63, t0 = posblk * 64 + w * 8;
  const float* fw0 = opaque(p.in[20] + l * 33 * 64); const float* fb0 = opaque(p.in[21] + l * 64);
  const float* fwin = opaque(p.in[22] + l * 2 * 64 * 64); const float* fbin = opaque(p.in[23] + l * 2 * 64);
  const float* freq = opaque(p.in[24] + l * 64); const float* fwl = opaque(p.in[25] + l * 64 * 512);
  const float invL1 = 1.f / (float)(L - 1);
  if (j < 33) {
#pragma unroll
    for (int q = 0; q < 8; ++q) {
      const int t = t0 + q; const float tn = (float)t * invL1;
      float z;
      if (j == 0) z = tn;
      else { const int bi = (j - 1) & 15; const float f = 1e-4f + (float)bi * ((15.f - 1e-4f) / 15.f); const float wv = 6.283185307179586f * (float)t / (float)L; const float a = f * wv; z = (j <= 16) ? __cosf(a) : -__sinf(a); }
      zs[(w * 8 + q) * 36 + j] = z;
    }
  }
  __syncthreads();
  const float fr = freq[j];
  { float acc[8];
    const float b0 = fb0[j];
#pragma unroll
    for (int q = 0; q < 8; ++q) acc[q] = b0;
#pragma unroll 3
    for (int i = 0; i < 33; ++i) { const float wv = fw0[i * 64 + j];
#pragma unroll
      for (int q = 0; q < 8; ++q) acc[q] += zs[(w * 8 + q) * 36 + i] * wv; }
#pragma unroll
    for (int q = 0; q < 8; ++q) hb[(0 * 64 + w * 8 + q) * 64 + j] = __sinf(fr * acc[q]); }
  __syncthreads();
  float* wl = hb + 2 * 64 * 64;
#pragma unroll
  for (int s2 = 0; s2 < 2; ++s2) {
    { const f32x4 w0 = *(const f32x4*)(fwin + s2 * 4096 + tid * 4), w1 = *(const f32x4*)(fwin + s2 * 4096 + (tid + NTHREADS) * 4);
      *(f32x4*)(wl + tid * 4) = w0; *(f32x4*)(wl + (tid + NTHREADS) * 4) = w1; }
    __syncthreads();
    float acc[8];
    const float b0 = fbin[s2 * 64 + j];
#pragma unroll
    for (int q = 0; q < 8; ++q) acc[q] = b0;
#pragma unroll 8
    for (int i = 0; i < 64; ++i) { const float wv = wl[i * 64 + j];
#pragma unroll
      for (int q = 0; q < 8; ++q) acc[q] += hb[((s2 & 1) * 64 + w * 8 + q) * 64 + i] * wv; }
#pragma unroll
    for (int q = 0; q < 8; ++q) hb[(((s2 + 1) & 1) * 64 + w * 8 + q) * 64 + j] = __sinf(fr * acc[q]);
    __syncthreads();
  }
  const float mind = -3.0701134573253945f, maxd = -15.350567286626973f;
#pragma unroll 1
  for (int qq = 0; qq < 8; qq += 2) {
    { f32x4 wv4[4];
#pragma unroll
      for (int k = 0; k < 4; ++k) { const int idx = tid + k * NTHREADS, i = idx >> 5, c4 = idx & 31; wv4[k] = *(const f32x4*)(fwl + i * 512 + 64 * qq + c4 * 4); }
#pragma unroll
      for (int k = 0; k < 4; ++k) { const int idx = tid + k * NTHREADS; *(f32x4*)(wl + idx * 4) = wv4[k]; } }
    __syncthreads();
    float acc[2][8];
#pragma unroll
    for (int q = 0; q < 8; ++q) { acc[0][q] = 0.f; acc[1][q] = 0.f; }
#pragma unroll 8
    for (int i = 0; i < 64; ++i) {
      const float w0 = wl[i * 128 + j], w1 = wl[i * 128 + 64 + j];
#pragma unroll
      for (int q = 0; q < 8; ++q) { const float hv = hb[(0 * 64 + w * 8 + q) * 64 + i]; acc[0][q] += hv * w0; acc[1][q] += hv * w1; }
    }
#pragma unroll
    for (int u = 0; u < 2; ++u) {
      const int n = j + 64 * (qq + u), c = n & 255; const float delta = fabsf(mind + (float)c * ((maxd - mind) / 255.f));
#pragma unroll
      for (int q = 0; q < 8; ++q) {
        const int t = t0 + q; const float val = acc[u][q] * __expf(-((float)t * invL1) * delta);
        if (n < 256) KF[(size_t)c * 2 * L + (L - t)] = f2bf(val);
        else if (t >= 1) KF[(size_t)c * 2 * L + (L + t)] = f2bf(val);
      }
    }
    __syncthreads();
  }
  if (t0 == 0) {
#pragma unroll
    for (int qq = 0; qq < 4; ++qq) KF[(size_t)(j + 64 * qq) * 2 * L] = 0;
  }
  __syncthreads();
}
DEVI void phase0(const Params& p) {
  const int N_MOD_IT = 288, N_FIL = 64 + 64 + 4;
  constexpr int I_W1 = 16 * 22, I_W2 = 44 * 4, I_WIN = 16 * 8, I_WO = 16 * 4;
  const int N_TR = 4 * I_W1 + 4 * I_W2 + 2 * I_WIN + 2 * I_WO;
  const int NIT = N_MOD_IT + N_FIL + N_TR;
  for (int it = blockIdx.x; it < NIT; it += gridDim.x) {
    asm volatile("" ::: "memory");
    int r = it;
    if (r < N_FIL) {
      if (r < 64) filter_item(p, 0, 4096, (u16*)(p.ws + OFF_KF), r);
      else if (r < 128) filter_item(p, 1, 4096, (u16*)(p.ws + OFF_KF) + (size_t)256 * 8192, r - 64);
      else filter_item(p, 0, 256, (u16*)(p.ws + OFF_KFC), r - 128);
      continue;
    }
    r -= N_FIL;
    if (r < N_MOD_IT) { mod_item(p, r); continue; } r -= N_MOD_IT;
    if (r < 4 * I_W1) { const int mi = r / I_W1; transpose_item(p, p.in[7] + (size_t)mi * 1024 * 5632, 1024, 5632, (u16*)(p.ws + OFF_W1T) + (size_t)mi * 5632 * 1024, 1, r % I_W1); continue; } r -= 4 * I_W1;
    if (r < 4 * I_W2) { const int mi = r / I_W2; transpose_item(p, p.in[8] + (size_t)mi * 2816 * 1024, 2816, 1024, (u16*)(p.ws + OFF_W2T) + (size_t)mi * 1024 * 2816, 0, r % I_W2); continue; } r -= 4 * I_W2;
    if (r < 2 * I_WIN) { const int mi = r / I_WIN; transpose_item(p, p.in[9] + (size_t)mi * 1024 * 2048, 1024, 2048, (u16*)(p.ws + OFF_WINT) + (size_t)mi * 2048 * 1024, 2, r % I_WIN); continue; } r -= 2 * I_WIN;
    { const int mi = r / I_WO; transpose_item(p, p.in[10] + (size_t)mi * 1024 * 1024, 1024, 1024, (u16*)(p.ws + OFF_WOT) + (size_t)mi * 1024 * 1024, 0, r % I_WO); }
  }
  u16* WGT = (u16*)(p.ws + OFF_WGT);
  for (int o = blockIdx.x * NTHREADS + otid(); o < 2 * 2 * 2 * 4 * 64 * 64; o += gridDim.x * NTHREADS) {
    const int k = o & 63, e = (o >> 6) & 63, nb = (o >> 12) & 3, mat = (o >> 14) & 1, ld = o >> 15;
    const float* src = mat ? p.in[15] : p.in[13];
    WGT[o] = f2bf(src[(size_t)((ld * 4 + nb) * 64 + k) * 64 + e]);
  }
}

DEVI float wave_sum(float v, int lane) {
#pragma unroll
  for (int o = 1; o < 64; o <<= 1) v += shx(v, o, lane);
  return v;
}
DEVI void norm_phase(const Params& p, int l, int which, int rbeg, int Mrows, bool from_input) {
  const int tid = otid();
  const int lane = tid & 63, gw = blockIdx.x * 8 + (tid >> 6), NW = gridDim.x * 8;
  const float* X = (const float*)(p.ws + OFF_X); u16* H = (u16*)(p.ws + OFF_H);
  const float* MOD = (const float*)(p.ws + OFF_MOD);
  const f32x4* g4 = (const f32x4*)(p.in[6] + (size_t)(l * 3 + which) * D) + lane;
  for (int row0 = rbeg + gw * 2; row0 < Mrows; row0 += NW * 2) {
    f32x4 v[2][4]; float ss[2] = {0.f, 0.f};
#pragma unroll
    for (int u = 0; u < 2; ++u) {
      const int row = row0 + u;
      const float* xr = from_input ? (row < TL ? p.in[0] + (size_t)row * D : p.in[2] + (size_t)(row - TL) * D) : X + (size_t)row * D;
      const f32x4* x4 = (const f32x4*)xr + lane;
#pragma unroll
      for (int j = 0; j < 4; ++j) v[u][j] = x4[64 * j];
    }
#pragma unroll
    for (int u = 0; u < 2; ++u)
#pragma unroll
      for (int j = 0; j < 4; ++j) ss[u] += (v[u][j][0] * v[u][j][0] + v[u][j][1] * v[u][j][1]) + (v[u][j][2] * v[u][j][2] + v[u][j][3] * v[u][j][3]);
#pragma unroll
    for (int u = 0; u < 2; ++u) {
      const int row = row0 + u;
      const int r = row < TL ? (row >> 12) : 8;
      const f32x4* sh4 = (const f32x4*)(MOD + (size_t)((l * 9 + r) * 9 + which * 3) * D) + lane;
      const f32x4* sc4 = sh4 + D / 4;
      const float rinv = rsqrtf(wave_sum(ss[u], lane) * (1.f / D) + 1e-6f);
      uint2* o8 = (uint2*)(H + (size_t)row * D) + lane;
#pragma unroll
      for (int j = 0; j < 4; ++j) {
        const f32x4 g = g4[64 * j], sh = sh4[64 * j], sc = sc4[64 * j];
        f32x4 y;
#pragma unroll
        for (int q = 0; q < 4; ++q) y[q] = v[u][j][q] * rinv * g[q] * (1.f + sc[q]) + sh[q];
        uint2 o; o.x = pk_bf16(y[0], y[1]); o.y = pk_bf16(y[2], y[3]); o8[64 * j] = o;
      }
    }
  }
}
DEVI void ctx_combine_phase(const Params& p, int l, int gi, float coef, int ln, int lwhich) {
  const int tid = otid(), lane = tid & 63, gw = blockIdx.x * 8 + (tid >> 6), NW = gridDim.x * 8;
  float* X = (float*)(p.ws + OFF_X); u16* H = (u16*)(p.ws + OFF_H);
  const u16* PS = (const u16*)(p.ws + OFF_PS);
  const float* MOD = (const float*)(p.ws + OFF_MOD);
  const f32x4* gate4 = (const f32x4*)(MOD + (size_t)((l * 9 + 8) * 9 + gi) * D) + lane;
  for (int rc = gw; rc < TC; rc += NW) {
    f32x4* x4 = (f32x4*)(X + (size_t)(TL + rc) * D) + lane;
    f32x4 v[4]; float ss = 0.f;
#pragma unroll
    for (int j = 0; j < 4; ++j) {
      f32x4 sum = {0.f, 0.f, 0.f, 0.f};
#pragma unroll
      for (int sl = 0; sl < 7; ++sl) {
        const uint2 w = *((const uint2*)(PS + ((size_t)sl * TC + rc) * D) + lane + 64 * j);
        sum[0] += __uint_as_float(w.x << 16); sum[1] += __uint_as_float(w.x & 0xffff0000u); sum[2] += __uint_as_float(w.y << 16); sum[3] += __uint_as_float(w.y & 0xffff0000u);
      }
      const f32x4 xo = x4[64 * j], gv = gate4[64 * j];
#pragma unroll
      for (int q = 0; q < 4; ++q) v[j][q] = xo[q] + coef * gv[q] * sum[q];
      x4[64 * j] = v[j];
      ss += (v[j][0] * v[j][0] + v[j][1] * v[j][1]) + (v[j][2] * v[j][2] + v[j][3] * v[j][3]);
    }
    if (ln >= 0) {
      const f32x4* g4 = (const f32x4*)(p.in[6] + (size_t)(ln * 3 + lwhich) * D) + lane;
      const f32x4* sh4 = (const f32x4*)(MOD + (size_t)((ln * 9 + 8) * 9 + lwhich * 3) * D) + lane;
      const f32x4* sc4 = sh4 + D / 4;
      const float rinv = rsqrtf(wave_sum(ss, lane) * (1.f / D) + 1e-6f);
      uint2* o8 = (uint2*)(H + (size_t)(TL + rc) * D) + lane;
#pragma unroll
      for (int j = 0; j < 4; ++j) {
        const f32x4 g = g4[64 * j], sh = sh4[64 * j], sc = sc4[64 * j];
        f32x4 y;
#pragma unroll
        for (int q = 0; q < 4; ++q) y[q] = v[j][q] * rinv * g[q] * (1.f + sc[q]) + sh[q];
        uint2 o; o.x = pk_bf16(y[0], y[1]); o.y = pk_bf16(y[2], y[3]); o8[64 * j] = o;
      }
    }
  }
}
DEVI void prep2_phase(const Params& p) {
  const int tid = otid(), lane = tid & 63, gw = blockIdx.x * 8 + (tid >> 6), NW = gridDim.x * 8;
  const float* MOD = (const float*)(p.ws + OFF_MOD);
  float* GV = (float*)(p.ws + OFF_GV);
  for (int o = blockIdx.x * NTHREADS + tid; o < 6 * 9 * 1024; o += gridDim.x * NTHREADS) {
    const int col = o & 1023, r = (o >> 10) % 9, lw = o / (9 * 1024), l = lw / 3, which = lw % 3;
    GV[o] = p.in[6][(size_t)(l * 3 + which) * D + col] * (1.f + MOD[(size_t)((l * 9 + r) * 9 + which * 3 + 1) * D + col]);
  }
  for (int wi = gw; wi < 9 * 152; wi += NW) {
    const int r = wi % 9, grp = wi / 9, row0 = grp * 64;
    const u16* wbase; const float* shv; float* dst;
    if (row0 < 4096) { const int l = row0 >> 11, pn = row0 & 2047; wbase = (const u16*)(p.ws + OFF_WINT) + (size_t)(l * 2048 + pn) * 1024; shv = MOD + (size_t)((l * 9 + r) * 9 + 3) * D; dst = (float*)(p.ws + OFF_SWIN) + (size_t)(l * 9 + r) * 2048 + pn; }
    else { const int pn = row0 - 4096; wbase = (const u16*)(p.ws + OFF_W1T) + (size_t)(2 * 5632 + pn) * 1024; shv = MOD + (size_t)((1 * 9 + r) * 9 + 0) * D; dst = (float*)(p.ws + OFF_SW1) + (size_t)r * 5632 + pn; }
    float sh[16];
#pragma unroll
    for (int q = 0; q < 4; ++q) { const f32x4 sv = *(const f32x4*)(shv + lane * 16 + 4 * q); sh[4 * q] = sv[0]; sh[4 * q + 1] = sv[1]; sh[4 * q + 2] = sv[2]; sh[4 * q + 3] = sv[3]; }
#pragma unroll 1
    for (int i = 0; i < 64; i += 8) {
      float a8[8];
#pragma unroll
      for (int u = 0; u < 8; ++u) {
        const u16* wrow = wbase + (size_t)(i + u) * 1024 + lane * 16;
        const bf16x8 v0 = *(const bf16x8*)wrow, v1 = *(const bf16x8*)(wrow + 8);
        float acc = 0.f;
#pragma unroll
        for (int q = 0; q < 8; ++q) acc += bf2f((u16)v0[q]) * sh[q] + bf2f((u16)v1[q]) * sh[8 + q];
        a8[u] = acc;
      }
#pragma unroll
      for (int u = 0; u < 8; ++u) a8[u] = wave_sum(a8[u], lane);
      if (lane < 8) { float v = a8[0];
#pragma unroll
        for (int u = 1; u < 8; ++u) v = lane == u ? a8[u] : v;
        dst[i + lane] = v; }
    }
  }
}
DEVI void final_norm_phase(const Params& p) {
  const int tid = otid();
  const int lane = tid & 63, gw = blockIdx.x * 8 + (tid >> 6), NW = gridDim.x * 8;
  const float* X = (const float*)(p.ws + OFF_X);
  const f32x4* g4 = (const f32x4*)p.in[28] + lane;
  for (int row0 = gw * 2; row0 < TL; row0 += NW * 2) {
    f32x4 v[2][4]; float ss[2] = {0.f, 0.f};
#pragma unroll
    for (int u = 0; u < 2; ++u) {
      const f32x4* x4 = (const f32x4*)(X + (size_t)(row0 + u) * D) + lane;
#pragma unroll
      for (int j = 0; j < 4; ++j) v[u][j] = x4[64 * j];
    }
#pragma unroll
    for (int u = 0; u < 2; ++u)
#pragma unroll
      for (int j = 0; j < 4; ++j) ss[u] += (v[u][j][0] * v[u][j][0] + v[u][j][1] * v[u][j][1]) + (v[u][j][2] * v[u][j][2] + v[u][j][3] * v[u][j][3]);
#pragma unroll
    for (int u = 0; u < 2; ++u) {
      const float rinv = rsqrtf(wave_sum(ss[u], lane) * (1.f / D) + 1e-6f);
      f32x4* o4 = (f32x4*)(p.out + (size_t)(row0 + u) * D) + lane;
#pragma unroll
      for (int j = 0; j < 4; ++j) { const f32x4 g = g4[64 * j]; f32x4 y;
#pragma unroll
        for (int q = 0; q < 4; ++q) y[q] = v[u][j][q] * rinv * g[q];
        o4[64 * j] = y; }
    }
  }
}

constexpr int AT_KSTR = 72, AT_VSTR = 408;
template <int NKEYS>
DEVI void attn_stage(const u16* __restrict__ QK, const u16* __restrict__ PT, u16* Ks, u16* Vs, int tid, int kvh, int kbase, int kstart, int klen) {
  constexpr int NCH = NKEYS * 8, NIT = (NCH + NTHREADS - 1) / NTHREADS, NCK = NKEYS / 8;
  uint4 kv[NIT], vv[NIT];
#pragma unroll
  for (int i = 0; i < NIT; ++i) {
    const int idx = tid + i * NTHREADS;
    { const int kl = idx >> 3, cp = idx & 7, kp = kstart + kl;
      kv[i] = make_uint4(0u, 0u, 0u, 0u);
      if (idx < NCH && kp >= 0 && kp < klen) kv[i] = *(const uint4*)(QK + (size_t)(kbase + kp) * 640 + 512 + kvh * 64 + cp * 8); }
    { const int dim = idx / NCK, ck = idx % NCK, kp = kstart + ck * 8;
      vv[i] = make_uint4(0u, 0u, 0u, 0u);
      if (idx < NCH && kp >= 0 && kp < klen) vv[i] = *(const uint4*)(PT + (size_t)(1280 + kvh * 64 + dim) * T + kbase + kp); }
  }
#pragma unroll
  for (int i = 0; i < NIT; ++i) {
    const int idx = tid + i * NTHREADS;
    if (idx < NCH) {
      *(uint4*)(Ks + (idx >> 3) * AT_KSTR + (idx & 7) * 8) = kv[i];
      *(uint4*)(Vs + (idx / NCK) * AT_VSTR + (idx % NCK) * 8) = vv[i];
    }
  }
}
DEVI void attn_item(const Params& p, int l, int item) {
  const u16* QK = (const u16*)(p.ws + OFF_QK); const u16* PT = (const u16*)(p.ws + OFF_PT); u16* YC = (u16*)(p.ws + OFF_H);
  u16* Ks = (u16*)smem; u16* Vs = Ks + 400 * AT_KSTR;
  const int tid = otid();
  const int wave = tid >> 6, lane = tid & 63, fr = lane & 15, g = lane >> 4;
  int kvh, b, qb, isctx;
  if (item < 512) { kvh = item & 1; qb = (item >> 1) & 31; b = item >> 6; isctx = 0; }
  else { const int it = item - 512; kvh = it & 1; qb = (it >> 1) & 1; b = it >> 2; isctx = 1; }
  const int rowbase = isctx ? TL + b * CTXL : b * SEQ;
  const int ctxbase = TL + b * CTXL;
  const int q0b = qb * 128, q0 = q0b + wave * 16;
  const int qrow = rowbase + q0 + fr, qpos = q0 + fr;
  bf16x8 Qf[4][2];
  float m[4], lsum[4];
  f32x4 O[4][4];
#pragma unroll
  for (int hh = 0; hh < 4; ++hh) {
    const u16* qp = QK + (size_t)qrow * 640 + (kvh * 4 + hh) * 64 + g * 8;
    Qf[hh][0] = *(const bf16x8*)qp; Qf[hh][1] = *(const bf16x8*)(qp + 32);
    m[hh] = p.in[27][l * 8 + kvh * 4 + hh] * 1.4426950408889634f; lsum[hh] = 0.f;
#pragma unroll
    for (int dt = 0; dt < 4; ++dt) O[hh][dt] = (f32x4){0.f, 0.f, 0.f, 0.f};
  }
  auto chunk = [&](const int lk, const int kp0, const bool win) {
    bf16x8 Kf[2][2];
#pragma unroll
    for (int tt = 0; tt < 2; ++tt) {
      const u16* kr = Ks + (lk + 16 * tt + fr) * AT_KSTR + g * 8;
      Kf[tt][0] = *(const bf16x8*)kr; Kf[tt][1] = *(const bf16x8*)(kr + 32);
    }
    bf16x8 Vf[4];
#pragma unroll
    for (int dt = 0; dt < 4; ++dt) {
      const u16* vr = Vs + (16 * dt + fr) * AT_VSTR + lk + 4 * g;
      union { uint2 u[2]; bf16x8 v; } t; t.u[0] = *(const uint2*)vr; t.u[1] = *(const uint2*)(vr + 16); Vf[dt] = t.v;
    }
    bool valid[2][4];
#pragma unroll
    for (int tt = 0; tt < 2; ++tt)
#pragma unroll
      for (int j = 0; j < 4; ++j) {
        const int kp = kp0 + 16 * tt + 4 * g + j; int dq = qpos - kp; dq = dq < 0 ? -dq : dq;
        valid[tt][j] = win ? (kp >= 0 && kp < SEQ && dq <= 128) : true;
      }
#pragma unroll
    for (int hh = 0; hh < 4; ++hh) {
      f32x4 st[2];
#pragma unroll
      for (int tt = 0; tt < 2; ++tt) { f32x4 z = {0.f, 0.f, 0.f, 0.f}; z = mfma16(Kf[tt][0], Qf[hh][0], z); z = mfma16(Kf[tt][1], Qf[hh][1], z); st[tt] = z; }
      float mx = -3.0e38f;
#pragma unroll
      for (int tt = 0; tt < 2; ++tt)
#pragma unroll
        for (int j = 0; j < 4; ++j) { const float sv = valid[tt][j] ? st[tt][j] : -1e30f; st[tt][j] = sv; mx = fmaxf(mx, sv); }
      mx = fmaxf(mx, shx(mx, 16, lane)); mx = fmaxf(mx, shx(mx, 32, lane));
      const float mnew = fmaxf(m[hh], mx);
      const float alpha = __builtin_amdgcn_exp2f(m[hh] - mnew); m[hh] = mnew;
      float ps = 0.f; float pv[2][4];
#pragma unroll
      for (int tt = 0; tt < 2; ++tt)
#pragma unroll
        for (int j = 0; j < 4; ++j) { const float e = __builtin_amdgcn_exp2f(st[tt][j] - mnew); pv[tt][j] = e; ps += e; }
      lsum[hh] = lsum[hh] * alpha + ps;
      union { unsigned u[4]; bf16x8 v; } Pf;
      Pf.u[0] = pk_bf16(pv[0][0], pv[0][1]); Pf.u[1] = pk_bf16(pv[0][2], pv[0][3]);
      Pf.u[2] = pk_bf16(pv[1][0], pv[1][1]); Pf.u[3] = pk_bf16(pv[1][2], pv[1][3]);
#pragma unroll
      for (int dt = 0; dt < 4; ++dt) {
        f32x4 o = O[hh][dt]; o[0] *= alpha; o[1] *= alpha; o[2] *= alpha; o[3] *= alpha;
        O[hh][dt] = mfma16(Vf[dt], Pf.v, o);
      }
    }
  };
  if (!isctx) {
    attn_stage<400>(QK, PT, Ks, Vs, tid, kvh, rowbase, q0b - 128, SEQ);
    __syncthreads();
#pragma unroll 1
    for (int ci = 0; ci < 9; ++ci) {
      const int kp0 = q0 - 128 + 32 * ci;
      chunk(16 * wave + 32 * ci, kp0, ci == 0 || ci == 8 || kp0 < 0 || kp0 + 31 >= SEQ);
    }
    __syncthreads();
  }
  attn_stage<256>(QK, PT, Ks, Vs, tid, kvh, ctxbase, 0, CTXL);
  __syncthreads();
#pragma unroll 1
  for (int ci = 0; ci < 8; ++ci) chunk(32 * ci, 32 * ci, false);
#pragma unroll
  for (int hh = 0; hh < 4; ++hh) {
    float ls = lsum[hh]; ls += shx(ls, 16, lane); ls += shx(ls, 32, lane);
    const float sink = p.in[27][l * 8 + kvh * 4 + hh] * 1.4426950408889634f;
    const float inv = 1.f / (ls + __builtin_amdgcn_exp2f(sink - m[hh]));
#pragma unroll
    for (int dt = 0; dt < 4; ++dt) {
      uint2 o; o.x = pk_bf16(O[hh][dt][0] * inv, O[hh][dt][1] * inv); o.y = pk_bf16(O[hh][dt][2] * inv, O[hh][dt][3] * inv);
      *(uint2*)(YC + (size_t)qrow * D + 512 + (kvh * 4 + hh) * 64 + 16 * dt + 4 * g) = o;
    }
  }
  __syncthreads();
}

DEVI void lru_item(const Params& p, int l, int item, int pass) {
  const u16* PT = (const u16*)(p.ws + OFF_PT); u16* YC = (u16*)(p.ws + OFF_H);
  float2* SUMM = (float2*)(p.ws + OFF_SUMM);
  const int ch = item >> 2, n = item & 3;
  const int isctx = ch >= 256;
  int b, tq; if (!isctx) { b = ch >> 5; tq = ch & 31; } else { b = (ch - 256) >> 1; tq = (ch - 256) & 1; }
  const int Lseq = isctx ? CTXL : SEQ, rowbase = isctx ? TL + b * CTXL : b * SEQ, t0 = tq * 128;
  float* xs = (float*)smem;
  u16* ub = (u16*)(xs + 64 * 145);
  float* ex = (float*)(ub + 128 * 72);
  float* sm = ex + 8 * 16 * 65;
  float* hc = sm + 2 * 8 * 64 * 2;
  float2* ss = (float2*)(hc + 128);
  const int tid = otid(), e = tid & 63, tg = tid >> 6, c = n * 64 + e, lane = e, fr = lane & 15, g = lane >> 4;
  { bf16x8 xv[3];
#pragma unroll
    for (int i = 0; i < 3; ++i) {
      const int idx = tid + i * NTHREADS, chn = idx / 18, ck = idx % 18, t = t0 - 8 + ck * 8;
      xv[i] = (bf16x8){0, 0, 0, 0, 0, 0, 0, 0};
      if (idx < 64 * 18 && t >= 0 && t < Lseq) xv[i] = *(const bf16x8*)(PT + (size_t)(n * 64 + chn) * T + rowbase + t);
    }
#pragma unroll
    for (int i = 0; i < 3; ++i) {
      const int idx = tid + i * NTHREADS, chn = idx / 18, ck = idx % 18;
      if (idx < 64 * 18) {
#pragma unroll
        for (int q = 0; q < 8; ++q) xs[chn * 145 + ck * 8 + q] = bf2f((u16)xv[i][q]);
      }
    } }
  if (pass) {
    float2 sv[9];
#pragma unroll
    for (int i = 0; i < 9; ++i) {
      const int idx = tid + i * NTHREADS;
      const int d = idx / (34 * 64), rem = idx % (34 * 64), j = rem >> 6, ee = rem & 63;
      const int cidx = j < 2 ? 256 + b * 2 + j : b * 32 + (j - 2);
      sv[i] = make_float2(0.f, 0.f);
      if (idx < 2 * 34 * 64) sv[i] = SUMM[((size_t)d * 272 + cidx) * 256 + n * 64 + ee];
    }
#pragma unroll
    for (int i = 0; i < 9; ++i) { const int idx = tid + i * NTHREADS; if (idx < 2 * 34 * 64) ss[idx] = sv[i]; }
  }
  __syncthreads();
  float uo[16];
  { const float* cw = p.in[11] + (size_t)l * 4 * 256 + c;
    const float w0 = cw[0], w1 = cw[256], w2 = cw[512], w3 = cw[768], cb = p.in[12][l * 256 + c];
    const float* xr = xs + e * 145 + 8 + 16 * tg;
#pragma unroll
    for (int tt = 0; tt < 16; ++tt) { const float u = cb + w0 * xr[tt - 2] + w1 * xr[tt - 1] + w2 * xr[tt] + w3 * xr[tt + 1]; uo[tt] = u; ub[(16 * tg + tt) * 72 + e] = f2bf(u); } }
  if (pass && tid < 128) {
    const int d = tid >> 6, ee = tid & 63, my = isctx ? tq : 2 + tq;
    const float2* S = ss + d * 34 * 64 + ee;
    float h = 0.f;
    if (d == 0) { for (int j = 0; j < my; ++j) { const float2 sv = S[j * 64]; h = sv.x * h + sv.y; } }
    else {
      if (my < 2) { for (int j = 1; j > my; --j) { const float2 sv = S[j * 64]; h = sv.x * h + sv.y; } }
      else {
        { const float2 sv = S[1 * 64]; h = sv.x * h + sv.y; }
        { const float2 sv = S[0 * 64]; h = sv.x * h + sv.y; }
        for (int j = 33; j > my; --j) { const float2 sv = S[j * 64]; h = sv.x * h + sv.y; }
      }
    }
    hc[tid] = h;
  }
  __syncthreads();
  if (pass) {
    bf16x8 gv2[2];
#pragma unroll
    for (int i = 0; i < 2; ++i) { const int idx = tid + i * NTHREADS, chn = idx >> 4, ck = idx & 15; gv2[i] = *(const bf16x8*)(PT + (size_t)(256 + n * 64 + chn) * T + rowbase + t0 + ck * 8); }
#pragma unroll
    for (int i = 0; i < 2; ++i) { const int idx = tid + i * NTHREADS, chn = idx >> 4, ck = idx & 15;
#pragma unroll
      for (int q = 0; q < 8; ++q) xs[chn * 145 + 8 + ck * 8 + q] = bf2f((u16)gv2[i][q]); }
  }
  const bf16x8 A0 = *(const bf16x8*)(ub + (16 * tg + fr) * 72 + 8 * g), A1 = *(const bf16x8*)(ub + (16 * tg + fr) * 72 + 32 + 8 * g);
  const u16* WGT = (const u16*)(p.ws + OFF_WGT);
  float* exw = ex + tg * 16 * 65;
  float av[2][16], bv[2][16];
#pragma unroll
  for (int d = 0; d < 2; ++d) {
    float pre[2][16];
#pragma unroll
    for (int mat = 0; mat < 2; ++mat) {
      const u16* wb = WGT + (size_t)((((l * 2 + d) * 2 + mat) * 4 + n) * 64) * 64 + 8 * g;
      f32x4 acc[4];
#pragma unroll
      for (int nt = 0; nt < 4; ++nt) {
        const bf16x8 B0 = *(const bf16x8*)(wb + (16 * nt + fr) * 64), B1 = *(const bf16x8*)(wb + (16 * nt + fr) * 64 + 32);
        f32x4 z = {0.f, 0.f, 0.f, 0.f};
        z = mfma16(A0, B0, z); z = mfma16(A1, B1, z); acc[nt] = z;
      }
      asm volatile("s_waitcnt lgkmcnt(0)" ::: "memory");
#pragma unroll
      for (int nt = 0; nt < 4; ++nt)
#pragma unroll
        for (int j = 0; j < 4; ++j) exw[(4 * g + j) * 65 + 16 * nt + fr] = acc[nt][j];
      asm volatile("s_waitcnt lgkmcnt(0)" ::: "memory");
#pragma unroll
      for (int tt = 0; tt < 16; ++tt) pre[mat][tt] = exw[tt * 65 + lane];
    }
    const float ba = p.in[14][(l * 2 + d) * 256 + c], bx = p.in[16][(l * 2 + d) * 256 + c];
    const float lam = p.in[17][(l * 2 + d) * 256 + c];
    const float exl = __expf(-lam); const float sp = exl < 0.03f ? exl * (1.f - exl * (0.5f - exl * (0.33333334f - 0.25f * exl))) : __logf(1.f + exl);
    float Ap = 1.f, Bp = 0.f;
#pragma unroll
    for (int q = 0; q < 16; ++q) {
      const int tt = d == 0 ? q : 15 - q;
      const float r = sigmoidf_(pre[0][tt] + ba), ig = sigmoidf_(pre[1][tt] + bx);
      const float la = -8.f * r * sp;
      const float a = __expf(la);
      const float om = fmaxf(1.f - a * a, 0.f);
      const float bb = sqrtf(om) * (ig * uo[tt]);
      av[d][tt] = a; bv[d][tt] = bb;
      Bp = a * Bp + bb; Ap *= a;
    }
    sm[((d * 8 + tg) * 64 + e) * 2 + 0] = Ap; sm[((d * 8 + tg) * 64 + e) * 2 + 1] = Bp;
  }
  __syncthreads();
  if (!pass) {
    if (tid < 128) {
      const int d = tid >> 6, ee = tid & 63;
      float A = 1.f, Bc = 0.f;
      if (d == 0) { for (int g2 = 0; g2 < 8; ++g2) { const float a = sm[((0 * 8 + g2) * 64 + ee) * 2], bq = sm[((0 * 8 + g2) * 64 + ee) * 2 + 1]; Bc = a * Bc + bq; A *= a; } }
      else { for (int g2 = 7; g2 >= 0; --g2) { const float a = sm[((1 * 8 + g2) * 64 + ee) * 2], bq = sm[((1 * 8 + g2) * 64 + ee) * 2 + 1]; Bc = a * Bc + bq; A *= a; } }
      SUMM[((size_t)d * 272 + ch) * 256 + n * 64 + ee] = make_float2(A, Bc);
    }
  } else {
    float hs[16];
    { float h = hc[e];
      for (int g2 = 0; g2 < tg; ++g2) { const float a = sm[((0 * 8 + g2) * 64 + e) * 2], bq = sm[((0 * 8 + g2) * 64 + e) * 2 + 1]; h = a * h + bq; }
#pragma unroll
      for (int tt = 0; tt < 16; ++tt) { h = av[0][tt] * h + bv[0][tt]; hs[tt] = h; } }
    { float h = hc[64 + e];
      for (int g2 = 7; g2 > tg; --g2) { const float a = sm[((1 * 8 + g2) * 64 + e) * 2], bq = sm[((1 * 8 + g2) * 64 + e) * 2 + 1]; h = a * h + bq; }
#pragma unroll
      for (int tt = 15; tt >= 0; --tt) { h = av[1][tt] * h + bv[1][tt]; hs[tt] += h; } }
    const float* gr = xs + e * 145 + 8 + 16 * tg;
#pragma unroll
    for (int tt = 0; tt < 16; ++tt) {
      const float y = hs[tt] * gelu_tanh(gr[tt]);
      YC[(size_t)(rowbase + t0 + 16 * tg + tt) * D + c] = f2bf(y);
    }
  }
  __syncthreads();
}

DEVI void uprep_phase(const Params& p, int l) {
  const u16* PT = (const u16*)(p.ws + OFF_PT); u16* UT = (u16*)(p.ws + OFF_UT); u16* X0T = (u16*)(p.ws + OFF_X0T);
  constexpr int NCH = T / 8;
  for (int idx = blockIdx.x * NTHREADS + otid(); idx < 256 * NCH; idx += gridDim.x * NTHREADS) {
    const int c = idx / NCH, ck = idx % NCH, row = ck * 8;
    int t, Lseq; if (row < TL) { t = row & 4095; Lseq = SEQ; } else { t = (row - TL) & 255; Lseq = CTXL; }
    float o[3][8];
#pragma unroll
    for (int k = 0; k < 3; ++k) {
      const int col = k * 256 + c;
      const u16* src = PT + (size_t)(512 + col) * T + row;
      const bf16x8 v = *(const bf16x8*)src;
      float x[10];
      x[0] = t > 0 ? bf2f(src[-1]) : 0.f;
      x[9] = (t + 8 < Lseq) ? bf2f(src[8]) : 0.f;
#pragma unroll
      for (int q = 0; q < 8; ++q) x[q + 1] = bf2f((u16)v[q]);
      const float w0 = p.in[18][(l * 3 + 0) * 768 + col], w1 = p.in[18][(l * 3 + 1) * 768 + col], w2 = p.in[18][(l * 3 + 2) * 768 + col], bb = p.in[19][l * 768 + col];
#pragma unroll
      for (int q = 0; q < 8; ++q) o[k][q] = bb + w0 * x[q] + w1 * x[q + 1] + w2 * x[q + 2];
    }
    uint4 uo, xo;
    uo.x = pk_bf16(o[1][0] * o[2][0], o[1][1] * o[2][1]); uo.y = pk_bf16(o[1][2] * o[2][2], o[1][3] * o[2][3]);
    uo.z = pk_bf16(o[1][4] * o[2][4], o[1][5] * o[2][5]); uo.w = pk_bf16(o[1][6] * o[2][6], o[1][7] * o[2][7]);
    xo.x = pk_bf16(o[0][0], o[0][1]); xo.y = pk_bf16(o[0][2], o[0][3]); xo.z = pk_bf16(o[0][4], o[0][5]); xo.w = pk_bf16(o[0][6], o[0][7]);
    *(uint4*)(UT + (size_t)c * T + row) = uo;
    *(uint4*)(X0T + (size_t)c * T + row) = xo;
  }
}

DEVI bf16x8 ld_frag8(const u16* a) { union { uint2 u[2]; bf16x8 v; } f; f.u[0] = *(const uint2*)a; f.u[1] = *(const uint2*)(a + 4); return f.v; }
DEVI void toep_item(const Params& p, int l, int c, int isctx) {
  const int L = isctx ? CTXL : SEQ;
  const u16* KF = isctx ? (const u16*)(p.ws + OFF_KFC) + (size_t)c * 512 : (const u16*)(p.ws + OFF_KF) + (size_t)(l * 256 + c) * 8192;
  u16* R = (u16*)smem; const int CS = 2 * L + 8;
  u16* Us = R + 4 * CS; const int USTR = L + 8;
  const int tid = otid(), wave = tid >> 6, lane = tid & 63, fr = lane & 15, g = lane >> 4;
  const u16* Uc = (const u16*)(p.ws + OFF_UT) + (size_t)c * T;
  const u16* X0c = (const u16*)(p.ws + OFF_X0T) + (size_t)c * T;
  for (int q = tid; q < (2 * L) / 8; q += NTHREADS) {
    const bf16x8 v = *(const bf16x8*)(KF + 8 * q);
#pragma unroll
    for (int mm = 0; mm < 4; ++mm)
#pragma unroll
      for (int e = 0; e < 8; ++e) R[mm * CS + 8 * q + e + mm] = (u16)v[e];
  }
  if (tid < 32) { const int mm = tid >> 3, e = tid & 7; if (e < mm) R[mm * CS + e] = 0; else R[mm * CS + 2 * L + e] = 0; }
  for (int q = tid; q < L; q += NTHREADS) {
    const int bb = q / (L / 8), ck = q % (L / 8);
    const size_t row = (isctx ? (size_t)TL + (size_t)bb * CTXL : (size_t)bb * SEQ) + ck * 8;
    *(uint4*)(Us + bb * USTR + ck * 8) = *(const uint4*)(Uc + row);
  }
  __syncthreads();
  u16* YHc = (u16*)(p.ws + OFF_YHT) + (size_t)c * T;
  const float skip = p.in[26][l * 256 + c];
  const int nT = L / 256;
  const int mcp = fr & 3;
  const u16* Rl = R + mcp * CS + (L + 8 * g - (fr - mcp));
  const u16* Ul = Us + (fr & 7) * USTR + 8 * g;
  const size_t urow = isctx ? (size_t)TL + (size_t)(fr & 7) * CTXL : (size_t)(fr & 7) * SEQ;
  for (int wt = wave; wt < nT; wt += 8) {
    const int T0 = wt * 256;
    f32x4 acc[16];
#pragma unroll
    for (int m8 = 0; m8 < 16; ++m8) acc[m8] = (f32x4){0.f, 0.f, 0.f, 0.f};
    bf16x8 F[16];
#pragma unroll
    for (int m8 = 2; m8 < 16; ++m8) F[m8] = ld_frag8(Rl + (0 - T0 - 16 * m8));
#pragma unroll 1
    for (int s0 = 0; s0 < L; s0 += 256) {
#pragma unroll
      for (int k = 0; k < 8; ++k) {
        const int s = s0 + 32 * k;
        const bf16x8 Bf = *(const bf16x8*)(Ul + s);
        F[(16 - 2 * k) & 15] = ld_frag8(Rl + (s - T0));
        F[(17 - 2 * k) & 15] = ld_frag8(Rl + (s - T0 - 16));
#pragma unroll
        for (int m8 = 0; m8 < 16; ++m8) acc[m8] = mfma16(F[(m8 + 16 - 2 * k) & 15], Bf, acc[m8]);
      }
    }
    if (fr < 8) {
#pragma unroll
      for (int m8 = 0; m8 < 16; ++m8) {
        const size_t row = urow + T0 + 16 * m8 + 4 * g;
        const bf16x4 u4 = *(const bf16x4*)(Us + fr * USTR + T0 + 16 * m8 + 4 * g), x4 = *(const bf16x4*)(X0c + row);
        float y[4];
#pragma unroll
        for (int j = 0; j < 4; ++j) y[j] = bf2f((u16)x4[j]) * (acc[m8][j] + skip * bf2f((u16)u4[j]));
        uint2 o; o.x = pk_bf16(y[0], y[1]); o.y = pk_bf16(y[2], y[3]);
        *(uint2*)(YHc + row) = o;
      }
    }
  }
  __syncthreads();
}

DEVI void toep_item_lat(const Params& p, int l, int c) {
  constexpr int L = SEQ, HL = SEQ / 2, CS = 2 * L + 8, USTR = L + 8;
  const u16* KF = (const u16*)(p.ws + OFF_KF) + (size_t)(l * 256 + c) * 8192;
  u16* R = (u16*)smem;
  u16* Us = R + 4 * CS;
  const int tid = otid(), wave = tid >> 6, lane = tid & 63, fr = lane & 15, g = lane >> 4;
  const u16* Uc = (const u16*)(p.ws + OFF_UT) + (size_t)c * T;
  const u16* X0c = (const u16*)(p.ws + OFF_X0T) + (size_t)c * T;
  { const bf16x8 v0 = *(const bf16x8*)(KF + 8 * tid), v1 = *(const bf16x8*)(KF + 8 * (tid + NTHREADS));
#pragma unroll
    for (int mm = 0; mm < 4; ++mm)
#pragma unroll
      for (int e = 0; e < 8; ++e) { R[mm * CS + 8 * tid + e + mm] = (u16)v0[e]; R[mm * CS + 8 * (tid + NTHREADS) + e + mm] = (u16)v1[e]; } }
  if (tid < 32) { const int mm = tid >> 3, e = tid & 7; if (e < mm) R[mm * CS + e] = 0; else R[mm * CS + 2 * L + e] = 0; }
  { uint4 uu[8];
#pragma unroll
    for (int b2 = 0; b2 < 8; ++b2) uu[b2] = *(const uint4*)(Uc + (size_t)b2 * SEQ + tid * 8);
#pragma unroll
    for (int b2 = 0; b2 < 8; ++b2) *(uint4*)(Us + b2 * USTR + tid * 8) = uu[b2]; }
  __syncthreads();
  u16* YHc = (u16*)(p.ws + OFF_YHT) + (size_t)c * T;
  const float skip = p.in[26][l * 256 + c];
  const int mcp = fr & 3, bb = fr & 7, hh = fr >> 3;
  const u16* Rl = R + mcp * CS + (L + 8 * g - (fr - mcp));
  const u16* Ul = Us + bb * USTR + HL * hh + 8 * g;
  const int T0 = wave * 256;
  f32x4 acc[16];
#pragma unroll
  for (int m8 = 0; m8 < 16; ++m8) acc[m8] = (f32x4){0.f, 0.f, 0.f, 0.f};
  bf16x8 F[16];
#pragma unroll
  for (int m8 = 2; m8 < 16; ++m8) F[m8] = ld_frag8(Rl + (-HL - T0 - 16 * m8));
#pragma unroll 1
  for (int s0 = -HL; s0 < L; s0 += 256) {
#pragma unroll
    for (int k = 0; k < 8; ++k) {
      const int s = s0 + 32 * k;
      const int ui = s + HL * hh + 8 * g;
      const bool ok = (unsigned)ui < (unsigned)L;
      bf16x8 Bf = *(const bf16x8*)(Ul + (ok ? s : -(HL * hh)));
      if (!ok) Bf = (bf16x8){0, 0, 0, 0, 0, 0, 0, 0};
      F[(16 - 2 * k) & 15] = ld_frag8(Rl + (s - T0));
      F[(17 - 2 * k) & 15] = ld_frag8(Rl + (s - T0 - 16));
#pragma unroll
      for (int m8 = 0; m8 < 16; ++m8) acc[m8] = mfma16(F[(m8 + 16 - 2 * k) & 15], Bf, acc[m8]);
    }
  }
#pragma unroll
  for (int m8 = 0; m8 < 16; ++m8) {
    const int tt = HL * hh + T0 + 16 * m8 + 4 * g;
    const size_t row = (size_t)bb * SEQ + tt;
    const bf16x4 u4 = *(const bf16x4*)(Us + bb * USTR + tt), x4 = *(const bf16x4*)(X0c + row);
    float y[4];
#pragma unroll
    for (int j = 0; j < 4; ++j) y[j] = bf2f((u16)x4[j]) * (acc[m8][j] + skip * bf2f((u16)u4[j]));
    uint2 o; o.x = pk_bf16(y[0], y[1]); o.y = pk_bf16(y[2], y[3]);
    *(uint2*)(YHc + row) = o;
  }
  __syncthreads();
}

DEVI void yht_phase(const Params& p, int Mrows) {
  const u16* YHT = (const u16*)(p.ws + OFF_YHT); u16* YC = (u16*)(p.ws + OFF_H);
  u16* tile = (u16*)smem;
  const int tid = otid();
  const int nit = (Mrows / 64) * 4;
  for (int it = blockIdx.x; it < nit; it += gridDim.x) {
    const int cg = it & 3, row0 = (it >> 2) * 64;
    { const int chn = tid >> 3, ck = tid & 7;
      *(uint4*)(tile + chn * 72 + ck * 8) = *(const uint4*)(YHT + (size_t)(cg * 64 + chn) * T + row0 + ck * 8); }
    __syncthreads();
    { const int r = tid >> 3, q = tid & 7;
      const u16* tp = tile + (q * 8) * 72 + r;
      uint4 o;
      o.x = (unsigned)tp[0] | ((unsigned)tp[72] << 16); o.y = (unsigned)tp[144] | ((unsigned)tp[216] << 16);
      o.z = (unsigned)tp[288] | ((unsigned)tp[360] << 16); o.w = (unsigned)tp[432] | ((unsigned)tp[504] << 16);
      *(uint4*)(YC + (size_t)(row0 + r) * D + 256 + cg * 64 + q * 8) = o; }
    __syncthreads();
  }
}

#define XB_TMO      128
#define XB_XCNT(j)  (256  + 64 * (j))
#define XB_XSUB(j)  (1280 + 64 * (j))
#define XB_XGEN(j)  (2304 + 64 * (j))
#define XB_TOP      3328
#define XB_TOPGEN   3392
#define XCD_BAR_WORDS 3456
#define XB_SPIN_CAP (1u << 18)
DEVI unsigned xb_ld(unsigned* q)              { return __hip_atomic_load(q, __ATOMIC_RELAXED, __HIP_MEMORY_SCOPE_AGENT); }
DEVI unsigned xb_add(unsigned* q, unsigned v) { return __hip_atomic_fetch_add(q, v, __ATOMIC_RELAXED, __HIP_MEMORY_SCOPE_AGENT); }
DEVI unsigned xb_xcc_id() { return (unsigned)__builtin_amdgcn_s_getreg((3 << 11) | 20) & 0xFu; }
#define XB_SPIN(cond, bar) do { unsigned _sp = 0; while (cond) { __builtin_amdgcn_s_sleep(1); \
    if ((++_sp & 255u) == 0u) { if (xb_ld(&(bar)[XB_TMO])) break; if (_sp > XB_SPIN_CAP) { atomicAdd(&(bar)[XB_TMO], 1u); break; } } } } while (0)
DEVI void xcd_barrier_complete(unsigned* bar, unsigned x, unsigned& nloc, unsigned& nx) {
  const unsigned G = gridDim.x;
  unsigned sum, cnt, mine, sp = 0u;
  for (;;) {
    sum = 0u; cnt = 0u; mine = 0u;
#pragma unroll
    for (unsigned j = 0; j < 16; ++j) { const unsigned c = xb_ld(&bar[XB_XCNT(j)]); sum += c; cnt += (c > 0u) ? 1u : 0u; mine = (j == x) ? c : mine; }
    if (sum == G) break;
    __builtin_amdgcn_s_sleep(1);
    if ((++sp & 255u) == 0u) { if (xb_ld(&bar[XB_TMO])) break; if (sp > XB_SPIN_CAP) { atomicAdd(&bar[XB_TMO], 1u); break; } }
  }
  nloc = mine > 0u ? mine : 1u; nx = cnt > 0u ? cnt : 1u;
}
DEVI void xcd_barrier(const Params& p) {
  asm volatile("s_waitcnt vmcnt(0)" ::: "memory");
  __syncthreads();
  if (otid() == 0) {
    unsigned* bar = (unsigned*)(p.ws + OFF_BAR);
    volatile unsigned* st = (volatile unsigned*)(smem + LDS_BYTES - 256);
    const unsigned x = xb_xcc_id();
    __builtin_amdgcn_s_waitcnt(0);
    unsigned nloc = st[0], nx = st[1];
    if (nloc == 0u) { xcd_barrier_complete(bar, x, nloc, nx); st[0] = nloc; st[1] = nx; }
    const unsigned old = xb_add(&bar[XB_XSUB(x)], 1u);
    const unsigned gen = old / nloc;
    if (old + 1u == (gen + 1u) * nloc) {
      __builtin_amdgcn_fence(__ATOMIC_RELEASE, "agent");
      asm volatile("s_waitcnt vmcnt(0)" ::: "memory");
      const unsigned og = xb_add(&bar[XB_TOP], 1u);
      const unsigned tg = og / nx;
      if (og + 1u == (tg + 1u) * nx) xb_add(&bar[XB_TOPGEN], 1u);
      else XB_SPIN(xb_ld(&bar[XB_TOPGEN]) == tg, bar);
      __builtin_amdgcn_fence(__ATOMIC_ACQUIRE, "agent");
      xb_add(&bar[XB_XGEN(x)], 1u);
      asm volatile("s_waitcnt vmcnt(0)" ::: "memory");
    } else {
      XB_SPIN(xb_ld(&bar[XB_XGEN(x)]) == gen, bar);
      __builtin_amdgcn_fence(__ATOMIC_ACQUIRE, "agent");
      asm volatile("s_waitcnt vmcnt(0)" ::: "memory");
    }
  }
  __syncthreads();
}

#ifndef PROBE
#define PROBE -1
#endif
#define GSYNC() xcd_barrier(p)
#define PHASE(id, ...) do { { const float rcf = 1.f; (void)rcf; __VA_ARGS__ } GSYNC(); if (PROBE == (id)) { { const float rcf = 0.f; (void)rcf; __VA_ARGS__ } GSYNC(); } } while (0)
__global__ void __launch_bounds__(NTHREADS) mega(Params p_in) {
  cg::grid_group grid = cg::this_grid();
  Params p = p_in;
  p.wv = __builtin_amdgcn_readfirstlane((int)(threadIdx.x >> 6));
  if (threadIdx.x == 0) {
    volatile unsigned* st = (volatile unsigned*)(smem + LDS_BYTES - 256); st[0] = 0u; st[1] = 0u;
    (void)xb_add(&((unsigned*)(p.ws + OFF_BAR))[XB_XCNT(xb_xcc_id())], 1u);
  }
  __syncthreads();
  phase0(p);
  grid.sync();
  if (PROBE == 0) { phase0(p); GSYNC(); }
  float* const SSQ = (float*)(p.ws + OFF_SSQ);
  const float* const GVt = (const float*)(p.ws + OFF_GV);
#pragma unroll 1
  for (int l = 0; l < 2; ++l) {
    const int Mpost = l == 0 ? T : TL;
    if (l == 0) PHASE(1, norm_phase(p, 0, 0, 0, T, true); prep2_phase(p);
      { const f32x4* src = (const f32x4*)p.in[2]; f32x4* dst = (f32x4*)((float*)(p.ws + OFF_X) + (size_t)TL * D);
        for (int i = blockIdx.x * NTHREADS + otid(); i < TC * D / 4; i += gridDim.x * NTHREADS) dst[i] = src[i]; });
    PHASE(2, { EpiAct e{(u16*)(p.ws + OFF_BIG), l == 1 ? SSQ + (size_t)1 * 4 * T : nullptr, (const float*)(p.ws + OFF_SW1)};
      gemm_phase(p, (const u16*)(p.ws + OFF_H), (const u16*)(p.ws + OFF_W1T) + (size_t)(l * 2 + 0) * 5632 * 1024, T, 2 * DFF, D, 0, e); });
    PHASE(3, { float* X = (float*)(p.ws + OFF_X); const float* modl = (const float*)(p.ws + OFF_MOD) + (size_t)l * 9 * 9216;
      const u16* W2 = (const u16*)(p.ws + OFF_W2T) + (size_t)(l * 2 + 0) * 1024 * 2816;
      EpiRes e{(l == 0 && rcf != 0.f) ? p.in[0] : X, X + (size_t)TL * D, X, modl, 2, 0.5f * rcf,
               rcf != 0.f ? (u16*)(p.ws + OFF_H) : nullptr, GVt + (size_t)(l * 3 + 1) * 9 * D, rcf != 0.f ? SSQ + (size_t)(l == 0 ? 0 : 2) * 4 * T : nullptr, (u16*)(p.ws + OFF_PS)};
      gemm_phase(p, (const u16*)(p.ws + OFF_BIG), W2, TL, D, DFF, TC, e); });
    PHASE(14, ctx_combine_phase(p, l, 2, 0.5f * rcf, l, 1););
    PHASE(4, { EpiProj e{(u16*)(p.ws + OFF_PT), (u16*)(p.ws + OFF_QK), (const float*)(p.ws + OFF_ROPE), (const float*)(p.ws + OFF_ROPE) + 4096 * 32,
                         SSQ + (size_t)(l == 0 ? 0 : 2) * 4 * T, (const float*)(p.ws + OFF_SWIN) + (size_t)l * 9 * 2048};
      gemm_phase(p, (const u16*)(p.ws + OFF_H), (const u16*)(p.ws + OFF_WINT) + (size_t)l * 2048 * 1024, T, DIN, D, 0, e); });
    PHASE(5, { const int n_att = l == 0 ? 512 + 32 : 512, n_lru = 1088;
      for (int it = blockIdx.x; it < n_att + n_lru; it += gridDim.x) { if (it < n_att) attn_item(p, l, it); else lru_item(p, l, it - n_att, 0); }
      uprep_phase(p, l); });
    if (PROBE == 8) { for (int it = blockIdx.x; it < 1088; it += gridDim.x) lru_item(p, l, it, 0); GSYNC(); }
    if (PROBE == 9) { for (int it = blockIdx.x; it < 512; it += gridDim.x) attn_item(p, l, it); GSYNC(); }
    if (PROBE == 11) { uprep_phase(p, l); GSYNC(); }
    PHASE(6, { const int n_t1 = 256, n_t2 = l == 0 ? 256 : 0, n_lru = l == 0 ? 1088 : 1024;
      for (int it = blockIdx.x; it < n_t1 + n_t2 + n_lru; it += gridDim.x) {
        if (it < n_t1) toep_item_lat(p, l, it);
        else if (it < n_t1 + n_t2) toep_item(p, l, it - n_t1, 1);
        else lru_item(p, l, it - n_t1 - n_t2, 1);
      } });
    if (PROBE == 10) { for (int it = blockIdx.x; it < 256; it += gridDim.x) toep_item_lat(p, l, it); GSYNC(); }
    PHASE(12, yht_phase(p, Mpost););
    PHASE(7, { float* X = (float*)(p.ws + OFF_X); const float* modl = (const float*)(p.ws + OFF_MOD) + (size_t)l * 9 * 9216;
      const u16* WO = (const u16*)(p.ws + OFF_WOT) + (size_t)l * 1024 * 1024;
      EpiRes e{X, X + (size_t)TL * D, X, modl, 5, 1.0f * rcf, nullptr, nullptr, nullptr, (u16*)(p.ws + OFF_PS)};
      gemm_phase(p, (const u16*)(p.ws + OFF_H), WO, TL, D, D, l == 0 ? TC : 0, e); });
    PHASE(1, norm_phase(p, l, 2, 0, TL, false); if (l == 0) ctx_combine_phase(p, 0, 5, 1.0f * rcf, 0, 2););
    PHASE(2, { EpiAct e{(u16*)(p.ws + OFF_BIG), nullptr, nullptr};
      gemm_phase(p, (const u16*)(p.ws + OFF_H), (const u16*)(p.ws + OFF_W1T) + (size_t)(l * 2 + 1) * 5632 * 1024, Mpost, 2 * DFF, D, 0, e); });
    PHASE(3, { float* X = (float*)(p.ws + OFF_X); const float* modl = (const float*)(p.ws + OFF_MOD) + (size_t)l * 9 * 9216;
      const u16* W2 = (const u16*)(p.ws + OFF_W2T) + (size_t)(l * 2 + 1) * 1024 * 2816;
      EpiRes e{X, X + (size_t)TL * D, X, modl, 8, 0.5f * rcf,
               (l == 0 && rcf != 0.f) ? (u16*)(p.ws + OFF_H) : nullptr, GVt + (size_t)(1 * 3 + 0) * 9 * D, (l == 0 && rcf != 0.f) ? SSQ + (size_t)1 * 4 * T : nullptr, (u16*)(p.ws + OFF_PS)};
      gemm_phase(p, (const u16*)(p.ws + OFF_BIG), W2, TL, D, DFF, l == 0 ? TC : 0, e); });
    if (l == 0) PHASE(14, ctx_combine_phase(p, 0, 8, 0.5f * rcf, 1, 0););
  }
  if (PROBE == 13) { for (int i = 0; i < 20; ++i) GSYNC(); }
  final_norm_phase(p);
}

extern "C" void kernel_launch(void* const* d_in, const int* in_sizes, int n_in, void* d_out, int out_size, void* d_ws, size_t ws_size, hipStream_t stream) {
  static int grid_blocks = 0;
  if (!grid_blocks) {
    if (ws_size < WS_END || n_in != 29) { fprintf(stderr, "kernel_launch: workspace %zu < %zu or n_in %d != 29\n", ws_size, (size_t)WS_END, n_in); grid_blocks = -1; return; }
    int dev = 0, cus = 0, per_cu = 0;
    hipGetDevice(&dev);
    hipDeviceGetAttribute(&cus, hipDeviceAttributeMultiprocessorCount, dev);
    if (hipFuncSetAttribute((const void*)mega, hipFuncAttributeMaxDynamicSharedMemorySize, LDS_BYTES) != hipSuccess) { fprintf(stderr, "hipFuncSetAttribute failed\n"); }
    hipOccupancyMaxActiveBlocksPerMultiprocessor(&per_cu, (const void*)mega, NTHREADS, LDS_BYTES);
    if (per_cu < 1) { fprintf(stderr, "occupancy query returned %d\n", per_cu); per_cu = 1; }
    if (per_cu > 1) per_cu = 1;
    grid_blocks = cus * per_cu;
    (void)hipGetLastError();
  }
  if (grid_blocks < 0) return;
  Params p{};
  for (int i = 0; i < 29; ++i) p.in[i] = (const float*)d_in[i];
  p.out = (float*)d_out; p.ws = (unsigned char*)d_ws;
  if (hipMemsetAsync((char*)d_ws + OFF_BAR, 0, (size_t)3456 * 4, stream) != hipSuccess) { fprintf(stderr, "kernel_launch: memset of the barrier words failed\n"); return; }
  void* args[] = {&p};
  hipError_t e = hipLaunchCooperativeKernel((void*)mega, dim3(grid_blocks), dim3(NTHREADS), args, LDS_BYTES, stream);
  if (e != hipSuccess) fprintf(stderr, "cooperative launch failed: %s (grid %d)\n", hipGetErrorString(e), grid_blocks);
}
```

```cpp
#include <hip/hip_runtime.h>
#include <hip/hip_cooperative_groups.h>
#include <cstdio>
namespace cg = cooperative_groups;

using bf16x8 = __attribute__((ext_vector_type(8))) short;
using bf16x4 = __attribute__((ext_vector_type(4))) short;
using f32x4  = __attribute__((ext_vector_type(4))) float;
typedef unsigned short u16;
#define DEVI __device__ __forceinline__

constexpr int D = 1024, NB = 8, SEQ = 4096, CTXL = 256, TL = NB * SEQ, TC = NB * CTXL, T = TL + TC;
constexpr int DFF = 2816, DIN = 2048;
constexpr int NTHREADS = 512;
constexpr int LDS_BYTES = 163840;

constexpr size_t OFF_X    = 0;
constexpr size_t OFF_H    = OFF_X + (size_t)T * D * 4;
constexpr size_t OFF_BIG  = OFF_H + (size_t)T * D * 2;
constexpr size_t OFF_PT   = OFF_BIG;
constexpr size_t OFF_QK   = OFF_PT + (size_t)1408 * T * 2;
constexpr size_t OFF_UT   = OFF_QK + (size_t)T * 640 * 2;
constexpr size_t OFF_X0T  = OFF_UT + (size_t)256 * T * 2;
constexpr size_t OFF_SUMM = OFF_X0T + (size_t)256 * T * 2;
constexpr size_t OFF_W1T  = OFF_BIG + (size_t)T * DFF * 2;
constexpr size_t OFF_W2T  = OFF_W1T + (size_t)4 * 5632 * 1024 * 2;
constexpr size_t OFF_WINT = OFF_W2T + (size_t)4 * 1024 * 2816 * 2;
constexpr size_t OFF_WOT  = OFF_WINT + (size_t)2 * 2048 * 1024 * 2;
constexpr size_t OFF_MOD  = OFF_WOT + (size_t)2 * 1024 * 1024 * 2;
constexpr size_t OFF_KF   = OFF_MOD + (size_t)2 * 9 * 9216 * 4;
constexpr size_t OFF_KFC  = OFF_KF + (size_t)2 * 256 * 8192 * 2;
constexpr size_t OFF_ROPE = OFF_KFC + (size_t)256 * 512 * 2;
constexpr size_t OFF_WGT  = OFF_ROPE + (size_t)2 * 4096 * 32 * 4;
constexpr size_t OFF_GV   = OFF_WGT + (size_t)2 * 2 * 2 * 4 * 64 * 64 * 2;
constexpr size_t OFF_SWIN = OFF_GV + (size_t)6 * 9 * 1024 * 4;
constexpr size_t OFF_SW1  = OFF_SWIN + (size_t)2 * 9 * 2048 * 4;
constexpr size_t OFF_SSQ  = OFF_SW1 + (size_t)9 * 5632 * 4;
constexpr size_t OFF_BAR  = OFF_SSQ + (size_t)3 * 4 * T * 4;
constexpr size_t OFF_YHT  = OFF_BAR + (size_t)3456 * 4;
constexpr size_t OFF_PS   = OFF_YHT;
constexpr size_t WS_END   = OFF_PS + (size_t)7 * TC * D * 2;
static_assert((size_t)256 * T * 2 <= (size_t)7 * TC * D * 2, "YHT must fit inside the PS region");
static_assert(OFF_SUMM + 2 * 272 * 256 * 8 <= OFF_W1T, "mixer buffers overflow ACT region");

struct Params {
  const float* in[29];
  float* out;
  unsigned char* ws;
  int wv, pad_;
};

extern __shared__ __attribute__((aligned(16))) unsigned char smem[];

DEVI unsigned pk_bf16(float lo, float hi) { unsigned r; asm volatile("v_cvt_pk_bf16_f32 %0, %1, %2" : "=v"(r) : "v"(lo), "v"(hi)); return r; }
DEVI u16 f2bf(float x) { return (u16)(pk_bf16(x, 0.f) & 0xffffu); }
DEVI float bf2f(u16 h) { return __uint_as_float(((unsigned)h) << 16); }
DEVI float sigmoidf_(float x) { return __builtin_amdgcn_rcpf(1.f + __expf(-x)); }
DEVI float gelu_tanh(float x) { float z = 0.7978845608028654f * (x + 0.044715f * x * x * x); float th = 1.f - 2.f * __builtin_amdgcn_rcpf(1.f + __expf(2.f * z)); return 0.5f * x * (1.f + th); }
template <class Tp> DEVI const Tp* opaque(const Tp* q) { asm volatile("" : "+s"(q)); return q; }
DEVI int otid_(int wv) { int t; asm volatile("v_mbcnt_lo_u32_b32 %0, -1, 0\n\tv_mbcnt_hi_u32_b32 %0, -1, %0" : "=v"(t)); return (wv << 6) | t; }
#define otid() otid_(p.wv)
DEVI float shx(float v, int o, int lane) { return __int_as_float(__builtin_amdgcn_ds_bpermute((lane ^ o) << 2, __float_as_int(v))); }
DEVI float swz_xor16(float v) { return __int_as_float(__builtin_amdgcn_ds_swizzle(__float_as_int(v), 0x401F)); }
DEVI f32x4 mfma16(bf16x8 a, bf16x8 b, f32x4 c) { return __builtin_amdgcn_mfma_f32_16x16x32_bf16(a, b, c, 0, 0, 0); }

constexpr int BM = 256, BK = 64, HALF = 128, HT = HALF * BK;
DEVI int lds_byte(int r, int c) { int st = (r >> 4) * 2 + (c >> 5), rr = r & 15, cc = c & 31, ob = rr * 64 + cc * 2; return st * 1024 + (ob ^ (((ob >> 9) & 1) << 5)); }
DEVI void stage_rc(int b, int& R, int& C) { int st = b / 1024, sb = b % 1024, swz = sb ^ (((sb >> 9) & 1) << 5); R = (st >> 1) * 16 + swz / 64; C = (st & 1) * 32 + (swz % 64) / 2; }

DEVI bool tile_next(int i, int nM, int nN, int& pm, int& pn) {
  const int nwg = nM * nN; const long Lx = (long)i * gridDim.x + blockIdx.x; if (Lx >= nwg) return false;
  int wgid = (int)Lx; { const int q = nwg / 8, r = nwg % 8, xcd = wgid % 8, off = wgid / 8; wgid = (xcd < r ? xcd * (q + 1) : r * (q + 1) + (xcd - r) * q) + off; }
  constexpr int WGM = 4; const int nig = WGM * nN, gid = wgid / nig, fm = gid * WGM, gsz = (nM - fm) < WGM ? (nM - fm) : WGM;
  pm = fm + ((wgid % nig) % gsz); pn = (wgid % nig) / gsz; return true;
}
template <class Epi>
DEVI void gemm_phase(const Params& p, const u16* __restrict__ A, const u16* __restrict__ Bt, const int M, const int N, const int K, const int Msplit, const Epi& epi) {
  u16* shm = (u16*)smem;
#define SA(b, h) (shm + ((b) * 2 + (h)) * HT)
#define SB(b, h) (shm + (4 + (b) * 2 + (h)) * HT)
#define STAGE(P, BASE, br, kt) do { const char* _ub = (const char*)(BASE + (long)(br) * K + (long)(kt) * BK); asm volatile("" : "+s"(_ub)); \
      __builtin_amdgcn_global_load_lds((const unsigned*)(_ub + soff0), (unsigned*)((char*)(P) + p.wv * 1024), 16, 0, 0); \
      __builtin_amdgcn_global_load_lds((const unsigned*)(_ub + soff1), (unsigned*)((char*)(P) + p.wv * 1024 + 8192), 16, 0, 0); } while (0)
#define LDA(dst, b, h) for (int m = 0; m < 4; ++m) for (int k = 0; k < 2; ++k) \
    dst[m][k] = *reinterpret_cast<const bf16x8*>((char*)SA(b, h) + lds_byte(wr * 64 + m * 16 + fr, k * 32 + fq * 8))
#define LDB(dst, b, h) for (int n = 0; n < 2; ++n) for (int k = 0; k < 2; ++k) \
    dst[n][k] = *reinterpret_cast<const bf16x8*>((char*)SB(b, h) + lds_byte(wc * 32 + n * 16 + fr, k * 32 + fq * 8))
#define MMA(ai, bj, At_, Bt_) do { __builtin_amdgcn_s_setprio(1); \
    for (int m = 0; m < 4; ++m) for (int n = 0; n < 2; ++n) for (int k = 0; k < 2; ++k) \
      acc[ai][bj][m][n] = Epi::TR ? __builtin_amdgcn_mfma_f32_16x16x32_bf16(Bt_[n][k], At_[m][k], acc[ai][bj][m][n], 0, 0, 0) \
                                  : __builtin_amdgcn_mfma_f32_16x16x32_bf16(At_[m][k], Bt_[n][k], acc[ai][bj][m][n], 0, 0, 0); \
    __builtin_amdgcn_s_setprio(0); } while (0)
#define WAIT_V(n) asm volatile("s_waitcnt vmcnt(" #n ")" ::: "memory")
#define WAIT_L(n) asm volatile("s_waitcnt lgkmcnt(" #n ")" ::: "memory")
#define BAR __builtin_amdgcn_s_barrier()
#define SCHED __builtin_amdgcn_sched_barrier(0)
#define PRO_K0(brow_, bcol_) do { STAGE(SB(0, 0), Bt, bcol_, 0); STAGE(SA(0, 0), A, brow_, 0); STAGE(SB(0, 1), Bt, (bcol_) + HALF, 0); STAGE(SA(0, 1), A, (brow_) + HALF, 0); } while (0)
#define PRO_K1(brow_, bcol_) do { STAGE(SB(1, 0), Bt, bcol_, 1); STAGE(SA(1, 0), A, brow_, 1); STAGE(SB(1, 1), Bt, (bcol_) + HALF, 1); } while (0)
  const int tid = otid();
  const int wid = tid >> 6, lane = tid & 63, wr = wid >> 2, wc = wid & 3, fr = lane & 15, fq = lane >> 4;
  unsigned soff0, soff1;
  { int r_, c_; stage_rc(tid * 16, r_, c_); soff0 = (unsigned)(r_ * K + c_) * 2u; stage_rc(tid * 16 + 8192, r_, c_); soff1 = (unsigned)(r_ * K + c_) * 2u; }
  const int nM = M / BM, nN = N / BM, ntT = K / BK, nfull = nM * nN, nsl = (Msplit / BM) * nN * 7;
  auto unit_next = [&](const int i, int& pm_, int& pn_, int& kt0_, int& ntl_) -> bool {
    kt0_ = 0; ntl_ = ntT;
    if (tile_next(i, nM, nN, pm_, pn_)) return true;
    const long u = (long)i * gridDim.x + blockIdx.x - nfull; if (u >= nsl) return false;
    const int tl = (int)(u / 7), sl = (int)(u % 7); pm_ = nM + tl / nN; pn_ = tl % nN;
    const int base = (ntT / 7) & ~1;
    kt0_ = sl * base; ntl_ = sl < 6 ? base : ntT - 6 * base;
    return true;
  };
  int pm, pn, kt0, nt;
  bool have = unit_next(0, pm, pn, kt0, nt);
  const u16* A0 = A; const u16* B0p = Bt;
  if (have) { A = A0 + (long)kt0 * BK; Bt = B0p + (long)kt0 * BK; PRO_K0(pm * BM, pn * BM); PRO_K1(pm * BM, pn * BM); }
#pragma unroll 1
  for (int it = 0; have; ++it) {
    const int brow = pm * BM, bcol = pn * BM;
    const int slcur = brow < M ? -1 : kt0 / ((ntT / 7) & ~1);
    int kt0n = 0, ntn = 2;
    const bool have2 = unit_next(it + 1, pm, pn, kt0n, ntn);
    const u16* An = A0 + (long)kt0n * BK; const u16* Bn = B0p + (long)kt0n * BK;
    f32x4 acc[2][2][4][2] = {};
    bf16x8 At[4][2], B0[2][2], B1[2][2];
    if (it == 0) { WAIT_V(0); } else { if constexpr (Epi::NST == 16) WAIT_V(16); else if constexpr (Epi::NST == 32) WAIT_V(32); else WAIT_V(0); }
    if (wr == 1) BAR;
    BAR;
    BAR;
    for (int t = 0; t < nt - 2; t += 2) {
      LDB(B0, 0, 0); SCHED; LDA(At, 0, 0); STAGE(SA(1, 1), A, brow + HALF, t + 1);
      WAIT_L(8); BAR; WAIT_L(0); MMA(0, 0, At, B0); BAR; SCHED;
      LDB(B1, 0, 1); STAGE(SB(0, 0), Bt, bcol, t + 2);
      BAR; WAIT_L(0); MMA(0, 1, At, B1); BAR;
      LDA(At, 0, 1); STAGE(SA(0, 0), A, brow, t + 2);
      BAR; WAIT_L(0); MMA(1, 0, At, B0); BAR; SCHED;
      STAGE(SB(0, 1), Bt, bcol + HALF, t + 2);
      WAIT_V(6); BAR; MMA(1, 1, At, B1); BAR;
      LDB(B0, 1, 0); SCHED; LDA(At, 1, 0); STAGE(SA(0, 1), A, brow + HALF, t + 2);
      WAIT_L(8); BAR; WAIT_L(0); MMA(0, 0, At, B0); BAR; SCHED;
      LDB(B1, 1, 1); STAGE(SB(1, 0), Bt, bcol, t + 3);
      BAR; WAIT_L(0); MMA(0, 1, At, B1); BAR;
      LDA(At, 1, 1); STAGE(SA(1, 0), A, brow, t + 3);
      BAR; WAIT_L(0); MMA(1, 0, At, B0); BAR; SCHED;
      STAGE(SB(1, 1), Bt, bcol + HALF, t + 3);
      WAIT_V(6); BAR; MMA(1, 1, At, B1); BAR;
    }
    { LDB(B0, 0, 0); LDA(At, 0, 0); STAGE(SA(1, 1), A, brow + HALF, nt - 1);
      BAR; WAIT_L(0); MMA(0, 0, At, B0); BAR;
      LDB(B1, 0, 1); BAR; WAIT_L(0); MMA(0, 1, At, B1); BAR;
      LDA(At, 0, 1); WAIT_V(4); BAR; WAIT_L(0); MMA(1, 0, At, B0); MMA(1, 1, At, B1); BAR; }
    { LDB(B0, 1, 0); LDA(At, 1, 0); WAIT_V(2); BAR;
      if (have2) { const u16* Asv = A; const u16* Bsv = Bt; A = An; Bt = Bn; PRO_K0(pm * BM, pn * BM); A = Asv; Bt = Bsv; }
      WAIT_L(0); MMA(0, 0, At, B0); BAR;
      LDB(B1, 1, 1); if (have2) { WAIT_V(8); } else { WAIT_V(0); } BAR; WAIT_L(0); MMA(0, 1, At, B1); BAR;
      LDA(At, 1, 1); BAR; WAIT_L(0); MMA(1, 0, At, B0); MMA(1, 1, At, B1); BAR; }
    if (wr == 0) BAR;
    have = have2;
    A = An; Bt = Bn; nt = ntn; kt0 = kt0n;
    if (have) { PRO_K1(pm * BM, pn * BM); }
    { const int tid2 = otid(), wid2 = tid2 >> 6, lane2 = tid2 & 63, wr2 = wid2 >> 2, wc2 = wid2 & 3, fr2 = lane2 & 15, fq2 = lane2 >> 4;
      float sq[8] = {0.f, 0.f, 0.f, 0.f, 0.f, 0.f, 0.f, 0.f};
      float* rl = (float*)((char*)shm + 3 * HT * 2);
      bool nrm = false;
      if constexpr (Epi::NRM) {
        nrm = epi.ssq != nullptr && brow < TL;
        if (nrm) {
          if (tid2 < 256) { const float* q = epi.ssq + brow + tid2; rl[tid2] = rsqrtf(((q[0] + q[T]) + (q[2 * T] + q[3 * T])) * (1.f / D) + 1e-6f); }
          WAIT_L(0); BAR;
        }
      }
#pragma unroll
      for (int ai = 0; ai < 2; ++ai)
#pragma unroll
        for (int bj = 0; bj < 2; ++bj) {
          const int colb = bcol + bj * HALF + wc2 * 32;
          typename Epi::Pre pre;
          if constexpr (Epi::NRM || Epi::SQ) epi.preload(pre, brow, colb, wr2, fr2, fq2, nrm, slcur);
#pragma unroll
          for (int m = 0; m < 4; ++m) {
            const int rloc = ai * HALF + wr2 * 64 + m * 16;
            if constexpr (Epi::SQ) epi(brow + rloc + fr2, colb, fq2, acc[ai][bj][m][0], acc[ai][bj][m][1], sq[ai * 4 + m], slcur, pre);
            else if constexpr (Epi::TR) { float rv = 1.f; if (nrm) rv = rl[rloc + fr2]; epi(brow + rloc + fr2, colb, fq2, acc[ai][bj][m][0], acc[ai][bj][m][1], rv, nrm, pre); }
            else { f32x4 rv = {1.f, 1.f, 1.f, 1.f}; if (nrm) rv = *(const f32x4*)(rl + rloc + fq2 * 4); epi(brow + rloc + fq2 * 4, colb, fr2, acc[ai][bj][m][0], acc[ai][bj][m][1], rv, nrm, pre); }
          }
        }
      if constexpr (Epi::SQ) {
        if (epi.part && slcur < 0) {
          float* lp = (float*)((char*)shm + 3 * HT * 2);
#pragma unroll
          for (int i = 0; i < 8; ++i) {
            float v = sq[i]; v += swz_xor16(v); v += shx(v, 32, lane2);
            if (fq2 == 0) lp[wc2 * 256 + (i >> 2) * HALF + wr2 * 64 + (i & 3) * 16 + fr2] = v;
          }
          WAIT_L(0); BAR;
          if (tid2 < 256) epi.part[(size_t)(bcol >> 8) * T + brow + tid2] = (lp[tid2] + lp[256 + tid2]) + (lp[512 + tid2] + lp[768 + tid2]);
        }
      } }
  }
  __syncthreads();
#undef SA
#undef SB
#undef STAGE
#undef LDA
#undef LDB
#undef MMA
#undef PRO_K0
#undef PRO_K1
}

struct EpiAct {
  static constexpr bool TR = true, SQ = false, NRM = true; static constexpr int NST = 16;
  u16* act; const float* ssq; const float* sw;
  struct Pre { f32x4 sa, sb; };
  DEVI void preload(Pre& q, int brow, int colb, int wr, int fr, int fq, bool nrm, int) const {
    if (nrm) { const int r = brow < TL ? (brow >> 12) : 8; q.sa = *(const f32x4*)(sw + (size_t)r * 5632 + colb + 4 * fq); q.sb = *(const f32x4*)(sw + (size_t)r * 5632 + colb + 16 + 4 * fq); }
  }
  DEVI void operator()(int row, int colb, int fq, const f32x4& a0, const f32x4& a1, const float rinv, const bool nrm, const Pre& q) const {
    const int oc = (colb >> 5) * 16 + 4 * fq;
    f32x4 xa = a0, xb = a1;
    if (nrm) {
#pragma unroll
      for (int j = 0; j < 4; ++j) { xa[j] = xa[j] * rinv + q.sa[j]; xb[j] = xb[j] * rinv + q.sb[j]; }
    }
    float v[4];
#pragma unroll
    for (int j = 0; j < 4; ++j) { const float a = xa[j]; v[j] = a * sigmoidf_(a) * xb[j]; }
    uint2 o; o.x = pk_bf16(v[0], v[1]); o.y = pk_bf16(v[2], v[3]);
    *(uint2*)(act + (size_t)row * DFF + oc) = o;
  }
};
struct EpiRes {
  static constexpr bool TR = true, SQ = true, NRM = false; static constexpr int NST = 32;
  const float* xin_lat; const float* xin_ctx;
  float* xout; const float* modl;
  int gi; float coef;
  u16* xg; const float* gvl; float* part;
  struct Pre { f32x4 gv[2], G[2]; };
  u16* ps;
  DEVI void preload(Pre& q, int brow, int colb, int wr, int fr, int fq, bool, int slice) const {
    if (slice >= 0) return;
    const int r = brow < TL ? (brow >> 12) : 8;
    const float* gate = modl + (size_t)(r * 9 + gi) * D;
#pragma unroll
    for (int n = 0; n < 2; ++n) {
      const int col = colb + n * 16 + 4 * fq;
      q.gv[n] = *(const f32x4*)(gate + col);
      if (xg) q.G[n] = *(const f32x4*)(gvl + (size_t)r * D + col);
    }
  }
  DEVI void operator()(int row, int colb, int fq, const f32x4& a0, const f32x4& a1, float& sqacc, const int slice, const Pre& q) const {
    if (slice >= 0) {
#pragma unroll
      for (int n = 0; n < 2; ++n) {
        const int col = colb + n * 16 + 4 * fq;
        const f32x4& a = n ? a1 : a0;
        uint2 w; w.x = pk_bf16(a[0], a[1]); w.y = pk_bf16(a[2], a[3]);
        *(uint2*)(ps + ((size_t)slice * TC + (row - TL)) * D + col) = w;
      }
      return;
    }
    const float* src = row < TL ? xin_lat + (size_t)row * D : xin_ctx + (size_t)(row - TL) * D;
    const f32x4 xi0 = *(const f32x4*)(src + colb + 4 * fq), xi1 = *(const f32x4*)(src + colb + 16 + 4 * fq);
#pragma unroll
    for (int n = 0; n < 2; ++n) {
      const int col = colb + n * 16 + 4 * fq;
      const f32x4& a = n ? a1 : a0; const f32x4& xi = n ? xi1 : xi0;
      f32x4 o;
#pragma unroll
      for (int j = 0; j < 4; ++j) o[j] = xi[j] + coef * q.gv[n][j] * a[j];
      *(f32x4*)(xout + (size_t)row * D + col) = o;
      if (xg) {
        sqacc += (o[0] * o[0] + o[1] * o[1]) + (o[2] * o[2] + o[3] * o[3]);
        uint2 w; w.x = pk_bf16(o[0] * q.G[n][0], o[1] * q.G[n][1]); w.y = pk_bf16(o[2] * q.G[n][2], o[3] * q.G[n][3]);
        *(uint2*)(xg + (size_t)row * D + col) = w;
      }
    }
  }
};
struct EpiProj {
  static constexpr bool TR = false, SQ = false, NRM = true; static constexpr int NST = 32;
  u16* pt; u16* qk; const float* cost; const float* sint; const float* ssq; const float* sw;
  struct Pre { float s0, s1, invrev; };
  DEVI void preload(Pre& q, int brow, int colb, int wr, int fr, int fq, bool nrm, int) const {
    const int r = brow < TL ? (brow >> 12) : 8;
    q.s0 = nrm ? sw[r * 2048 + colb + fr] : 0.f; q.s1 = nrm ? sw[r * 2048 + colb + 16 + fr] : 0.f;
    q.invrev = exp2f(-(float)fr * (13.287712379549449f / 16.f)) * 0.15915494309189535f;
  }
  DEVI void operator()(int row0, int colb, int fr, const f32x4& b0, const f32x4& b1, const f32x4& rv, const bool nrm, const Pre& q) const {
    f32x4 a0, a1;
#pragma unroll
    for (int j = 0; j < 4; ++j) { a0[j] = b0[j] * rv[j] + q.s0; a1[j] = b1[j] * rv[j] + q.s1; }
    if (colb < 1280 || colb >= 1920) {
#pragma unroll
      for (int n = 0; n < 2; ++n) {
        const int pc = colb + n * 16 + fr; const int ptc = pc < 1280 ? pc : pc - 640;
        const f32x4& a = n ? a1 : a0;
        uint2 o; o.x = pk_bf16(a[0], a[1]); o.y = pk_bf16(a[2], a[3]);
        *(uint2*)(pt + (size_t)ptc * T + row0) = o;
      }
    } else {
      const int off = colb - 1280, head = off >> 6, grp = (off >> 5) & 1, pidx = 16 * grp + fr;
      const int d1 = head * 64 + pidx, d2 = d1 + 32;
      const float qs = head < 8 ? 0.125f * 1.4426950408889634f : 1.f;
#pragma unroll
      for (int j = 0; j < 4; ++j) {
        const int row = row0 + j; float c = 1.f, sn = 0.f;
        if (row < TL) { const int t = row & 4095; const float rev = (float)(grp ? (t & 63) : (t >> 6)) * q.invrev; c = __builtin_amdgcn_cosf(rev); sn = __builtin_amdgcn_sinf(rev); }
        const float o1 = (a0[j] * c - a1[j] * sn) * qs, o2 = (a0[j] * sn + a1[j] * c) * qs;
        qk[(size_t)row * 640 + d1] = f2bf(o1); qk[(size_t)row * 640 + d2] = f2bf(o2);
      }
    }
  }
};

DEVI int srccol(int mode, int pn) {
  if (mode == 1) { const int g = pn >> 5, hh = (pn >> 4) & 1, i = pn & 15; return hh * DFF + g * 16 + i; }
  if (mode == 2) { if (pn < 1280 || pn >= 1920) return pn; const int off = pn - 1280, head = off >> 6, w = off & 63, grp = w >> 5, hh = (w >> 4) & 1, i = w & 15; return 1280 + head * 64 + 16 * grp + i + 32 * hh; }
  return pn;
}
DEVI void transpose_item(const Params& p, const float* __restrict__ W, int K, int N, u16* __restrict__ WT, int mode, int item) {
  float* tile = (float*)smem;
  const int tid = otid(), nblk = N / 256, kb = item / nblk, nb = item % nblk, k0 = kb * 64, n0 = nb * 256;
  { const int nn = tid & 63, kr = tid >> 6;
#pragma unroll
    for (int c4 = 0; c4 < 4; ++c4) {
      const int src = srccol(mode, n0 + c4 * 64 + nn);
#pragma unroll
      for (int r = 0; r < 8; ++r) { const int kk = kr + 8 * r; tile[kk * 257 + c4 * 64 + nn] = W[(size_t)(k0 + kk) * N + src]; }
    } }
  __syncthreads();
#pragma unroll
  for (int c4 = 0; c4 < 4; ++c4) {
    const int rown = c4 * 64 + (tid >> 3), kc = tid & 7; const float* s = tile + (kc * 8) * 257 + rown;
    uint4 o; o.x = pk_bf16(s[0], s[257]); o.y = pk_bf16(s[514], s[771]); o.z = pk_bf16(s[1028], s[1285]); o.w = pk_bf16(s[1542], s[1799]);
    *(uint4*)(WT + (size_t)(n0 + rown) * K + k0 + kc * 8) = o; }
  __syncthreads();
}
DEVI void mod_item(const Params& p, int item) {
  float* sv = (float*)smem;
  float* red = sv + 9 * 1024;
  const int tid = otid(), l = item / 144, n0 = (item % 144) * 64;
  for (int i = tid; i < 9 * 1024; i += NTHREADS) { const int r = i >> 10, k = i & 1023; const float cv = r < 8 ? p.in[1][r * 1024 + k] : p.in[3][k]; sv[i] = cv * sigmoidf_(cv); }
  __syncthreads();
  const int cc = tid & 63, kq = tid >> 6;
  const float* w = p.in[4] + (size_t)l * 1024 * 9216 + n0 + cc;
  float acc[9];
#pragma unroll
  for (int r = 0; r < 9; ++r) acc[r] = 0.f;
#pragma unroll 4
  for (int k4 = 0; k4 < 32; ++k4) {
    const int k = kq * 128 + k4 * 4;
    const float w0 = w[(size_t)k * 9216], w1 = w[(size_t)(k + 1) * 9216], w2 = w[(size_t)(k + 2) * 9216], w3 = w[(size_t)(k + 3) * 9216];
#pragma unroll
    for (int r = 0; r < 9; ++r) { const float4 s4 = *(const float4*)(sv + r * 1024 + k); acc[r] += s4.x * w0 + s4.y * w1 + s4.z * w2 + s4.w * w3; }
  }
#pragma unroll
  for (int r = 0; r < 9; ++r) red[(kq * 9 + r) * 64 + cc] = acc[r];
  __syncthreads();
  float* MOD = (float*)(p.ws + OFF_MOD);
  for (int i = tid; i < 9 * 64; i += NTHREADS) {
    const int r = i >> 6, c2 = i & 63;
    float v = p.in[5][l * 9216 + n0 + c2];
#pragma unroll
    for (int q = 0; q < 8; ++q) v += red[(q * 9 + r) * 64 + c2];
    MOD[(size_t)(l * 9 + r) * 9216 + n0 + c2] = v;
  }
  __syncthreads();
}
DEVI void filter_item(const Params& p, int l, int L, u16* __restrict__ KF, int posblk) {
  float* zs = (float*)smem;
  float* hb = zs + 64 * 36;
  const int tid = otid(), w = tid >> 6, j = tid & 63, t0 = posblk * 64 + w * 8;
  const float* fw0 = opaque(p.in[20] + l * 33 * 64); const float* fb0 = opaque(p.in[21] + l * 64);
  const float* fwin = opaque(p.in[22] + l * 2 * 64 * 64); const float* fbin = opaque(p.in[23] + l * 2 * 64);
  const float* freq = opaque(p.in[24] + l * 64); const float* fwl = opaque(p.in[25] + l * 64 * 512);
  const float invL1 = 1.f / (float)(L - 1);
  if (j < 33) {
#pragma unroll
    for (int q = 0; q < 8; ++q) {
      const int t = t0 + q; const float tn = (float)t * invL1;
      float z;
      if (j == 0) z = tn;
      else { const int bi = (j - 1) & 15; const float f = 1e-4f + (float)bi * ((15.f - 1e-4f) / 15.f); const float wv = 6.283185307179586f * (float)t / (float)L; const float a = f * wv; z = (j <= 16) ? __cosf(a) : -__sinf(a); }
      zs[(w * 8 + q) * 36 + j] = z;
    }
  }
  __syncthreads();
  const float fr = freq[j];
  { float acc[8];
    const float b0 = fb0[j];
#pragma unroll
    for (int q = 0; q < 8; ++q) acc[q] = b0;
#pragma unroll 3
    for (int i = 0; i < 33; ++i) { const float wv = fw0[i * 64 + j];
#pragma unroll
      for (int q = 0; q < 8; ++q) acc[q] += zs[(w * 8 + q) * 36 + i] * wv; }
#pragma unroll
    for (int q = 0; q < 8; ++q) hb[(0 * 64 + w * 8 + q) * 64 + j] = __sinf(fr * acc[q]); }
  __syncthreads();
  float* wl = hb + 2 * 64 * 64;
#pragma unroll
  for (int s2 = 0; s2 < 2; ++s2) {
    { const f32x4 w0 = *(const f32x4*)(fwin + s2 * 4096 + tid * 4), w1 = *(const f32x4*)(fwin + s2 * 4096 + (tid + NTHREADS) * 4);
      *(f32x4*)(wl + tid * 4) = w0; *(f32x4*)(wl + (tid + NTHREADS) * 4) = w1; }
    __syncthreads();
    float acc[8];
    const float b0 = fbin[s2 * 64 + j];
#pragma unroll
    for (int q = 0; q < 8; ++q) acc[q] = b0;
#pragma unroll 8
    for (int i = 0; i < 64; ++i) { const float wv = wl[i * 64 + j];
#pragma unroll
      for (int q = 0; q < 8; ++q) acc[q] += hb[((s2 & 1) * 64 + w * 8 + q) * 64 + i] * wv; }
#pragma unroll
    for (int q = 0; q < 8; ++q) hb[(((s2 + 1) & 1) * 64 + w * 8 + q) * 64 + j] = __sinf(fr * acc[q]);
    __syncthreads();
  }
  const float mind = -3.0701134573253945f, maxd = -15.350567286626973f;
#pragma unroll 1
  for (int qq = 0; qq < 8; qq += 2) {
    { f32x4 wv4[4];
#pragma unroll
      for (int k = 0; k < 4; ++k) { const int idx = tid + k * NTHREADS, i = idx >> 5, c4 = idx & 31; wv4[k] = *(const f32x4*)(fwl + i * 512 + 64 * qq + c4 * 4); }
#pragma unroll
      for (int k = 0; k < 4; ++k) { const int idx = tid + k * NTHREADS; *(f32x4*)(wl + idx * 4) = wv4[k]; } }
    __syncthreads();
    float acc[2][8];
#pragma unroll
    for (int q = 0; q < 8; ++q) { acc[0][q] = 0.f; acc[1][q] = 0.f; }
#pragma unroll 8
    for (int i = 0; i < 64; ++i) {
      const float w0 = wl[i * 128 + j], w1 = wl[i * 128 + 64 + j];
#pragma unroll
      for (int q = 0; q < 8; ++q) { const float hv = hb[(0 * 64 + w * 8 + q) * 64 + i]; acc[0][q] += hv * w0; acc[1][q] += hv * w1; }
    }
#pragma unroll
    for (int u = 0; u < 2; ++u) {
      const int n = j + 64 * (qq + u), c = n & 255; const float delta = fabsf(mind + (float)c * ((maxd - mind) / 255.f));
#pragma unroll
      for (int q = 0; q < 8; ++q) {
        const int t = t0 + q; const float val = acc[u][q] * __expf(-((float)t * invL1) * delta);
        if (n < 256) KF[(size_t)c * 2 * L + (L - t)] = f2bf(val);
        else if (t >= 1) KF[(size_t)c * 2 * L + (L + t)] = f2bf(val);
      }
    }
    __syncthreads();
  }
  if (t0 == 0) {
#pragma unroll
    for (int qq = 0; qq < 4; ++qq) KF[(size_t)(j + 64 * qq) * 2 * L] = 0;
  }
  __syncthreads();
}
DEVI void phase0(const Params& p) {
  const int N_MOD_IT = 288, N_FIL = 64 + 64 + 4;
  constexpr int I_W1 = 16 * 22, I_W2 = 44 * 4, I_WIN = 16 * 8, I_WO = 16 * 4;
  const int N_TR = 4 * I_W1 + 4 * I_W2 + 2 * I_WIN + 2 * I_WO;
  const int NIT = N_MOD_IT + N_FIL + N_TR;
  for (int it = blockIdx.x; it < NIT; it += gridDim.x) {
    asm volatile("" ::: "memory");
    int r = it;
    if (r < N_FIL) {
      if (r < 64) filter_item(p, 0, 4096, (u16*)(p.ws + OFF_KF), r);
      else if (r < 128) filter_item(p, 1, 4096, (u16*)(p.ws + OFF_KF) + (size_t)256 * 8192, r - 64);
      else filter_item(p, 0, 256, (u16*)(p.ws + OFF_KFC), r - 128);
      continue;
    }
    r -= N_FIL;
    if (r < N_MOD_IT) { mod_item(p, r); continue; } r -= N_MOD_IT;
    if (r < 4 * I_W1) { const int mi = r / I_W1; transpose_item(p, p.in[7] + (size_t)mi * 1024 * 5632, 1024, 5632, (u16*)(p.ws + OFF_W1T) + (size_t)mi * 5632 * 1024, 1, r % I_W1); continue; } r -= 4 * I_W1;
    if (r < 4 * I_W2) { const int mi = r / I_W2; transpose_item(p, p.in[8] + (size_t)mi * 2816 * 1024, 2816, 1024, (u16*)(p.ws + OFF_W2T) + (size_t)mi * 1024 * 2816, 0, r % I_W2); continue; } r -= 4 * I_W2;
    if (r < 2 * I_WIN) { const int mi = r / I_WIN; transpose_item(p, p.in[9] + (size_t)mi * 1024 * 2048, 1024, 2048, (u16*)(p.ws + OFF_WINT) + (size_t)mi * 2048 * 1024, 2, r % I_WIN); continue; } r -= 2 * I_WIN;
    { const int mi = r / I_WO; transpose_item(p, p.in[10] + (size_t)mi * 1024 * 1024, 1024, 1024, (u16*)(p.ws + OFF_WOT) + (size_t)mi * 1024 * 1024, 0, r % I_WO); }
  }
  float* cost = (float*)(p.ws + OFF_ROPE); float* sint = cost + 4096 * 32;
  for (int idx = blockIdx.x * NTHREADS + otid(); idx < 4096 * 32; idx += gridDim.x * NTHREADS) {
    const int t = idx >> 5, pp = idx & 31;
    const float inv = exp2f(-(float)(pp & 15) * (13.287712379549449f / 16.f));
    const float pos = pp < 16 ? (float)(t >> 6) : (float)(t & 63);
    const float ang = pos * inv;
    cost[idx] = __cosf(ang); sint[idx] = __sinf(ang);
  }
  u16* WGT = (u16*)(p.ws + OFF_WGT);
  for (int o = blockIdx.x * NTHREADS + otid(); o < 2 * 2 * 2 * 4 * 64 * 64; o += gridDim.x * NTHREADS) {
    const int k = o & 63, e = (o >> 6) & 63, nb = (o >> 12) & 3, mat = (o >> 14) & 1, ld = o >> 15;
    const float* src = mat ? p.in[15] : p.in[13];
    WGT[o] = f2bf(src[(size_t)((ld * 4 + nb) * 64 + k) * 64 + e]);
  }
}

DEVI float wave_sum(float v, int lane) {
#pragma unroll
  for (int o = 1; o < 64; o <<= 1) v += shx(v, o, lane);
  return v;
}
DEVI void norm_phase(const Params& p, int l, int which, int rbeg, int Mrows, bool from_input) {
  const int tid = otid();
  const int lane = tid & 63, gw = blockIdx.x * 8 + (tid >> 6), NW = gridDim.x * 8;
  const float* X = (const float*)(p.ws + OFF_X); u16* H = (u16*)(p.ws + OFF_H);
  const float* MOD = (const float*)(p.ws + OFF_MOD);
  const f32x4* g4 = (const f32x4*)(p.in[6] + (size_t)(l * 3 + which) * D) + lane;
  for (int row0 = rbeg + gw * 2; row0 < Mrows; row0 += NW * 2) {
    f32x4 v[2][4]; float ss[2] = {0.f, 0.f};
#pragma unroll
    for (int u = 0; u < 2; ++u) {
      const int row = row0 + u;
      const float* xr = from_input ? (row < TL ? p.in[0] + (size_t)row * D : p.in[2] + (size_t)(row - TL) * D) : X + (size_t)row * D;
      const f32x4* x4 = (const f32x4*)xr + lane;
#pragma unroll
      for (int j = 0; j < 4; ++j) v[u][j] = x4[64 * j];
    }
#pragma unroll
    for (int u = 0; u < 2; ++u)
#pragma unroll
      for (int j = 0; j < 4; ++j) ss[u] += (v[u][j][0] * v[u][j][0] + v[u][j][1] * v[u][j][1]) + (v[u][j][2] * v[u][j][2] + v[u][j][3] * v[u][j][3]);
#pragma unroll
    for (int u = 0; u < 2; ++u) {
      const int row = row0 + u;
      const int r = row < TL ? (row >> 12) : 8;
      const f32x4* sh4 = (const f32x4*)(MOD + (size_t)((l * 9 + r) * 9 + which * 3) * D) + lane;
      const f32x4* sc4 = sh4 + D / 4;
      const float rinv = rsqrtf(wave_sum(ss[u], lane) * (1.f / D) + 1e-6f);
      uint2* o8 = (uint2*)(H + (size_t)row * D) + lane;
#pragma unroll
      for (int j = 0; j < 4; ++j) {
        const f32x4 g = g4[64 * j], sh = sh4[64 * j], sc = sc4[64 * j];
        f32x4 y;
#pragma unroll
        for (int q = 0; q < 4; ++q) y[q] = v[u][j][q] * rinv * g[q] * (1.f + sc[q]) + sh[q];
        uint2 o; o.x = pk_bf16(y[0], y[1]); o.y = pk_bf16(y[2], y[3]); o8[64 * j] = o;
      }
    }
  }
}
DEVI void ctx_combine_phase(const Params& p, int l, int gi, float coef, int ln, int lwhich) {
  const int tid = otid(), lane = tid & 63, gw = blockIdx.x * 8 + (tid >> 6), NW = gridDim.x * 8;
  float* X = (float*)(p.ws + OFF_X); u16* H = (u16*)(p.ws + OFF_H);
  const u16* PS = (const u16*)(p.ws + OFF_PS);
  const float* MOD = (const float*)(p.ws + OFF_MOD);
  const f32x4* gate4 = (const f32x4*)(MOD + (size_t)((l * 9 + 8) * 9 + gi) * D) + lane;
  for (int rc = gw; rc < TC; rc += NW) {
    f32x4* x4 = (f32x4*)(X + (size_t)(TL + rc) * D) + lane;
    f32x4 v[4]; float ss = 0.f;
#pragma unroll
    for (int j = 0; j < 4; ++j) {
      f32x4 sum = {0.f, 0.f, 0.f, 0.f};
#pragma unroll
      for (int sl = 0; sl < 7; ++sl) {
        const uint2 w = *((const uint2*)(PS + ((size_t)sl * TC + rc) * D) + lane + 64 * j);
        sum[0] += __uint_as_float(w.x << 16); sum[1] += __uint_as_float(w.x & 0xffff0000u); sum[2] += __uint_as_float(w.y << 16); sum[3] += __uint_as_float(w.y & 0xffff0000u);
      }
      const f32x4 xo = x4[64 * j], gv = gate4[64 * j];
#pragma unroll
      for (int q = 0; q < 4; ++q) v[j][q] = xo[q] + coef * gv[q] * sum[q];
      x4[64 * j] = v[j];
      ss += (v[j][0] * v[j][0] + v[j][1] * v[j][1]) + (v[j][2] * v[j][2] + v[j][3] * v[j][3]);
    }
    if (ln >= 0) {
      const f32x4* g4 = (const f32x4*)(p.in[6] + (size_t)(ln * 3 + lwhich) * D) + lane;
      const f32x4* sh4 = (const f32x4*)(MOD + (size_t)((ln * 9 + 8) * 9 + lwhich * 3) * D) + lane;
      const f32x4* sc4 = sh4 + D / 4;
      const float rinv = rsqrtf(wave_sum(ss, lane) * (1.f / D) + 1e-6f);
      uint2* o8 = (uint2*)(H + (size_t)(TL + rc) * D) + lane;
#pragma unroll
      for (int j = 0; j < 4; ++j) {
        const f32x4 g = g4[64 * j], sh = sh4[64 * j], sc = sc4[64 * j];
        f32x4 y;
#pragma unroll
        for (int q = 0; q < 4; ++q) y[q] = v[j][q] * rinv * g[q] * (1.f + sc[q]) + sh[q];
        uint2 o; o.x = pk_bf16(y[0], y[1]); o.y = pk_bf16(y[2], y[3]); o8[64 * j] = o;
      }
    }
  }
}
DEVI void prep2_phase(const Params& p) {
  const int tid = otid(), lane = tid & 63, gw = blockIdx.x * 8 + (tid >> 6), NW = gridDim.x * 8;
  const float* MOD = (const float*)(p.ws + OFF_MOD);
  float* GV = (float*)(p.ws + OFF_GV);
  for (int o = blockIdx.x * NTHREADS + tid; o < 6 * 9 * 1024; o += gridDim.x * NTHREADS) {
    const int col = o & 1023, r = (o >> 10) % 9, lw = o / (9 * 1024), l = lw / 3, which = lw % 3;
    GV[o] = p.in[6][(size_t)(l * 3 + which) * D + col] * (1.f + MOD[(size_t)((l * 9 + r) * 9 + which * 3 + 1) * D + col]);
  }
  for (int wi = gw; wi < 9 * 152; wi += NW) {
    const int r = wi % 9, grp = wi / 9, row0 = grp * 64;
    const u16* wbase; const float* shv; float* dst;
    if (row0 < 4096) { const int l = row0 >> 11, pn = row0 & 2047; wbase = (const u16*)(p.ws + OFF_WINT) + (size_t)(l * 2048 + pn) * 1024; shv = MOD + (size_t)((l * 9 + r) * 9 + 3) * D; dst = (float*)(p.ws + OFF_SWIN) + (size_t)(l * 9 + r) * 2048 + pn; }
    else { const int pn = row0 - 4096; wbase = (const u16*)(p.ws + OFF_W1T) + (size_t)(2 * 5632 + pn) * 1024; shv = MOD + (size_t)((1 * 9 + r) * 9 + 0) * D; dst = (float*)(p.ws + OFF_SW1) + (size_t)r * 5632 + pn; }
    float sh[16];
#pragma unroll
    for (int q = 0; q < 4; ++q) { const f32x4 sv = *(const f32x4*)(shv + lane * 16 + 4 * q); sh[4 * q] = sv[0]; sh[4 * q + 1] = sv[1]; sh[4 * q + 2] = sv[2]; sh[4 * q + 3] = sv[3]; }
#pragma unroll 1
    for (int i = 0; i < 64; i += 8) {
      float a8[8];
#pragma unroll
      for (int u = 0; u < 8; ++u) {
        const u16* wrow = wbase + (size_t)(i + u) * 1024 + lane * 16;
        const bf16x8 v0 = *(const bf16x8*)wrow, v1 = *(const bf16x8*)(wrow + 8);
        float acc = 0.f;
#pragma unroll
        for (int q = 0; q < 8; ++q) acc += bf2f((u16)v0[q]) * sh[q] + bf2f((u16)v1[q]) * sh[8 + q];
        a8[u] = acc;
      }
#pragma unroll
      for (int u = 0; u < 8; ++u) a8[u] = wave_sum(a8[u], lane);
      if (lane < 8) { float v = a8[0];
#pragma unroll
        for (int u = 1; u < 8; ++u) v = lane == u ? a8[u] : v;
        dst[i + lane] = v; }
    }
  }
}
DEVI void final_norm_phase(const Params& p) {
  const int tid = otid();
  const int lane = tid & 63, gw = blockIdx.x * 8 + (tid >> 6), NW = gridDim.x * 8;
  const float* X = (const float*)(p.ws + OFF_X);
  const f32x4* g4 = (const f32x4*)p.in[28] + lane;
  for (int row0 = gw * 2; row0 < TL; row0 += NW * 2) {
    f32x4 v[2][4]; float ss[2] = {0.f, 0.f};
#pragma unroll
    for (int u = 0; u < 2; ++u) {
      const f32x4* x4 = (const f32x4*)(X + (size_t)(row0 + u) * D) + lane;
#pragma unroll
      for (int j = 0; j < 4; ++j) v[u][j] = x4[64 * j];
    }
#pragma unroll
    for (int u = 0; u < 2; ++u)
#pragma unroll
      for (int j = 0; j < 4; ++j) ss[u] += (v[u][j][0] * v[u][j][0] + v[u][j][1] * v[u][j][1]) + (v[u][j][2] * v[u][j][2] + v[u][j][3] * v[u][j][3]);
#pragma unroll
    for (int u = 0; u < 2; ++u) {
      const float rinv = rsqrtf(wave_sum(ss[u], lane) * (1.f / D) + 1e-6f);
      f32x4* o4 = (f32x4*)(p.out + (size_t)(row0 + u) * D) + lane;
#pragma unroll
      for (int j = 0; j < 4; ++j) { const f32x4 g = g4[64 * j]; f32x4 y;
#pragma unroll
        for (int q = 0; q < 4; ++q) y[q] = v[u][j][q] * rinv * g[q];
        o4[64 * j] = y; }
    }
  }
}

constexpr int AT_KSTR = 72, AT_VSTR = 408;
template <int NKEYS>
DEVI void attn_stage(const u16* __restrict__ QK, const u16* __restrict__ PT, u16* Ks, u16* Vs, int tid, int kvh, int kbase, int kstart, int klen) {
  constexpr int NCH = NKEYS * 8, NIT = (NCH + NTHREADS - 1) / NTHREADS, NCK = NKEYS / 8;
  uint4 kv[NIT], vv[NIT];
#pragma unroll
  for (int i = 0; i < NIT; ++i) {
    const int idx = tid + i * NTHREADS;
    { const int kl = idx >> 3, cp = idx & 7, kp = kstart + kl;
      kv[i] = make_uint4(0u, 0u, 0u, 0u);
      if (idx < NCH && kp >= 0 && kp < klen) kv[i] = *(const uint4*)(QK + (size_t)(kbase + kp) * 640 + 512 + kvh * 64 + cp * 8); }
    { const int dim = idx / NCK, ck = idx % NCK, kp = kstart + ck * 8;
      vv[i] = make_uint4(0u, 0u, 0u, 0u);
      if (idx < NCH && kp >= 0 && kp < klen) vv[i] = *(const uint4*)(PT + (size_t)(1280 + kvh * 64 + dim) * T + kbase + kp); }
  }
#pragma unroll
  for (int i = 0; i < NIT; ++i) {
    const int idx = tid + i * NTHREADS;
    if (idx < NCH) {
      *(uint4*)(Ks + (idx >> 3) * AT_KSTR + (idx & 7) * 8) = kv[i];
      *(uint4*)(Vs + (idx / NCK) * AT_VSTR + (idx % NCK) * 8) = vv[i];
    }
  }
}
DEVI void attn_item(const Params& p, int l, int item) {
  const u16* QK = (const u16*)(p.ws + OFF_QK); const u16* PT = (const u16*)(p.ws + OFF_PT); u16* YC = (u16*)(p.ws + OFF_H);
  u16* Ks = (u16*)smem; u16* Vs = Ks + 400 * AT_KSTR;
  const int tid = otid();
  const int wave = tid >> 6, lane = tid & 63, fr = lane & 15, g = lane >> 4;
  int kvh, b, qb, isctx;
  if (item < 512) { kvh = item & 1; qb = (item >> 1) & 31; b = item >> 6; isctx = 0; }
  else { const int it = item - 512; kvh = it & 1; qb = (it >> 1) & 1; b = it >> 2; isctx = 1; }
  const int rowbase = isctx ? TL + b * CTXL : b * SEQ;
  const int ctxbase = TL + b * CTXL;
  const int q0b = qb * 128, q0 = q0b + wave * 16;
  const int qrow = rowbase + q0 + fr, qpos = q0 + fr;
  bf16x8 Qf[4][2];
  float m[4], lsum[4];
  f32x4 O[4][4];
#pragma unroll
  for (int hh = 0; hh < 4; ++hh) {
    const u16* qp = QK + (size_t)qrow * 640 + (kvh * 4 + hh) * 64 + g * 8;
    Qf[hh][0] = *(const bf16x8*)qp; Qf[hh][1] = *(const bf16x8*)(qp + 32);
    m[hh] = p.in[27][l * 8 + kvh * 4 + hh] * 1.4426950408889634f; lsum[hh] = 0.f;
#pragma unroll
    for (int dt = 0; dt < 4; ++dt) O[hh][dt] = (f32x4){0.f, 0.f, 0.f, 0.f};
  }
  auto chunk = [&](const int lk, const int kp0, const bool win) {
    bf16x8 Kf[2][2];
#pragma unroll
    for (int tt = 0; tt < 2; ++tt) {
      const u16* kr = Ks + (lk + 16 * tt + fr) * AT_KSTR + g * 8;
      Kf[tt][0] = *(const bf16x8*)kr; Kf[tt][1] = *(const bf16x8*)(kr + 32);
    }
    bf16x8 Vf[4];
#pragma unroll
    for (int dt = 0; dt < 4; ++dt) {
      const u16* vr = Vs + (16 * dt + fr) * AT_VSTR + lk + 4 * g;
      union { uint2 u[2]; bf16x8 v; } t; t.u[0] = *(const uint2*)vr; t.u[1] = *(const uint2*)(vr + 16); Vf[dt] = t.v;
    }
    bool valid[2][4];
#pragma unroll
    for (int tt = 0; tt < 2; ++tt)
#pragma unroll
      for (int j = 0; j < 4; ++j) {
        const int kp = kp0 + 16 * tt + 4 * g + j; int dq = qpos - kp; dq = dq < 0 ? -dq : dq;
        valid[tt][j] = win ? (kp >= 0 && kp < SEQ && dq <= 128) : true;
      }
#pragma unroll
    for (int hh = 0; hh < 4; ++hh) {
      f32x4 st[2];
#pragma unroll
      for (int tt = 0; tt < 2; ++tt) { f32x4 z = {0.f, 0.f, 0.f, 0.f}; z = mfma16(Kf[tt][0], Qf[hh][0], z); z = mfma16(Kf[tt][1], Qf[hh][1], z); st[tt] = z; }
      float mx = -3.0e38f;
#pragma unroll
      for (int tt = 0; tt < 2; ++tt)
#pragma unroll
        for (int j = 0; j < 4; ++j) { const float sv = valid[tt][j] ? st[tt][j] : -1e30f; st[tt][j] = sv; mx = fmaxf(mx, sv); }
      mx = fmaxf(mx, shx(mx, 16, lane)); mx = fmaxf(mx, shx(mx, 32, lane));
      const float mnew = fmaxf(m[hh], mx);
      const float alpha = __builtin_amdgcn_exp2f(m[hh] - mnew); m[hh] = mnew;
      float ps = 0.f; float pv[2][4];
#pragma unroll
      for (int tt = 0; tt < 2; ++tt)
#pragma unroll
        for (int j = 0; j < 4; ++j) { const float e = __builtin_amdgcn_exp2f(st[tt][j] - mnew); pv[tt][j] = e; ps += e; }
      lsum[hh] = lsum[hh] * alpha + ps;
      union { unsigned u[4]; bf16x8 v; } Pf;
      Pf.u[0] = pk_bf16(pv[0][0], pv[0][1]); Pf.u[1] = pk_bf16(pv[0][2], pv[0][3]);
      Pf.u[2] = pk_bf16(pv[1][0], pv[1][1]); Pf.u[3] = pk_bf16(pv[1][2], pv[1][3]);
#pragma unroll
      for (int dt = 0; dt < 4; ++dt) {
        f32x4 o = O[hh][dt]; o[0] *= alpha; o[1] *= alpha; o[2] *= alpha; o[3] *= alpha;
        O[hh][dt] = mfma16(Vf[dt], Pf.v, o);
      }
    }
  };
  if (!isctx) {
    attn_stage<400>(QK, PT, Ks, Vs, tid, kvh, rowbase, q0b - 128, SEQ);
    __syncthreads();
#pragma unroll 1
    for (int ci = 0; ci < 9; ++ci) {
      const int kp0 = q0 - 128 + 32 * ci;
      chunk(16 * wave + 32 * ci, kp0, ci == 0 || ci == 8 || kp0 < 0 || kp0 + 31 >= SEQ);
    }
    __syncthreads();
  }
  attn_stage<256>(QK, PT, Ks, Vs, tid, kvh, ctxbase, 0, CTXL);
  __syncthreads();
#pragma unroll 1
  for (int ci = 0; ci < 8; ++ci) chunk(32 * ci, 32 * ci, false);
#pragma unroll
  for (int hh = 0; hh < 4; ++hh) {
    float ls = lsum[hh]; ls += shx(ls, 16, lane); ls += shx(ls, 32, lane);
    const float sink = p.in[27][l * 8 + kvh * 4 + hh] * 1.4426950408889634f;
    const float inv = 1.f / (ls + __builtin_amdgcn_exp2f(sink - m[hh]));
#pragma unroll
    for (int dt = 0; dt < 4; ++dt) {
      uint2 o; o.x = pk_bf16(O[hh][dt][0] * inv, O[hh][dt][1] * inv); o.y = pk_bf16(O[hh][dt][2] * inv, O[hh][dt][3] * inv);
      *(uint2*)(YC + (size_t)qrow * D + 512 + (kvh * 4 + hh) * 64 + 16 * dt + 4 * g) = o;
    }
  }
  __syncthreads();
}

DEVI void lru_item(const Params& p, int l, int item, int pass) {
  const u16* PT = (const u16*)(p.ws + OFF_PT); u16* YC = (u16*)(p.ws + OFF_H);
  float2* SUMM = (float2*)(p.ws + OFF_SUMM);
  const int ch = item >> 2, n = item & 3;
  const int isctx = ch >= 256;
  int b, tq; if (!isctx) { b = ch >> 5; tq = ch & 31; } else { b = (ch - 256) >> 1; tq = (ch - 256) & 1; }
  const int Lseq = isctx ? CTXL : SEQ, rowbase = isctx ? TL + b * CTXL : b * SEQ, t0 = tq * 128;
  float* xs = (float*)smem;
  u16* ub = (u16*)(xs + 64 * 145);
  float* ex = (float*)(ub + 128 * 72);
  float* sm = ex + 8 * 16 * 65;
  float* hc = sm + 2 * 8 * 64 * 2;
  float2* ss = (float2*)(hc + 128);
  const int tid = otid(), e = tid & 63, tg = tid >> 6, c = n * 64 + e, lane = e, fr = lane & 15, g = lane >> 4;
  { bf16x8 xv[3];
#pragma unroll
    for (int i = 0; i < 3; ++i) {
      const int idx = tid + i * NTHREADS, chn = idx / 18, ck = idx % 18, t = t0 - 8 + ck * 8;
      xv[i] = (bf16x8){0, 0, 0, 0, 0, 0, 0, 0};
      if (idx < 64 * 18 && t >= 0 && t < Lseq) xv[i] = *(const bf16x8*)(PT + (size_t)(n * 64 + chn) * T + rowbase + t);
    }
#pragma unroll
    for (int i = 0; i < 3; ++i) {
      const int idx = tid + i * NTHREADS, chn = idx / 18, ck = idx % 18;
      if (idx < 64 * 18) {
#pragma unroll
        for (int q = 0; q < 8; ++q) xs[chn * 145 + ck * 8 + q] = bf2f((u16)xv[i][q]);
      }
    } }
  if (pass) {
    float2 sv[9];
#pragma unroll
    for (int i = 0; i < 9; ++i) {
      const int idx = tid + i * NTHREADS;
      const int d = idx / (34 * 64), rem = idx % (34 * 64), j = rem >> 6, ee = rem & 63;
      const int cidx = j < 2 ? 256 + b * 2 + j : b * 32 + (j - 2);
      sv[i] = make_float2(0.f, 0.f);
      if (idx < 2 * 34 * 64) sv[i] = SUMM[((size_t)d * 272 + cidx) * 256 + n * 64 + ee];
    }
#pragma unroll
    for (int i = 0; i < 9; ++i) { const int idx = tid + i * NTHREADS; if (idx < 2 * 34 * 64) ss[idx] = sv[i]; }
  }
  __syncthreads();
  float uo[16];
  { const float* cw = p.in[11] + (size_t)l * 4 * 256 + c;
    const float w0 = cw[0], w1 = cw[256], w2 = cw[512], w3 = cw[768], cb = p.in[12][l * 256 + c];
    const float* xr = xs + e * 145 + 8 + 16 * tg;
#pragma unroll
    for (int tt = 0; tt < 16; ++tt) { const float u = cb + w0 * xr[tt - 2] + w1 * xr[tt - 1] + w2 * xr[tt] + w3 * xr[tt + 1]; uo[tt] = u; ub[(16 * tg + tt) * 72 + e] = f2bf(u); } }
  if (pass && tid < 128) {
    const int d = tid >> 6, ee = tid & 63, my = isctx ? tq : 2 + tq;
    const float2* S = ss + d * 34 * 64 + ee;
    float h = 0.f;
    if (d == 0) { for (int j = 0; j < my; ++j) { const float2 sv = S[j * 64]; h = sv.x * h + sv.y; } }
    else {
      if (my < 2) { for (int j = 1; j > my; --j) { const float2 sv = S[j * 64]; h = sv.x * h + sv.y; } }
      else {
        { const float2 sv = S[1 * 64]; h = sv.x * h + sv.y; }
        { const float2 sv = S[0 * 64]; h = sv.x * h + sv.y; }
        for (int j = 33; j > my; --j) { const float2 sv = S[j * 64]; h = sv.x * h + sv.y; }
      }
    }
    hc[tid] = h;
  }
  __syncthreads();
  if (pass) {
    bf16x8 gv2[2];
#pragma unroll
    for (int i = 0; i < 2; ++i) { const int idx = tid + i * NTHREADS, chn = idx >> 4, ck = idx & 15; gv2[i] = *(const bf16x8*)(PT + (size_t)(256 + n * 64 + chn) * T + rowbase + t0 + ck * 8); }
#pragma unroll
    for (int i = 0; i < 2; ++i) { const int idx = tid + i * NTHREADS, chn = idx >> 4, ck = idx & 15;
#pragma unroll
      for (int q = 0; q < 8; ++q) xs[chn * 145 + 8 + ck * 8 + q] = bf2f((u16)gv2[i][q]); }
  }
  const bf16x8 A0 = *(const bf16x8*)(ub + (16 * tg + fr) * 72 + 8 * g), A1 = *(const bf16x8*)(ub + (16 * tg + fr) * 72 + 32 + 8 * g);
  const u16* WGT = (const u16*)(p.ws + OFF_WGT);
  float* exw = ex + tg * 16 * 65;
  float av[2][16], bv[2][16];
#pragma unroll
  for (int d = 0; d < 2; ++d) {
    float pre[2][16];
#pragma unroll
    for (int mat = 0; mat < 2; ++mat) {
      const u16* wb = WGT + (size_t)((((l * 2 + d) * 2 + mat) * 4 + n) * 64) * 64 + 8 * g;
      f32x4 acc[4];
#pragma unroll
      for (int nt = 0; nt < 4; ++nt) {
        const bf16x8 B0 = *(const bf16x8*)(wb + (16 * nt + fr) * 64), B1 = *(const bf16x8*)(wb + (16 * nt + fr) * 64 + 32);
        f32x4 z = {0.f, 0.f, 0.f, 0.f};
        z = mfma16(A0, B0, z); z = mfma16(A1, B1, z); acc[nt] = z;
      }
      asm volatile("s_waitcnt lgkmcnt(0)" ::: "memory");
#pragma unroll
      for (int nt = 0; nt < 4; ++nt)
#pragma unroll
        for (int j = 0; j < 4; ++j) exw[(4 * g + j) * 65 + 16 * nt + fr] = acc[nt][j];
      asm volatile("s_waitcnt lgkmcnt(0)" ::: "memory");
#pragma unroll
      for (int tt = 0; tt < 16; ++tt) pre[mat][tt] = exw[tt * 65 + lane];
    }
    const float ba = p.in[14][(l * 2 + d) * 256 + c], bx = p.in[16][(l * 2 + d) * 256 + c];
    const float lam = p.in[17][(l * 2 + d) * 256 + c];
    const float exl = __expf(-lam); const float sp = exl < 0.03f ? exl * (1.f - exl * (0.5f - exl * (0.33333334f - 0.25f * exl))) : __logf(1.f + exl);
    float Ap = 1.f, Bp = 0.f;
#pragma unroll
    for (int q = 0; q < 16; ++q) {
      const int tt = d == 0 ? q : 15 - q;
      const float r = sigmoidf_(pre[0][tt] + ba), ig = sigmoidf_(pre[1][tt] + bx);
      const float la = -8.f * r * sp;
      const float a = __expf(la);
      const float om = fmaxf(1.f - a * a, 0.f);
      const float bb = sqrtf(om) * (ig * uo[tt]);
      av[d][tt] = a; bv[d][tt] = bb;
      Bp = a * Bp + bb; Ap *= a;
    }
    sm[((d * 8 + tg) * 64 + e) * 2 + 0] = Ap; sm[((d * 8 + tg) * 64 + e) * 2 + 1] = Bp;
  }
  __syncthreads();
  if (!pass) {
    if (tid < 128) {
      const int d = tid >> 6, ee = tid & 63;
      float A = 1.f, Bc = 0.f;
      if (d == 0) { for (int g2 = 0; g2 < 8; ++g2) { const float a = sm[((0 * 8 + g2) * 64 + ee) * 2], bq = sm[((0 * 8 + g2) * 64 + ee) * 2 + 1]; Bc = a * Bc + bq; A *= a; } }
      else { for (int g2 = 7; g2 >= 0; --g2) { const float a = sm[((1 * 8 + g2) * 64 + ee) * 2], bq = sm[((1 * 8 + g2) * 64 + ee) * 2 + 1]; Bc = a * Bc + bq; A *= a; } }
      SUMM[((size_t)d * 272 + ch) * 256 + n * 64 + ee] = make_float2(A, Bc);
    }
  } else {
    float hs[16];
    { float h = hc[e];
      for (int g2 = 0; g2 < tg; ++g2) { const float a = sm[((0 * 8 + g2) * 64 + e) * 2], bq = sm[((0 * 8 + g2) * 64 + e) * 2 + 1]; h = a * h + bq; }
#pragma unroll
      for (int tt = 0; tt < 16; ++tt) { h = av[0][tt] * h + bv[0][tt]; hs[tt] = h; } }
    { float h = hc[64 + e];
      for (int g2 = 7; g2 > tg; --g2) { const float a = sm[((1 * 8 + g2) * 64 + e) * 2], bq = sm[((1 * 8 + g2) * 64 + e) * 2 + 1]; h = a * h + bq; }
#pragma unroll
      for (int tt = 15; tt >= 0; --tt) { h = av[1][tt] * h + bv[1][tt]; hs[tt] += h; } }
    const float* gr = xs + e * 145 + 8 + 16 * tg;
#pragma unroll
    for (int tt = 0; tt < 16; ++tt) {
      const float y = hs[tt] * gelu_tanh(gr[tt]);
      YC[(size_t)(rowbase + t0 + 16 * tg + tt) * D + c] = f2bf(y);
    }
  }
  __syncthreads();
}

DEVI void uprep_phase(const Params& p, int l) {
  const u16* PT = (const u16*)(p.ws + OFF_PT); u16* UT = (u16*)(p.ws + OFF_UT); u16* X0T = (u16*)(p.ws + OFF_X0T);
  constexpr int NCH = T / 8;
  for (int idx = blockIdx.x * NTHREADS + otid(); idx < 256 * NCH; idx += gridDim.x * NTHREADS) {
    const int c = idx / NCH, ck = idx % NCH, row = ck * 8;
    int t, Lseq; if (row < TL) { t = row & 4095; Lseq = SEQ; } else { t = (row - TL) & 255; Lseq = CTXL; }
    float o[3][8];
#pragma unroll
    for (int k = 0; k < 3; ++k) {
      const int col = k * 256 + c;
      const u16* src = PT + (size_t)(512 + col) * T + row;
      const bf16x8 v = *(const bf16x8*)src;
      float x[10];
      x[0] = t > 0 ? bf2f(src[-1]) : 0.f;
      x[9] = (t + 8 < Lseq) ? bf2f(src[8]) : 0.f;
#pragma unroll
      for (int q = 0; q < 8; ++q) x[q + 1] = bf2f((u16)v[q]);
      const float w0 = p.in[18][(l * 3 + 0) * 768 + col], w1 = p.in[18][(l * 3 + 1) * 768 + col], w2 = p.in[18][(l * 3 + 2) * 768 + col], bb = p.in[19][l * 768 + col];
#pragma unroll
      for (int q = 0; q < 8; ++q) o[k][q] = bb + w0 * x[q] + w1 * x[q + 1] + w2 * x[q + 2];
    }
    uint4 uo, xo;
    uo.x = pk_bf16(o[1][0] * o[2][0], o[1][1] * o[2][1]); uo.y = pk_bf16(o[1][2] * o[2][2], o[1][3] * o[2][3]);
    uo.z = pk_bf16(o[1][4] * o[2][4], o[1][5] * o[2][5]); uo.w = pk_bf16(o[1][6] * o[2][6], o[1][7] * o[2][7]);
    xo.x = pk_bf16(o[0][0], o[0][1]); xo.y = pk_bf16(o[0][2], o[0][3]); xo.z = pk_bf16(o[0][4], o[0][5]); xo.w = pk_bf16(o[0][6], o[0][7]);
    *(uint4*)(UT + (size_t)c * T + row) = uo;
    *(uint4*)(X0T + (size_t)c * T + row) = xo;
  }
}

DEVI bf16x8 ld_frag8(const u16* a) { union { uint2 u[2]; bf16x8 v; } f; f.u[0] = *(const uint2*)a; f.u[1] = *(const uint2*)(a + 4); return f.v; }
DEVI void toep_item(const Params& p, int l, int c, int isctx) {
  const int L = isctx ? CTXL : SEQ;
  const u16* KF = isctx ? (const u16*)(p.ws + OFF_KFC) + (size_t)c * 512 : (const u16*)(p.ws + OFF_KF) + (size_t)(l * 256 + c) * 8192;
  u16* R = (u16*)smem; const int CS = 2 * L + 8;
  u16* Us = R + 4 * CS; const int USTR = L + 8;
  const int tid = otid(), wave = tid >> 6, lane = tid & 63, fr = lane & 15, g = lane >> 4;
  const u16* Uc = (const u16*)(p.ws + OFF_UT) + (size_t)c * T;
  const u16* X0c = (const u16*)(p.ws + OFF_X0T) + (size_t)c * T;
  for (int q = tid; q < (2 * L) / 8; q += NTHREADS) {
    const bf16x8 v = *(const bf16x8*)(KF + 8 * q);
#pragma unroll
    for (int mm = 0; mm < 4; ++mm)
#pragma unroll
      for (int e = 0; e < 8; ++e) R[mm * CS + 8 * q + e + mm] = (u16)v[e];
  }
  if (tid < 32) { const int mm = tid >> 3, e = tid & 7; if (e < mm) R[mm * CS + e] = 0; else R[mm * CS + 2 * L + e] = 0; }
  for (int q = tid; q < L; q += NTHREADS) {
    const int bb = q / (L / 8), ck = q % (L / 8);
    const size_t row = (isctx ? (size_t)TL + (size_t)bb * CTXL : (size_t)bb * SEQ) + ck * 8;
    *(uint4*)(Us + bb * USTR + ck * 8) = *(const uint4*)(Uc + row);
  }
  __syncthreads();
  u16* YHc = (u16*)(p.ws + OFF_YHT) + (size_t)c * T;
  const float skip = p.in[26][l * 256 + c];
  const int nT = L / 256;
  const int mcp = fr & 3;
  const u16* Rl = R + mcp * CS + (L + 8 * g - (fr - mcp));
  const u16* Ul = Us + (fr & 7) * USTR + 8 * g;
  const size_t urow = isctx ? (size_t)TL + (size_t)(fr & 7) * CTXL : (size_t)(fr & 7) * SEQ;
  for (int wt = wave; wt < nT; wt += 8) {
    const int T0 = wt * 256;
    f32x4 acc[16];
#pragma unroll
    for (int m8 = 0; m8 < 16; ++m8) acc[m8] = (f32x4){0.f, 0.f, 0.f, 0.f};
    bf16x8 F[16];
#pragma unroll
    for (int m8 = 2; m8 < 16; ++m8) F[m8] = ld_frag8(Rl + (0 - T0 - 16 * m8));
#pragma unroll 1
    for (int s0 = 0; s0 < L; s0 += 256) {
#pragma unroll
      for (int k = 0; k < 8; ++k) {
        const int s = s0 + 32 * k;
        const bf16x8 Bf = *(const bf16x8*)(Ul + s);
        F[(16 - 2 * k) & 15] = ld_frag8(Rl + (s - T0));
        F[(17 - 2 * k) & 15] = ld_frag8(Rl + (s - T0 - 16));
#pragma unroll
        for (int m8 = 0; m8 < 16; ++m8) acc[m8] = mfma16(F[(m8 + 16 - 2 * k) & 15], Bf, acc[m8]);
      }
    }
    if (fr < 8) {
#pragma unroll
      for (int m8 = 0; m8 < 16; ++m8) {
        const size_t row = urow + T0 + 16 * m8 + 4 * g;
        const bf16x4 u4 = *(const bf16x4*)(Us + fr * USTR + T0 + 16 * m8 + 4 * g), x4 = *(const bf16x4*)(X0c + row);
        float y[4];
#pragma unroll
        for (int j = 0; j < 4; ++j) y[j] = bf2f((u16)x4[j]) * (acc[m8][j] + skip * bf2f((u16)u4[j]));
        uint2 o; o.x = pk_bf16(y[0], y[1]); o.y = pk_bf16(y[2], y[3]);
        *(uint2*)(YHc + row) = o;
      }
    }
  }
  __syncthreads();
}

DEVI void toep_item_lat(const Params& p, int l, int c) {
  constexpr int L = SEQ, HL = SEQ / 2, CS = 2 * L + 8, USTR = L + 8;
  const u16* KF = (const u16*)(p.ws + OFF_KF) + (size_t)(l * 256 + c) * 8192;
  u16* R = (u16*)smem;
  u16* Us = R + 4 * CS;
  const int tid = otid(), wave = tid >> 6, lane = tid & 63, fr = lane & 15, g = lane >> 4;
  const u16* Uc = (const u16*)(p.ws + OFF_UT) + (size_t)c * T;
  const u16* X0c = (const u16*)(p.ws + OFF_X0T) + (size_t)c * T;
  { const bf16x8 v0 = *(const bf16x8*)(KF + 8 * tid), v1 = *(const bf16x8*)(KF + 8 * (tid + NTHREADS));
#pragma unroll
    for (int mm = 0; mm < 4; ++mm)
#pragma unroll
      for (int e = 0; e < 8; ++e) { R[mm * CS + 8 * tid + e + mm] = (u16)v0[e]; R[mm * CS + 8 * (tid + NTHREADS) + e + mm] = (u16)v1[e]; } }
  if (tid < 32) { const int mm = tid >> 3, e = tid & 7; if (e < mm) R[mm * CS + e] = 0; else R[mm * CS + 2 * L + e] = 0; }
  { uint4 uu[8];
#pragma unroll
    for (int b2 = 0; b2 < 8; ++b2) uu[b2] = *(const uint4*)(Uc + (size_t)b2 * SEQ + tid * 8);
#pragma unroll
    for (int b2 = 0; b2 < 8; ++b2) *(uint4*)(Us + b2 * USTR + tid * 8) = uu[b2]; }
  __syncthreads();
  u16* YHc = (u16*)(p.ws + OFF_YHT) + (size_t)c * T;
  const float skip = p.in[26][l * 256 + c];
  const int mcp = fr & 3, bb = fr & 7, hh = fr >> 3;
  const u16* Rl = R + mcp * CS + (L + 8 * g - (fr - mcp));
  const u16* Ul = Us + bb * USTR + HL * hh + 8 * g;
  const int T0 = wave * 256;
  f32x4 acc[16];
#pragma unroll
  for (int m8 = 0; m8 < 16; ++m8) acc[m8] = (f32x4){0.f, 0.f, 0.f, 0.f};
  bf16x8 F[16];
#pragma unroll
  for (int m8 = 2; m8 < 16; ++m8) F[m8] = ld_frag8(Rl + (-HL - T0 - 16 * m8));
#pragma unroll 1
  for (int s0 = -HL; s0 < L; s0 += 256) {
#pragma unroll
    for (int k = 0; k < 8; ++k) {
      const int s = s0 + 32 * k;
      const int ui = s + HL * hh + 8 * g;
      const bool ok = (unsigned)ui < (unsigned)L;
      bf16x8 Bf = *(const bf16x8*)(Ul + (ok ? s : -(HL * hh)));
      if (!ok) Bf = (bf16x8){0, 0, 0, 0, 0, 0, 0, 0};
      F[(16 - 2 * k) & 15] = ld_frag8(Rl + (s - T0));
      F[(17 - 2 * k) & 15] = ld_frag8(Rl + (s - T0 - 16));
#pragma unroll
      for (int m8 = 0; m8 < 16; ++m8) acc[m8] = mfma16(F[(m8 + 16 - 2 * k) & 15], Bf, acc[m8]);
    }
  }
#pragma unroll
  for (int m8 = 0; m8 < 16; ++m8) {
    const int tt = HL * hh + T0 + 16 * m8 + 4 * g;
    const size_t row = (size_t)bb * SEQ + tt;
    const bf16x4 u4 = *(const bf16x4*)(Us + bb * USTR + tt), x4 = *(const bf16x4*)(X0c + row);
    float y[4];
#pragma unroll
    for (int j = 0; j < 4; ++j) y[j] = bf2f((u16)x4[j]) * (acc[m8][j] + skip * bf2f((u16)u4[j]));
    uint2 o; o.x = pk_bf16(y[0], y[1]); o.y = pk_bf16(y[2], y[3]);
    *(uint2*)(YHc + row) = o;
  }
  __syncthreads();
}

DEVI void yht_phase(const Params& p, int Mrows) {
  const u16* YHT = (const u16*)(p.ws + OFF_YHT); u16* YC = (u16*)(p.ws + OFF_H);
  u16* tile = (u16*)smem;
  const int tid = otid();
  const int nit = (Mrows / 256) * 4;
  for (int it = blockIdx.x; it < nit; it += gridDim.x) {
    const int cg = it & 3, row0 = (it >> 2) * 256;
    { uint4 v[4];
#pragma unroll
      for (int k = 0; k < 4; ++k) { const int idx = tid + k * NTHREADS, chn = idx >> 5, ck = idx & 31; v[k] = *(const uint4*)(YHT + (size_t)(cg * 64 + chn) * T + row0 + ck * 8); }
#pragma unroll
      for (int k = 0; k < 4; ++k) { const int idx = tid + k * NTHREADS, chn = idx >> 5, ck = idx & 31; *(uint4*)(tile + chn * 264 + ck * 8) = v[k]; } }
    __syncthreads();
#pragma unroll
    for (int k = 0; k < 4; ++k) {
      const int idx = tid + k * NTHREADS, r = idx >> 3, q = idx & 7;
      const u16* tp = tile + (q * 8) * 264 + r;
      uint4 o;
      o.x = (unsigned)tp[0] | ((unsigned)tp[264] << 16); o.y = (unsigned)tp[528] | ((unsigned)tp[792] << 16);
      o.z = (unsigned)tp[1056] | ((unsigned)tp[1320] << 16); o.w = (unsigned)tp[1584] | ((unsigned)tp[1848] << 16);
      *(uint4*)(YC + (size_t)(row0 + r) * D + 256 + cg * 64 + q * 8) = o;
    }
    __syncthreads();
  }
}

#define XB_TMO      128
#define XB_XCNT(j)  (256  + 64 * (j))
#define XB_XSUB(j)  (1280 + 64 * (j))
#define XB_XGEN(j)  (2304 + 64 * (j))
#define XB_TOP      3328
#define XB_TOPGEN   3392
#define XCD_BAR_WORDS 3456
#define XB_SPIN_CAP (1u << 18)
DEVI unsigned xb_ld(unsigned* q)              { return __hip_atomic_load(q, __ATOMIC_RELAXED, __HIP_MEMORY_SCOPE_AGENT); }
DEVI unsigned xb_add(unsigned* q, unsigned v) { return __hip_atomic_fetch_add(q, v, __ATOMIC_RELAXED, __HIP_MEMORY_SCOPE_AGENT); }
DEVI unsigned xb_xcc_id() { return (unsigned)__builtin_amdgcn_s_getreg((3 << 11) | 20) & 0xFu; }
#define XB_SPIN(cond, bar) do { unsigned _sp = 0; while (cond) { __builtin_amdgcn_s_sleep(1); \
    if ((++_sp & 255u) == 0u) { if (xb_ld(&(bar)[XB_TMO])) break; if (_sp > XB_SPIN_CAP) { atomicAdd(&(bar)[XB_TMO], 1u); break; } } } } while (0)
DEVI void xcd_barrier_complete(unsigned* bar, unsigned x, unsigned& nloc, unsigned& nx) {
  const unsigned G = gridDim.x;
  unsigned sum, cnt, mine, sp = 0u;
  for (;;) {
    sum = 0u; cnt = 0u; mine = 0u;
#pragma unroll
    for (unsigned j = 0; j < 16; ++j) { const unsigned c = xb_ld(&bar[XB_XCNT(j)]); sum += c; cnt += (c > 0u) ? 1u : 0u; mine = (j == x) ? c : mine; }
    if (sum == G) break;
    __builtin_amdgcn_s_sleep(1);
    if ((++sp & 255u) == 0u) { if (xb_ld(&bar[XB_TMO])) break; if (sp > XB_SPIN_CAP) { atomicAdd(&bar[XB_TMO], 1u); break; } }
  }
  nloc = mine > 0u ? mine : 1u; nx = cnt > 0u ? cnt : 1u;
}
DEVI void xcd_barrier(const Params& p) {
  asm volatile("s_waitcnt vmcnt(0)" ::: "memory");
  __syncthreads();
  if (otid() == 0) {
    unsigned* bar = (unsigned*)(p.ws + OFF_BAR);
    volatile unsigned* st = (volatile unsigned*)(smem + LDS_BYTES - 256);
    const unsigned x = xb_xcc_id();
    __builtin_amdgcn_s_waitcnt(0);
    unsigned nloc = st[0], nx = st[1];
    if (nloc == 0u) { xcd_barrier_complete(bar, x, nloc, nx); st[0] = nloc; st[1] = nx; }
    const unsigned old = xb_add(&bar[XB_XSUB(x)], 1u);
    const unsigned gen = old / nloc;
    if (old + 1u == (gen + 1u) * nloc) {
      __builtin_amdgcn_fence(__ATOMIC_RELEASE, "agent");
      asm volatile("s_waitcnt vmcnt(0)" ::: "memory");
      const unsigned og = xb_add(&bar[XB_TOP], 1u);
      const unsigned tg = og / nx;
      if (og + 1u == (tg + 1u) * nx) xb_add(&bar[XB_TOPGEN], 1u);
      else XB_SPIN(xb_ld(&bar[XB_TOPGEN]) == tg, bar);
      __builtin_amdgcn_fence(__ATOMIC_ACQUIRE, "agent");
      xb_add(&bar[XB_XGEN(x)], 1u);
      asm volatile("s_waitcnt vmcnt(0)" ::: "memory");
    } else {
      XB_SPIN(xb_ld(&bar[XB_XGEN(x)]) == gen, bar);
      __builtin_amdgcn_fence(__ATOMIC_ACQUIRE, "agent");
      asm volatile("s_waitcnt vmcnt(0)" ::: "memory");
    }
  }
  __syncthreads();
}

#ifndef PROBE
#define PROBE -1
#endif
#define GSYNC() xcd_barrier(p)
#define PHASE(id, ...) do { { const float rcf = 1.f; (void)rcf; __VA_ARGS__ } GSYNC(); if (PROBE == (id)) { { const float rcf = 0.f; (void)rcf; __VA_ARGS__ } GSYNC(); } } while (0)
__global__ void __launch_bounds__(NTHREADS) mega(Params p_in) {
  cg::grid_group grid = cg::this_grid();
  Params p = p_in;
  p.wv = __builtin_amdgcn_readfirstlane((int)(threadIdx.x >> 6));
  if (threadIdx.x == 0) {
    volatile unsigned* st = (volatile unsigned*)(smem + LDS_BYTES - 256); st[0] = 0u; st[1] = 0u;
    (void)xb_add(&((unsigned*)(p.ws + OFF_BAR))[XB_XCNT(xb_xcc_id())], 1u);
  }
  __syncthreads();
  phase0(p);
  grid.sync();
  if (PROBE == 0) { phase0(p); GSYNC(); }
  float* const SSQ = (float*)(p.ws + OFF_SSQ);
  const float* const GVt = (const float*)(p.ws + OFF_GV);
#pragma unroll 1
  for (int l = 0; l < 2; ++l) {
    const int Mpost = l == 0 ? T : TL;
    if (l == 0) PHASE(1, norm_phase(p, 0, 0, 0, T, true); prep2_phase(p);
      { const f32x4* src = (const f32x4*)p.in[2]; f32x4* dst = (f32x4*)((float*)(p.ws + OFF_X) + (size_t)TL * D);
        for (int i = blockIdx.x * NTHREADS + otid(); i < TC * D / 4; i += gridDim.x * NTHREADS) dst[i] = src[i]; });
    PHASE(2, { EpiAct e{(u16*)(p.ws + OFF_BIG), l == 1 ? SSQ + (size_t)1 * 4 * T : nullptr, (const float*)(p.ws + OFF_SW1)};
      gemm_phase(p, (const u16*)(p.ws + OFF_H), (const u16*)(p.ws + OFF_W1T) + (size_t)(l * 2 + 0) * 5632 * 1024, T, 2 * DFF, D, 0, e); });
    PHASE(3, { float* X = (float*)(p.ws + OFF_X); const float* modl = (const float*)(p.ws + OFF_MOD) + (size_t)l * 9 * 9216;
      const u16* W2 = (const u16*)(p.ws + OFF_W2T) + (size_t)(l * 2 + 0) * 1024 * 2816;
      EpiRes e{(l == 0 && rcf != 0.f) ? p.in[0] : X, X + (size_t)TL * D, X, modl, 2, 0.5f * rcf,
               rcf != 0.f ? (u16*)(p.ws + OFF_H) : nullptr, GVt + (size_t)(l * 3 + 1) * 9 * D, rcf != 0.f ? SSQ + (size_t)(l == 0 ? 0 : 2) * 4 * T : nullptr, (u16*)(p.ws + OFF_PS)};
      gemm_phase(p, (const u16*)(p.ws + OFF_BIG), W2, TL, D, DFF, TC, e); });
    PHASE(14, ctx_combine_phase(p, l, 2, 0.5f * rcf, l, 1););
    PHASE(4, { EpiProj e{(u16*)(p.ws + OFF_PT), (u16*)(p.ws + OFF_QK), (const float*)(p.ws + OFF_ROPE), (const float*)(p.ws + OFF_ROPE) + 4096 * 32,
                         SSQ + (size_t)(l == 0 ? 0 : 2) * 4 * T, (const float*)(p.ws + OFF_SWIN) + (size_t)l * 9 * 2048};
      gemm_phase(p, (const u16*)(p.ws + OFF_H), (const u16*)(p.ws + OFF_WINT) + (size_t)l * 2048 * 1024, T, DIN, D, 0, e); });
    PHASE(5, { const int n_att = l == 0 ? 512 + 32 : 512, n_lru = 1088;
      for (int it = blockIdx.x; it < n_att + n_lru; it += gridDim.x) { if (it < n_att) attn_item(p, l, it); else lru_item(p, l, it - n_att, 0); }
      uprep_phase(p, l); });
    if (PROBE == 8) { for (int it = blockIdx.x; it < 1088; it += gridDim.x) lru_item(p, l, it, 0); GSYNC(); }
    if (PROBE == 9) { for (int it = blockIdx.x; it < 512; it += gridDim.x) attn_item(p, l, it); GSYNC(); }
    if (PROBE == 11) { uprep_phase(p, l); GSYNC(); }
    PHASE(6, { const int n_t1 = 256, n_t2 = l == 0 ? 256 : 0, n_lru = l == 0 ? 1088 : 1024;
      for (int it = blockIdx.x; it < n_t1 + n_t2 + n_lru; it += gridDim.x) {
        if (it < n_t1) toep_item_lat(p, l, it);
        else if (it < n_t1 + n_t2) toep_item(p, l, it - n_t1, 1);
        else lru_item(p, l, it - n_t1 - n_t2, 1);
      } });
    if (PROBE == 10) { for (int it = blockIdx.x; it < 256; it += gridDim.x) toep_item_lat(p, l, it); GSYNC(); }
    PHASE(12, yht_phase(p, Mpost););
    PHASE(7, { float* X = (float*)(p.ws + OFF_X); const float* modl = (const float*)(p.ws + OFF_MOD) + (size_t)l * 9 * 9216;
      const u16* WO = (const u16*)(p.ws + OFF_WOT) + (size_t)l * 1024 * 1024;
      EpiRes e{X, X + (size_t)TL * D, X, modl, 5, 1.0f * rcf, nullptr, nullptr, nullptr, (u16*)(p.ws + OFF_PS)};
      gemm_phase(p, (const u16*)(p.ws + OFF_H), WO, TL, D, D, l == 0 ? TC : 0, e); });
    PHASE(1, norm_phase(p, l, 2, 0, TL, false); if (l == 0) ctx_combine_phase(p, 0, 5, 1.0f * rcf, 0, 2););
    PHASE(2, { EpiAct e{(u16*)(p.ws + OFF_BIG), nullptr, nullptr};
      gemm_phase(p, (const u16*)(p.ws + OFF_H), (const u16*)(p.ws + OFF_W1T) + (size_t)(l * 2 + 1) * 5632 * 1024, Mpost, 2 * DFF, D, 0, e); });
    PHASE(3, { float* X = (float*)(p.ws + OFF_X); const float* modl = (const float*)(p.ws + OFF_MOD) + (size_t)l * 9 * 9216;
      const u16* W2 = (const u16*)(p.ws + OFF_W2T) + (size_t)(l * 2 + 1) * 1024 * 2816;
      EpiRes e{X, X + (size_t)TL * D, X, modl, 8, 0.5f * rcf,
               (l == 0 && rcf != 0.f) ? (u16*)(p.ws + OFF_H) : nullptr, GVt + (size_t)(1 * 3 + 0) * 9 * D, (l == 0 && rcf != 0.f) ? SSQ + (size_t)1 * 4 * T : nullptr, (u16*)(p.ws + OFF_PS)};
      gemm_phase(p, (const u16*)(p.ws + OFF_BIG), W2, TL, D, DFF, l == 0 ? TC : 0, e); });
    if (l == 0) PHASE(14, ctx_combine_phase(p, 0, 8, 0.5f * rcf, 1, 0););
  }
  if (PROBE == 13) { for (int i = 0; i < 20; ++i) GSYNC(); }
  final_norm_phase(p);
}

extern "C" void kernel_launch(void* const* d_in, const int* in_sizes, int n_in, void* d_out, int out_size, void* d_ws, size_t ws_size, hipStream_t stream) {
  static int grid_blocks = 0;
  if (!grid_blocks) {
    if (ws_size < WS_END || n_in != 29) { fprintf(stderr, "kernel_launch: workspace %zu < %zu or n_in %d != 29\n", ws_size, (size_t)WS_END, n_in); grid_blocks = -1; return; }
    int dev = 0, cus = 0, per_cu = 0;
    hipGetDevice(&dev);
    hipDeviceGetAttribute(&cus, hipDeviceAttributeMultiprocessorCount, dev);
    if (hipFuncSetAttribute((const void*)mega, hipFuncAttributeMaxDynamicSharedMemorySize, LDS_BYTES) != hipSuccess) { fprintf(stderr, "hipFuncSetAttribute failed\n"); }
    hipOccupancyMaxActiveBlocksPerMultiprocessor(&per_cu, (const void*)mega, NTHREADS, LDS_BYTES);
    if (per_cu < 1) { fprintf(stderr, "occupancy query returned %d\n", per_cu); per_cu = 1; }
    if (per_cu > 1) per_cu = 1;
    grid_blocks = cus * per_cu;
    (void)hipGetLastError();
  }
  if (grid_blocks < 0) return;
  Params p{};
  for (int i = 0; i < 29; ++i) p.in[i] = (const float*)d_in[i];
  p.out = (float*)d_out; p.ws = (unsigned char*)d_ws;
  if (hipMemsetAsync((char*)d_ws + OFF_BAR, 0, (size_t)3456 * 4, stream) != hipSuccess) { fprintf(stderr, "kernel_launch: memset of the barrier words failed\n"); return; }
  void* args[] = {&p};
  hipError_t e = hipLaunchCooperativeKernel((void*)mega, dim3(grid_blocks), dim3(NTHREADS), args, LDS_BYTES, stream);
  if (e != hipSuccess) fprintf(stderr, "cooperative launch failed: %s (grid %d)\n", hipGetErrorString(e), grid_blocks);
}
```

```cpp
#include <hip/hip_runtime.h>
#include <hip/hip_cooperative_groups.h>
#include <cstdio>
namespace cg = cooperative_groups;

using bf16x8 = __attribute__((ext_vector_type(8))) short;
using bf16x4 = __attribute__((ext_vector_type(4))) short;
using f32x4  = __attribute__((ext_vector_type(4))) float;
typedef unsigned short u16;
#define DEVI __device__ __forceinline__

constexpr int D = 1024, NB = 8, SEQ = 4096, CTXL = 256, TL = NB * SEQ, TC = NB * CTXL, T = TL + TC;
constexpr int DFF = 2816, DIN = 2048;
constexpr int NTHREADS = 512;
constexpr int LDS_BYTES = 163840;

constexpr size_t OFF_X    = 0;
constexpr size_t OFF_H    = OFF_X + (size_t)T * D * 4;
constexpr size_t OFF_BIG  = OFF_H + (size_t)T * D * 2;
constexpr size_t OFF_PT   = OFF_BIG;
constexpr size_t OFF_QK   = OFF_PT + (size_t)1408 * T * 2;
constexpr size_t OFF_UT   = OFF_QK + (size_t)T * 640 * 2;
constexpr size_t OFF_X0T  = OFF_UT + (size_t)256 * T * 2;
constexpr size_t OFF_SUMM = OFF_X0T + (size_t)256 * T * 2;
constexpr size_t OFF_W1T  = OFF_BIG + (size_t)T * DFF * 2;
constexpr size_t OFF_W2T  = OFF_W1T + (size_t)4 * 5632 * 1024 * 2;
constexpr size_t OFF_WINT = OFF_W2T + (size_t)4 * 1024 * 2816 * 2;
constexpr size_t OFF_WOT  = OFF_WINT + (size_t)2 * 2048 * 1024 * 2;
constexpr size_t OFF_MOD  = OFF_WOT + (size_t)2 * 1024 * 1024 * 2;
constexpr size_t OFF_KF   = OFF_MOD + (size_t)2 * 9 * 9216 * 4;
constexpr size_t OFF_KFC  = OFF_KF + (size_t)2 * 256 * 8192 * 2;
constexpr size_t OFF_ROPE = OFF_KFC + (size_t)256 * 512 * 2;
constexpr size_t OFF_WGT  = OFF_ROPE + (size_t)2 * 4096 * 32 * 4;
constexpr size_t OFF_GV   = OFF_WGT + (size_t)2 * 2 * 2 * 4 * 64 * 64 * 2;
constexpr size_t OFF_SWIN = OFF_GV + (size_t)6 * 9 * 1024 * 4;
constexpr size_t OFF_SW1  = OFF_SWIN + (size_t)2 * 9 * 2048 * 4;
constexpr size_t OFF_SSQ  = OFF_SW1 + (size_t)9 * 5632 * 4;
constexpr size_t OFF_BAR  = OFF_SSQ + (size_t)3 * 4 * T * 4;
constexpr size_t OFF_YHT  = OFF_BAR + (size_t)3456 * 4;
constexpr size_t OFF_PS   = OFF_YHT;
constexpr size_t WS_END   = OFF_PS + (size_t)7 * TC * D * 2;
static_assert((size_t)256 * T * 2 <= (size_t)7 * TC * D * 2, "YHT must fit inside the PS region");
static_assert(OFF_SUMM + 2 * 272 * 256 * 8 <= OFF_W1T, "mixer buffers overflow ACT region");

struct Params {
  const float* in[29];
  float* out;
  unsigned char* ws;
  int wv, pad_;
};

extern __shared__ __attribute__((aligned(16))) unsigned char smem[];

DEVI unsigned pk_bf16(float lo, float hi) { unsigned r; asm volatile("v_cvt_pk_bf16_f32 %0, %1, %2" : "=v"(r) : "v"(lo), "v"(hi)); return r; }
DEVI u16 f2bf(float x) { return (u16)(pk_bf16(x, 0.f) & 0xffffu); }
DEVI float bf2f(u16 h) { return __uint_as_float(((unsigned)h) << 16); }
DEVI float sigmoidf_(float x) { return __builtin_amdgcn_rcpf(1.f + __expf(-x)); }
DEVI float gelu_tanh(float x) { float z = 0.7978845608028654f * (x + 0.044715f * x * x * x); float th = 1.f - 2.f * __builtin_amdgcn_rcpf(1.f + __expf(2.f * z)); return 0.5f * x * (1.f + th); }
template <class Tp> DEVI const Tp* opaque(const Tp* q) { asm volatile("" : "+s"(q)); return q; }
DEVI int otid_(int wv) { int t; asm volatile("v_mbcnt_lo_u32_b32 %0, -1, 0\n\tv_mbcnt_hi_u32_b32 %0, -1, %0" : "=v"(t)); return (wv << 6) | t; }
#define otid() otid_(p.wv)
DEVI float shx(float v, int o, int lane) { return __int_as_float(__builtin_amdgcn_ds_bpermute((lane ^ o) << 2, __float_as_int(v))); }
DEVI float swz_xor16(float v) { return __int_as_float(__builtin_amdgcn_ds_swizzle(__float_as_int(v), 0x401F)); }
DEVI f32x4 mfma16(bf16x8 a, bf16x8 b, f32x4 c) { return __builtin_amdgcn_mfma_f32_16x16x32_bf16(a, b, c, 0, 0, 0); }

constexpr int BM = 256, BK = 64, HALF = 128, HT = HALF * BK;
DEVI int lds_byte(int r, int c) { int st = (r >> 4) * 2 + (c >> 5), rr = r & 15, cc = c & 31, ob = rr * 64 + cc * 2; return st * 1024 + (ob ^ (((ob >> 9) & 1) << 5)); }
DEVI void stage_rc(int b, int& R, int& C) { int st = b / 1024, sb = b % 1024, swz = sb ^ (((sb >> 9) & 1) << 5); R = (st >> 1) * 16 + swz / 64; C = (st & 1) * 32 + (swz % 64) / 2; }

DEVI bool tile_next(int i, int nM, int nN, int& pm, int& pn) {
  const int nwg = nM * nN; const long Lx = (long)i * gridDim.x + blockIdx.x; if (Lx >= nwg) return false;
  int wgid = (int)Lx; { const int q = nwg / 8, r = nwg % 8, xcd = wgid % 8, off = wgid / 8; wgid = (xcd < r ? xcd * (q + 1) : r * (q + 1) + (xcd - r) * q) + off; }
  constexpr int WGM = 4; const int nig = WGM * nN, gid = wgid / nig, fm = gid * WGM, gsz = (nM - fm) < WGM ? (nM - fm) : WGM;
  pm = fm + ((wgid % nig) % gsz); pn = (wgid % nig) / gsz; return true;
}
template <class Epi>
DEVI void gemm_phase(const Params& p, const u16* __restrict__ A, const u16* __restrict__ Bt, const int M, const int N, const int K, const int Msplit, const Epi& epi) {
  u16* shm = (u16*)smem;
#define SA(b, h) (shm + ((b) * 2 + (h)) * HT)
#define SB(b, h) (shm + (4 + (b) * 2 + (h)) * HT)
#define STAGE(P, BASE, br, kt) do { const char* _ub = (const char*)(BASE + (long)(br) * K + (long)(kt) * BK); asm volatile("" : "+s"(_ub)); \
      __builtin_amdgcn_global_load_lds((const unsigned*)(_ub + soff0), (unsigned*)((char*)(P) + p.wv * 1024), 16, 0, 0); \
      __builtin_amdgcn_global_load_lds((const unsigned*)(_ub + soff1), (unsigned*)((char*)(P) + p.wv * 1024 + 8192), 16, 0, 0); } while (0)
#define LDA(dst, b, h) for (int m = 0; m < 4; ++m) for (int k = 0; k < 2; ++k) \
    dst[m][k] = *reinterpret_cast<const bf16x8*>((char*)SA(b, h) + lds_byte(wr * 64 + m * 16 + fr, k * 32 + fq * 8))
#define LDB(dst, b, h) for (int n = 0; n < 2; ++n) for (int k = 0; k < 2; ++k) \
    dst[n][k] = *reinterpret_cast<const bf16x8*>((char*)SB(b, h) + lds_byte(wc * 32 + n * 16 + fr, k * 32 + fq * 8))
#define MMA(ai, bj, At_, Bt_) do { __builtin_amdgcn_s_setprio(1); \
    for (int m = 0; m < 4; ++m) for (int n = 0; n < 2; ++n) for (int k = 0; k < 2; ++k) \
      acc[ai][bj][m][n] = Epi::TR ? __builtin_amdgcn_mfma_f32_16x16x32_bf16(Bt_[n][k], At_[m][k], acc[ai][bj][m][n], 0, 0, 0) \
                                  : __builtin_amdgcn_mfma_f32_16x16x32_bf16(At_[m][k], Bt_[n][k], acc[ai][bj][m][n], 0, 0, 0); \
    __builtin_amdgcn_s_setprio(0); } while (0)
#define WAIT_V(n) asm volatile("s_waitcnt vmcnt(" #n ")" ::: "memory")
#define WAIT_L(n) asm volatile("s_waitcnt lgkmcnt(" #n ")" ::: "memory")
#define BAR __builtin_amdgcn_s_barrier()
#define SCHED __builtin_amdgcn_sched_barrier(0)
#define PRO_K0(brow_, bcol_) do { STAGE(SB(0, 0), Bt, bcol_, 0); STAGE(SA(0, 0), A, brow_, 0); STAGE(SB(0, 1), Bt, (bcol_) + HALF, 0); STAGE(SA(0, 1), A, (brow_) + HALF, 0); } while (0)
#define PRO_K1(brow_, bcol_) do { STAGE(SB(1, 0), Bt, bcol_, 1); STAGE(SA(1, 0), A, brow_, 1); STAGE(SB(1, 1), Bt, (bcol_) + HALF, 1); } while (0)
  const int tid = otid();
  const int wid = tid >> 6, lane = tid & 63, wr = wid >> 2, wc = wid & 3, fr = lane & 15, fq = lane >> 4;
  unsigned soff0, soff1;
  { int r_, c_; stage_rc(tid * 16, r_, c_); soff0 = (unsigned)(r_ * K + c_) * 2u; stage_rc(tid * 16 + 8192, r_, c_); soff1 = (unsigned)(r_ * K + c_) * 2u; }
  const int nM = M / BM, nN = N / BM, ntT = K / BK, nfull = nM * nN, nsl = (Msplit / BM) * nN * 7;
  auto unit_next = [&](const int i, int& pm_, int& pn_, int& kt0_, int& ntl_) -> bool {
    kt0_ = 0; ntl_ = ntT;
    if (tile_next(i, nM, nN, pm_, pn_)) return true;
    const long u = (long)i * gridDim.x + blockIdx.x - nfull; if (u >= nsl) return false;
    const int tl = (int)(u / 7), sl = (int)(u % 7); pm_ = nM + tl / nN; pn_ = tl % nN;
    const int base = (ntT / 7) & ~1;
    kt0_ = sl * base; ntl_ = sl < 6 ? base : ntT - 6 * base;
    return true;
  };
  int pm, pn, kt0, nt;
  bool have = unit_next(0, pm, pn, kt0, nt);
  const u16* A0 = A; const u16* B0p = Bt;
  if (have) { A = A0 + (long)kt0 * BK; Bt = B0p + (long)kt0 * BK; PRO_K0(pm * BM, pn * BM); PRO_K1(pm * BM, pn * BM); }
#pragma unroll 1
  for (int it = 0; have; ++it) {
    const int brow = pm * BM, bcol = pn * BM;
    const int slcur = brow < M ? -1 : kt0 / ((ntT / 7) & ~1);
    int kt0n = 0, ntn = 2;
    const bool have2 = unit_next(it + 1, pm, pn, kt0n, ntn);
    const u16* An = A0 + (long)kt0n * BK; const u16* Bn = B0p + (long)kt0n * BK;
    f32x4 acc[2][2][4][2] = {};
    bf16x8 At[4][2], B0[2][2], B1[2][2];
    if (it == 0) { WAIT_V(0); } else { if constexpr (Epi::NST == 16) WAIT_V(16); else if constexpr (Epi::NST == 32) WAIT_V(32); else WAIT_V(0); }
    if (wr == 1) BAR;
    BAR;
    BAR;
    for (int t = 0; t < nt - 2; t += 2) {
      LDB(B0, 0, 0); SCHED; LDA(At, 0, 0); STAGE(SA(1, 1), A, brow + HALF, t + 1);
      WAIT_L(8); BAR; WAIT_L(0); MMA(0, 0, At, B0); BAR; SCHED;
      LDB(B1, 0, 1); STAGE(SB(0, 0), Bt, bcol, t + 2);
      BAR; WAIT_L(0); MMA(0, 1, At, B1); BAR;
      LDA(At, 0, 1); STAGE(SA(0, 0), A, brow, t + 2);
      BAR; WAIT_L(0); MMA(1, 0, At, B0); BAR; SCHED;
      STAGE(SB(0, 1), Bt, bcol + HALF, t + 2);
      WAIT_V(6); BAR; MMA(1, 1, At, B1); BAR;
      LDB(B0, 1, 0); SCHED; LDA(At, 1, 0); STAGE(SA(0, 1), A, brow + HALF, t + 2);
      WAIT_L(8); BAR; WAIT_L(0); MMA(0, 0, At, B0); BAR; SCHED;
      LDB(B1, 1, 1); STAGE(SB(1, 0), Bt, bcol, t + 3);
      BAR; WAIT_L(0); MMA(0, 1, At, B1); BAR;
      LDA(At, 1, 1); STAGE(SA(1, 0), A, brow, t + 3);
      BAR; WAIT_L(0); MMA(1, 0, At, B0); BAR; SCHED;
      STAGE(SB(1, 1), Bt, bcol + HALF, t + 3);
      WAIT_V(6); BAR; MMA(1, 1, At, B1); BAR;
    }
    { LDB(B0, 0, 0); LDA(At, 0, 0); STAGE(SA(1, 1), A, brow + HALF, nt - 1);
      BAR; WAIT_L(0); MMA(0, 0, At, B0); BAR;
      LDB(B1, 0, 1); BAR; WAIT_L(0); MMA(0, 1, At, B1); BAR;
      LDA(At, 0, 1); WAIT_V(4); BAR; WAIT_L(0); MMA(1, 0, At, B0); MMA(1, 1, At, B1); BAR; }
    { LDB(B0, 1, 0); LDA(At, 1, 0); WAIT_V(2); BAR;
      if (have2) { const u16* Asv = A; const u16* Bsv = Bt; A = An; Bt = Bn; PRO_K0(pm * BM, pn * BM); A = Asv; Bt = Bsv; }
      WAIT_L(0); MMA(0, 0, At, B0); BAR;
      LDB(B1, 1, 1); if (have2) { WAIT_V(8); } else { WAIT_V(0); } BAR; WAIT_L(0); MMA(0, 1, At, B1); BAR;
      LDA(At, 1, 1); BAR; WAIT_L(0); MMA(1, 0, At, B0); MMA(1, 1, At, B1); BAR; }
    if (wr == 0) BAR;
    have = have2;
    A = An; Bt = Bn; nt = ntn; kt0 = kt0n;
    if (have) { PRO_K1(pm * BM, pn * BM); }
    { const int tid2 = otid(), wid2 = tid2 >> 6, lane2 = tid2 & 63, wr2 = wid2 >> 2, wc2 = wid2 & 3, fr2 = lane2 & 15, fq2 = lane2 >> 4;
      float sq[8] = {0.f, 0.f, 0.f, 0.f, 0.f, 0.f, 0.f, 0.f};
      float* rl = (float*)((char*)shm + 3 * HT * 2);
      bool nrm = false;
      if constexpr (Epi::NRM) {
        nrm = epi.ssq != nullptr && brow < TL;
        if (nrm) {
          if (tid2 < 256) { const float* q = epi.ssq + brow + tid2; rl[tid2] = rsqrtf(((q[0] + q[T]) + (q[2 * T] + q[3 * T])) * (1.f / D) + 1e-6f); }
          WAIT_L(0); BAR;
        }
      }
#pragma unroll
      for (int ai = 0; ai < 2; ++ai)
#pragma unroll
        for (int bj = 0; bj < 2; ++bj) {
          const int colb = bcol + bj * HALF + wc2 * 32;
          typename Epi::Pre pre;
          if constexpr (Epi::NRM || Epi::SQ) epi.preload(pre, brow, colb, wr2, fr2, fq2, nrm, slcur);
#pragma unroll
          for (int m = 0; m < 4; ++m) {
            const int rloc = ai * HALF + wr2 * 64 + m * 16;
            if constexpr (Epi::SQ) epi(brow + rloc + fr2, colb, fq2, acc[ai][bj][m][0], acc[ai][bj][m][1], sq[ai * 4 + m], slcur, pre);
            else if constexpr (Epi::TR) { float rv = 1.f; if (nrm) rv = rl[rloc + fr2]; epi(brow + rloc + fr2, colb, fq2, acc[ai][bj][m][0], acc[ai][bj][m][1], rv, nrm, pre); }
            else { f32x4 rv = {1.f, 1.f, 1.f, 1.f}; if (nrm) rv = *(const f32x4*)(rl + rloc + fq2 * 4); epi(brow + rloc + fq2 * 4, colb, fr2, acc[ai][bj][m][0], acc[ai][bj][m][1], rv, nrm, pre); }
          }
        }
      if constexpr (Epi::SQ) {
        if (epi.part && slcur < 0) {
          float* lp = (float*)((char*)shm + 3 * HT * 2);
#pragma unroll
          for (int i = 0; i < 8; ++i) {
            float v = sq[i]; v += swz_xor16(v); v += shx(v, 32, lane2);
            if (fq2 == 0) lp[wc2 * 256 + (i >> 2) * HALF + wr2 * 64 + (i & 3) * 16 + fr2] = v;
          }
          WAIT_L(0); BAR;
          if (tid2 < 256) epi.part[(size_t)(bcol >> 8) * T + brow + tid2] = (lp[tid2] + lp[256 + tid2]) + (lp[512 + tid2] + lp[768 + tid2]);
        }
      } }
  }
  __syncthreads();
#undef SA
#undef SB
#undef STAGE
#undef LDA
#undef LDB
#undef MMA
#undef PRO_K0
#undef PRO_K1
}

struct EpiAct {
  static constexpr bool TR = true, SQ = false, NRM = true; static constexpr int NST = 16;
  u16* act; const float* ssq; const float* sw;
  struct Pre { f32x4 sa, sb; };
  DEVI void preload(Pre& q, int brow, int colb, int wr, int fr, int fq, bool nrm, int) const {
    if (nrm) { const int r = brow < TL ? (brow >> 12) : 8; q.sa = *(const f32x4*)(sw + (size_t)r * 5632 + colb + 4 * fq); q.sb = *(const f32x4*)(sw + (size_t)r * 5632 + colb + 16 + 4 * fq); }
  }
  DEVI void operator()(int row, int colb, int fq, const f32x4& a0, const f32x4& a1, const float rinv, const bool nrm, const Pre& q) const {
    const int oc = (colb >> 5) * 16 + 4 * fq;
    f32x4 xa = a0, xb = a1;
    if (nrm) {
#pragma unroll
      for (int j = 0; j < 4; ++j) { xa[j] = xa[j] * rinv + q.sa[j]; xb[j] = xb[j] * rinv + q.sb[j]; }
    }
    float v[4];
#pragma unroll
    for (int j = 0; j < 4; ++j) { const float a = xa[j]; v[j] = a * sigmoidf_(a) * xb[j]; }
    uint2 o; o.x = pk_bf16(v[0], v[1]); o.y = pk_bf16(v[2], v[3]);
    *(uint2*)(act + (size_t)row * DFF + oc) = o;
  }
};
struct EpiRes {
  static constexpr bool TR = true, SQ = true, NRM = false; static constexpr int NST = 32;
  const float* xin_lat; const float* xin_ctx;
  float* xout; const float* modl;
  int gi; float coef;
  u16* xg; const float* gvl; float* part;
  struct Pre { f32x4 gv[2], G[2]; };
  u16* ps;
  DEVI void preload(Pre& q, int brow, int colb, int wr, int fr, int fq, bool, int slice) const {
    if (slice >= 0) return;
    const int r = brow < TL ? (brow >> 12) : 8;
    const float* gate = modl + (size_t)(r * 9 + gi) * D;
#pragma unroll
    for (int n = 0; n < 2; ++n) {
      const int col = colb + n * 16 + 4 * fq;
      q.gv[n] = *(const f32x4*)(gate + col);
      if (xg) q.G[n] = *(const f32x4*)(gvl + (size_t)r * D + col);
    }
  }
  DEVI void operator()(int row, int colb, int fq, const f32x4& a0, const f32x4& a1, float& sqacc, const int slice, const Pre& q) const {
    if (slice >= 0) {
#pragma unroll
      for (int n = 0; n < 2; ++n) {
        const int col = colb + n * 16 + 4 * fq;
        const f32x4& a = n ? a1 : a0;
        uint2 w; w.x = pk_bf16(a[0], a[1]); w.y = pk_bf16(a[2], a[3]);
        *(uint2*)(ps + ((size_t)slice * TC + (row - TL)) * D + col) = w;
      }
      return;
    }
    const float* src = row < TL ? xin_lat + (size_t)row * D : xin_ctx + (size_t)(row - TL) * D;
    const f32x4 xi0 = *(const f32x4*)(src + colb + 4 * fq), xi1 = *(const f32x4*)(src + colb + 16 + 4 * fq);
#pragma unroll
    for (int n = 0; n < 2; ++n) {
      const int col = colb + n * 16 + 4 * fq;
      const f32x4& a = n ? a1 : a0; const f32x4& xi = n ? xi1 : xi0;
      f32x4 o;
#pragma unroll
      for (int j = 0; j < 4; ++j) o[j] = xi[j] + coef * q.gv[n][j] * a[j];
      *(f32x4*)(xout + (size_t)row * D + col) = o;
      if (xg) {
        sqacc += (o[0] * o[0] + o[1] * o[1]) + (o[2] * o[2] + o[3] * o[3]);
        uint2 w; w.x = pk_bf16(o[0] * q.G[n][0], o[1] * q.G[n][1]); w.y = pk_bf16(o[2] * q.G[n][2], o[3] * q.G[n][3]);
        *(uint2*)(xg + (size_t)row * D + col) = w;
      }
    }
  }
};
struct EpiProj {
  static constexpr bool TR = false, SQ = false, NRM = true; static constexpr int NST = 32;
  u16* pt; u16* qk; const float* cost; const float* sint; const float* ssq; const float* sw;
  struct Pre { float s0, s1, invrev; };
  DEVI void preload(Pre& q, int brow, int colb, int wr, int fr, int fq, bool nrm, int) const {
    const int r = brow < TL ? (brow >> 12) : 8;
    q.s0 = nrm ? sw[r * 2048 + colb + fr] : 0.f; q.s1 = nrm ? sw[r * 2048 + colb + 16 + fr] : 0.f;
    q.invrev = exp2f(-(float)fr * (13.287712379549449f / 16.f)) * 0.15915494309189535f;
  }
  DEVI void operator()(int row0, int colb, int fr, const f32x4& b0, const f32x4& b1, const f32x4& rv, const bool nrm, const Pre& q) const {
    f32x4 a0, a1;
#pragma unroll
    for (int j = 0; j < 4; ++j) { a0[j] = b0[j] * rv[j] + q.s0; a1[j] = b1[j] * rv[j] + q.s1; }
    if (colb < 1280 || colb >= 1920) {
#pragma unroll
      for (int n = 0; n < 2; ++n) {
        const int pc = colb + n * 16 + fr; const int ptc = pc < 1280 ? pc : pc - 640;
        const f32x4& a = n ? a1 : a0;
        uint2 o; o.x = pk_bf16(a[0], a[1]); o.y = pk_bf16(a[2], a[3]);
        *(uint2*)(pt + (size_t)ptc * T + row0) = o;
      }
    } else {
      const int off = colb - 1280, head = off >> 6, grp = (off >> 5) & 1, pidx = 16 * grp + fr;
      const int d1 = head * 64 + pidx, d2 = d1 + 32;
      const float qs = head < 8 ? 0.125f * 1.4426950408889634f : 1.f;
#pragma unroll
      for (int j = 0; j < 4; ++j) {
        const int row = row0 + j; float c = 1.f, sn = 0.f;
        if (row < TL) { const int t = row & 4095; const float rev = (float)(grp ? (t & 63) : (t >> 6)) * q.invrev; c = __builtin_amdgcn_cosf(rev); sn = __builtin_amdgcn_sinf(rev); }
        const float o1 = (a0[j] * c - a1[j] * sn) * qs, o2 = (a0[j] * sn + a1[j] * c) * qs;
        qk[(size_t)row * 640 + d1] = f2bf(o1); qk[(size_t)row * 640 + d2] = f2bf(o2);
      }
    }
  }
};

DEVI int srccol(int mode, int pn) {
  if (mode == 1) { const int g = pn >> 5, hh = (pn >> 4) & 1, i = pn & 15; return hh * DFF + g * 16 + i; }
  if (mode == 2) { if (pn < 1280 || pn >= 1920) return pn; const int off = pn - 1280, head = off >> 6, w = off & 63, grp = w >> 5, hh = (w >> 4) & 1, i = w & 15; return 1280 + head * 64 + 16 * grp + i + 32 * hh; }
  return pn;
}
DEVI void transpose_item(const Params& p, const float* __restrict__ W, int K, int N, u16* __restrict__ WT, int mode, int item) {
  float* tile = (float*)smem;
  const int tid = otid(), nblk = N / 256, kb = item / nblk, nb = item % nblk, k0 = kb * 64, n0 = nb * 256;
  { const int nn = tid & 63, kr = tid >> 6;
#pragma unroll
    for (int c4 = 0; c4 < 4; ++c4) {
      const int src = srccol(mode, n0 + c4 * 64 + nn);
#pragma unroll
      for (int r = 0; r < 8; ++r) { const int kk = kr + 8 * r; tile[kk * 257 + c4 * 64 + nn] = W[(size_t)(k0 + kk) * N + src]; }
    } }
  __syncthreads();
#pragma unroll
  for (int c4 = 0; c4 < 4; ++c4) {
    const int rown = c4 * 64 + (tid >> 3), kc = tid & 7; const float* s = tile + (kc * 8) * 257 + rown;
    uint4 o; o.x = pk_bf16(s[0], s[257]); o.y = pk_bf16(s[514], s[771]); o.z = pk_bf16(s[1028], s[1285]); o.w = pk_bf16(s[1542], s[1799]);
    *(uint4*)(WT + (size_t)(n0 + rown) * K + k0 + kc * 8) = o; }
  __syncthreads();
}
DEVI void mod_item(const Params& p, int item) {
  float* sv = (float*)smem;
  float* red = sv + 9 * 1024;
  const int tid = otid(), l = item / 144, n0 = (item % 144) * 64;
  for (int i = tid; i < 9 * 1024; i += NTHREADS) { const int r = i >> 10, k = i & 1023; const float cv = r < 8 ? p.in[1][r * 1024 + k] : p.in[3][k]; sv[i] = cv * sigmoidf_(cv); }
  __syncthreads();
  const int cc = tid & 63, kq = tid >> 6;
  const float* w = p.in[4] + (size_t)l * 1024 * 9216 + n0 + cc;
  float acc[9];
#pragma unroll
  for (int r = 0; r < 9; ++r) acc[r] = 0.f;
#pragma unroll 4
  for (int k4 = 0; k4 < 32; ++k4) {
    const int k = kq * 128 + k4 * 4;
    const float w0 = w[(size_t)k * 9216], w1 = w[(size_t)(k + 1) * 9216], w2 = w[(size_t)(k + 2) * 9216], w3 = w[(size_t)(k + 3) * 9216];
#pragma unroll
    for (int r = 0; r < 9; ++r) { const float4 s4 = *(const float4*)(sv + r * 1024 + k); acc[r] += s4.x * w0 + s4.y * w1 + s4.z * w2 + s4.w * w3; }
  }
#pragma unroll
  for (int r = 0; r < 9; ++r) red[(kq * 9 + r) * 64 + cc] = acc[r];
  __syncthreads();
  float* MOD = (float*)(p.ws + OFF_MOD);
  for (int i = tid; i < 9 * 64; i += NTHREADS) {
    const int r = i >> 6, c2 = i & 63;
    float v = p.in[5][l * 9216 + n0 + c2];
#pragma unroll
    for (int q = 0; q < 8; ++q) v += red[(q * 9 + r) * 64 + c2];
    MOD[(size_t)(l * 9 + r) * 9216 + n0 + c2] = v;
  }
  __syncthreads();
}
DEVI void filter_item(const Params& p, int l, int L, u16* __restrict__ KF, int posblk) {
  float* zs = (float*)smem;
  float* hb = zs + 64 * 36;
  const int tid = otid(), w = tid >> 6, j = tid & 63, t0 = posblk * 64 + w * 8;
  const float* fw0 = opaque(p.in[20] + l * 33 * 64); const float* fb0 = opaque(p.in[21] + l * 64);
  const float* fwin = opaque(p.in[22] + l * 2 * 64 * 64); const float* fbin = opaque(p.in[23] + l * 2 * 64);
  const float* freq = opaque(p.in[24] + l * 64); const float* fwl = opaque(p.in[25] + l * 64 * 512);
  const float invL1 = 1.f / (float)(L - 1);
  if (j < 33) {
#pragma unroll
    for (int q = 0; q < 8; ++q) {
      const int t = t0 + q; const float tn = (float)t * invL1;
      float z;
      if (j == 0) z = tn;
      else { const int bi = (j - 1) & 15; const float f = 1e-4f + (float)bi * ((15.f - 1e-4f) / 15.f); const float wv = 6.283185307179586f * (float)t / (float)L; const float a = f * wv; z = (j <= 16) ? __cosf(a) : -__sinf(a); }
      zs[(w * 8 + q) * 36 + j] = z;
    }
  }
  __syncthreads();
  const float fr = freq[j];
  { float acc[8];
    const float b0 = fb0[j];
#pragma unroll
    for (int q = 0; q < 8; ++q) acc[q] = b0;
#pragma unroll 3
    for (int i = 0; i < 33; ++i) { const float wv = fw0[i * 64 + j];
#pragma unroll
      for (int q = 0; q < 8; ++q) acc[q] += zs[(w * 8 + q) * 36 + i] * wv; }
#pragma unroll
    for (int q = 0; q < 8; ++q) hb[(0 * 64 + w * 8 + q) * 64 + j] = __sinf(fr * acc[q]); }
  __syncthreads();
  float* wl = hb + 2 * 64 * 64;
#pragma unroll
  for (int s2 = 0; s2 < 2; ++s2) {
    { const f32x4 w0 = *(const f32x4*)(fwin + s2 * 4096 + tid * 4), w1 = *(const f32x4*)(fwin + s2 * 4096 + (tid + NTHREADS) * 4);
      *(f32x4*)(wl + tid * 4) = w0; *(f32x4*)(wl + (tid + NTHREADS) * 4) = w1; }
    __syncthreads();
    float acc[8];
    const float b0 = fbin[s2 * 64 + j];
#pragma unroll
    for (int q = 0; q < 8; ++q) acc[q] = b0;
#pragma unroll 8
    for (int i = 0; i < 64; ++i) { const float wv = wl[i * 64 + j];
#pragma unroll
      for (int q = 0; q < 8; ++q) acc[q] += hb[((s2 & 1) * 64 + w * 8 + q) * 64 + i] * wv; }
#pragma unroll
    for (int q = 0; q < 8; ++q) hb[(((s2 + 1) & 1) * 64 + w * 8 + q) * 64 + j] = __sinf(fr * acc[q]);
    __syncthreads();
  }
  const float mind = -3.0701134573253945f, maxd = -15.350567286626973f;
#pragma unroll 1
  for (int qq = 0; qq < 8; qq += 2) {
    { f32x4 wv4[4];
#pragma unroll
      for (int k = 0; k < 4; ++k) { const int idx = tid + k * NTHREADS, i = idx >> 5, c4 = idx & 31; wv4[k] = *(const f32x4*)(fwl + i * 512 + 64 * qq + c4 * 4); }
#pragma unroll
      for (int k = 0; k < 4; ++k) { const int idx = tid + k * NTHREADS; *(f32x4*)(wl + idx * 4) = wv4[k]; } }
    __syncthreads();
    float acc[2][8];
#pragma unroll
    for (int q = 0; q < 8; ++q) { acc[0][q] = 0.f; acc[1][q] = 0.f; }
#pragma unroll 8
    for (int i = 0; i < 64; ++i) {
      const float w0 = wl[i * 128 + j], w1 = wl[i * 128 + 64 + j];
#pragma unroll
      for (int q = 0; q < 8; ++q) { const float hv = hb[(0 * 64 + w * 8 + q) * 64 + i]; acc[0][q] += hv * w0; acc[1][q] += hv * w1; }
    }
#pragma unroll
    for (int u = 0; u < 2; ++u) {
      const int n = j + 64 * (qq + u), c = n & 255; const float delta = fabsf(mind + (float)c * ((maxd - mind) / 255.f));
#pragma unroll
      for (int q = 0; q < 8; ++q) {
        const int t = t0 + q; const float val = acc[u][q] * __expf(-((float)t * invL1) * delta);
        if (n < 256) KF[(size_t)c * 2 * L + (L - t)] = f2bf(val);
        else if (t >= 1) KF[(size_t)c * 2 * L + (L + t)] = f2bf(val);
      }
    }
    __syncthreads();
  }
  if (t0 == 0) {
#pragma unroll
    for (int qq = 0; qq < 4; ++qq) KF[(size_t)(j + 64 * qq) * 2 * L] = 0;
  }
  __syncthreads();
}
DEVI void phase0(const Params& p) {
  const int N_MOD_IT = 288, N_FIL = 64 + 64 + 4;
  constexpr int I_W1 = 16 * 22, I_W2 = 44 * 4, I_WIN = 16 * 8, I_WO = 16 * 4;
  const int N_TR = 4 * I_W1 + 4 * I_W2 + 2 * I_WIN + 2 * I_WO;
  const int NIT = N_MOD_IT + N_FIL + N_TR;
  for (int it = blockIdx.x; it < NIT; it += gridDim.x) {
    asm volatile("" ::: "memory");
    int r = it;
    if (r < N_FIL) {
      if (r < 64) filter_item(p, 0, 4096, (u16*)(p.ws + OFF_KF), r);
      else if (r < 128) filter_item(p, 1, 4096, (u16*)(p.ws + OFF_KF) + (size_t)256 * 8192, r - 64);
      else filter_item(p, 0, 256, (u16*)(p.ws + OFF_KFC), r - 128);
      continue;
    }
    r -= N_FIL;
    if (r < N_MOD_IT) { mod_item(p, r); continue; } r -= N_MOD_IT;
    if (r < 4 * I_W1) { const int mi = r / I_W1; transpose_item(p, p.in[7] + (size_t)mi * 1024 * 5632, 1024, 5632, (u16*)(p.ws + OFF_W1T) + (size_t)mi * 5632 * 1024, 1, r % I_W1); continue; } r -= 4 * I_W1;
    if (r < 4 * I_W2) { const int mi = r / I_W2; transpose_item(p, p.in[8] + (size_t)mi * 2816 * 1024, 2816, 1024, (u16*)(p.ws + OFF_W2T) + (size_t)mi * 1024 * 2816, 0, r % I_W2); continue; } r -= 4 * I_W2;
    if (r < 2 * I_WIN) { const int mi = r / I_WIN; transpose_item(p, p.in[9] + (size_t)mi * 1024 * 2048, 1024, 2048, (u16*)(p.ws + OFF_WINT) + (size_t)mi * 2048 * 1024, 2, r % I_WIN); continue; } r -= 2 * I_WIN;
    { const int mi = r / I_WO; transpose_item(p, p.in[10] + (size_t)mi * 1024 * 1024, 1024, 1024, (u16*)(p.ws + OFF_WOT) + (size_t)mi * 1024 * 1024, 0, r % I_WO); }
  }
  float* cost = (float*)(p.ws + OFF_ROPE); float* sint = cost + 4096 * 32;
  for (int idx = blockIdx.x * NTHREADS + otid(); idx < 4096 * 32; idx += gridDim.x * NTHREADS) {
    const int t = idx >> 5, pp = idx & 31;
    const float inv = exp2f(-(float)(pp & 15) * (13.287712379549449f / 16.f));
    const float pos = pp < 16 ? (float)(t >> 6) : (float)(t & 63);
    const float ang = pos * inv;
    cost[idx] = __cosf(ang); sint[idx] = __sinf(ang);
  }
  u16* WGT = (u16*)(p.ws + OFF_WGT);
  for (int o = blockIdx.x * NTHREADS + otid(); o < 2 * 2 * 2 * 4 * 64 * 64; o += gridDim.x * NTHREADS) {
    const int k = o & 63, e = (o >> 6) & 63, nb = (o >> 12) & 3, mat = (o >> 14) & 1, ld = o >> 15;
    const float* src = mat ? p.in[15] : p.in[13];
    WGT[o] = f2bf(src[(size_t)((ld * 4 + nb) * 64 + k) * 64 + e]);
  }
}

DEVI float wave_sum(float v, int lane) {
#pragma unroll
  for (int o = 1; o < 64; o <<= 1) v += shx(v, o, lane);
  return v;
}
DEVI void norm_phase(const Params& p, int l, int which, int rbeg, int Mrows, bool from_input) {
  const int tid = otid();
  const int lane = tid & 63, gw = blockIdx.x * 8 + (tid >> 6), NW = gridDim.x * 8;
  const float* X = (const float*)(p.ws + OFF_X); u16* H = (u16*)(p.ws + OFF_H);
  const float* MOD = (const float*)(p.ws + OFF_MOD);
  const f32x4* g4 = (const f32x4*)(p.in[6] + (size_t)(l * 3 + which) * D) + lane;
  for (int row0 = rbeg + gw * 2; row0 < Mrows; row0 += NW * 2) {
    f32x4 v[2][4]; float ss[2] = {0.f, 0.f};
#pragma unroll
    for (int u = 0; u < 2; ++u) {
      const int row = row0 + u;
      const float* xr = from_input ? (row < TL ? p.in[0] + (size_t)row * D : p.in[2] + (size_t)(row - TL) * D) : X + (size_t)row * D;
      const f32x4* x4 = (const f32x4*)xr + lane;
#pragma unroll
      for (int j = 0; j < 4; ++j) v[u][j] = x4[64 * j];
    }
#pragma unroll
    for (int u = 0; u < 2; ++u)
#pragma unroll
      for (int j = 0; j < 4; ++j) ss[u] += (v[u][j][0] * v[u][j][0] + v[u][j][1] * v[u][j][1]) + (v[u][j][2] * v[u][j][2] + v[u][j][3] * v[u][j][3]);
#pragma unroll
    for (int u = 0; u < 2; ++u) {
      const int row = row0 + u;
      const int r = row < TL ? (row >> 12) : 8;
      const f32x4* sh4 = (const f32x4*)(MOD + (size_t)((l * 9 + r) * 9 + which * 3) * D) + lane;
      const f32x4* sc4 = sh4 + D / 4;
      const float rinv = rsqrtf(wave_sum(ss[u], lane) * (1.f / D) + 1e-6f);
      uint2* o8 = (uint2*)(H + (size_t)row * D) + lane;
#pragma unroll
      for (int j = 0; j < 4; ++j) {
        const f32x4 g = g4[64 * j], sh = sh4[64 * j], sc = sc4[64 * j];
        f32x4 y;
#pragma unroll
        for (int q = 0; q < 4; ++q) y[q] = v[u][j][q] * rinv * g[q] * (1.f + sc[q]) + sh[q];
        uint2 o; o.x = pk_bf16(y[0], y[1]); o.y = pk_bf16(y[2], y[3]); o8[64 * j] = o;
      }
    }
  }
}
DEVI void ctx_combine_phase(const Params& p, int l, int gi, float coef, int ln, int lwhich) {
  const int tid = otid(), lane = tid & 63, gw = blockIdx.x * 8 + (tid >> 6), NW = gridDim.x * 8;
  float* X = (float*)(p.ws + OFF_X); u16* H = (u16*)(p.ws + OFF_H);
  const u16* PS = (const u16*)(p.ws + OFF_PS);
  const float* MOD = (const float*)(p.ws + OFF_MOD);
  const f32x4* gate4 = (const f32x4*)(MOD + (size_t)((l * 9 + 8) * 9 + gi) * D) + lane;
  for (int rc = gw; rc < TC; rc += NW) {
    f32x4* x4 = (f32x4*)(X + (size_t)(TL + rc) * D) + lane;
    f32x4 v[4]; float ss = 0.f;
#pragma unroll
    for (int j = 0; j < 4; ++j) {
      f32x4 sum = {0.f, 0.f, 0.f, 0.f};
#pragma unroll
      for (int sl = 0; sl < 7; ++sl) {
        const uint2 w = *((const uint2*)(PS + ((size_t)sl * TC + rc) * D) + lane + 64 * j);
        sum[0] += __uint_as_float(w.x << 16); sum[1] += __uint_as_float(w.x & 0xffff0000u); sum[2] += __uint_as_float(w.y << 16); sum[3] += __uint_as_float(w.y & 0xffff0000u);
      }
      const f32x4 xo = x4[64 * j], gv = gate4[64 * j];
#pragma unroll
      for (int q = 0; q < 4; ++q) v[j][q] = xo[q] + coef * gv[q] * sum[q];
      x4[64 * j] = v[j];
      ss += (v[j][0] * v[j][0] + v[j][1] * v[j][1]) + (v[j][2] * v[j][2] + v[j][3] * v[j][3]);
    }
    if (ln >= 0) {
      const f32x4* g4 = (const f32x4*)(p.in[6] + (size_t)(ln * 3 + lwhich) * D) + lane;
      const f32x4* sh4 = (const f32x4*)(MOD + (size_t)((ln * 9 + 8) * 9 + lwhich * 3) * D) + lane;
      const f32x4* sc4 = sh4 + D / 4;
      const float rinv = rsqrtf(wave_sum(ss, lane) * (1.f / D) + 1e-6f);
      uint2* o8 = (uint2*)(H + (size_t)(TL + rc) * D) + lane;
#pragma unroll
      for (int j = 0; j < 4; ++j) {
        const f32x4 g = g4[64 * j], sh = sh4[64 * j], sc = sc4[64 * j];
        f32x4 y;
#pragma unroll
        for (int q = 0; q < 4; ++q) y[q] = v[j][q] * rinv * g[q] * (1.f + sc[q]) + sh[q];
        uint2 o; o.x = pk_bf16(y[0], y[1]); o.y = pk_bf16(y[2], y[3]); o8[64 * j] = o;
      }
    }
  }
}
DEVI void prep2_phase(const Params& p) {
  const int tid = otid(), lane = tid & 63, gw = blockIdx.x * 8 + (tid >> 6), NW = gridDim.x * 8;
  const float* MOD = (const float*)(p.ws + OFF_MOD);
  float* GV = (float*)(p.ws + OFF_GV);
  for (int o = blockIdx.x * NTHREADS + tid; o < 6 * 9 * 1024; o += gridDim.x * NTHREADS) {
    const int col = o & 1023, r = (o >> 10) % 9, lw = o / (9 * 1024), l = lw / 3, which = lw % 3;
    GV[o] = p.in[6][(size_t)(l * 3 + which) * D + col] * (1.f + MOD[(size_t)((l * 9 + r) * 9 + which * 3 + 1) * D + col]);
  }
  for (int wi = gw; wi < 9 * 152; wi += NW) {
    const int r = wi % 9, grp = wi / 9, row0 = grp * 64;
    const u16* wbase; const float* shv; float* dst;
    if (row0 < 4096) { const int l = row0 >> 11, pn = row0 & 2047; wbase = (const u16*)(p.ws + OFF_WINT) + (size_t)(l * 2048 + pn) * 1024; shv = MOD + (size_t)((l * 9 + r) * 9 + 3) * D; dst = (float*)(p.ws + OFF_SWIN) + (size_t)(l * 9 + r) * 2048 + pn; }
    else { const int pn = row0 - 4096; wbase = (const u16*)(p.ws + OFF_W1T) + (size_t)(2 * 5632 + pn) * 1024; shv = MOD + (size_t)((1 * 9 + r) * 9 + 0) * D; dst = (float*)(p.ws + OFF_SW1) + (size_t)r * 5632 + pn; }
    float sh[16];
#pragma unroll
    for (int q = 0; q < 4; ++q) { const f32x4 sv = *(const f32x4*)(shv + lane * 16 + 4 * q); sh[4 * q] = sv[0]; sh[4 * q + 1] = sv[1]; sh[4 * q + 2] = sv[2]; sh[4 * q + 3] = sv[3]; }
#pragma unroll 1
    for (int i = 0; i < 64; i += 8) {
      float a8[8];
#pragma unroll
      for (int u = 0; u < 8; ++u) {
        const u16* wrow = wbase + (size_t)(i + u) * 1024 + lane * 16;
        const bf16x8 v0 = *(const bf16x8*)wrow, v1 = *(const bf16x8*)(wrow + 8);
        float acc = 0.f;
#pragma unroll
        for (int q = 0; q < 8; ++q) acc += bf2f((u16)v0[q]) * sh[q] + bf2f((u16)v1[q]) * sh[8 + q];
        a8[u] = acc;
      }
#pragma unroll
      for (int u = 0; u < 8; ++u) a8[u] = wave_sum(a8[u], lane);
      if (lane < 8) { float v = a8[0];
#pragma unroll
        for (int u = 1; u < 8; ++u) v = lane == u ? a8[u] : v;
        dst[i + lane] = v; }
    }
  }
}
DEVI void final_norm_phase(const Params& p) {
  const int tid = otid();
  const int lane = tid & 63, gw = blockIdx.x * 8 + (tid >> 6), NW = gridDim.x * 8;
  const float* X = (const float*)(p.ws + OFF_X);
  const f32x4* g4 = (const f32x4*)p.in[28] + lane;
  for (int row0 = gw * 2; row0 < TL; row0 += NW * 2) {
    f32x4 v[2][4]; float ss[2] = {0.f, 0.f};
#pragma unroll
    for (int u = 0; u < 2; ++u) {
      const f32x4* x4 = (const f32x4*)(X + (size_t)(row0 + u) * D) + lane;
#pragma unroll
      for (int j = 0; j < 4; ++j) v[u][j] = x4[64 * j];
    }
#pragma unroll
    for (int u = 0; u < 2; ++u)
#pragma unroll
      for (int j = 0; j < 4; ++j) ss[u] += (v[u][j][0] * v[u][j][0] + v[u][j][1] * v[u][j][1]) + (v[u][j][2] * v[u][j][2] + v[u][j][3] * v[u][j][3]);
#pragma unroll
    for (int u = 0; u < 2; ++u) {
      const float rinv = rsqrtf(wave_sum(ss[u], lane) * (1.f / D) + 1e-6f);
      f32x4* o4 = (f32x4*)(p.out + (size_t)(row0 + u) * D) + lane;
#pragma unroll
      for (int j = 0; j < 4; ++j) { const f32x4 g = g4[64 * j]; f32x4 y;
#pragma unroll
        for (int q = 0; q < 4; ++q) y[q] = v[u][j][q] * rinv * g[q];
        o4[64 * j] = y; }
    }
  }
}

constexpr int AT_KSTR = 72, AT_VSTR = 408;
template <int NKEYS>
DEVI void attn_stage(const u16* __restrict__ QK, const u16* __restrict__ PT, u16* Ks, u16* Vs, int tid, int kvh, int kbase, int kstart, int klen) {
  constexpr int NCH = NKEYS * 8, NIT = (NCH + NTHREADS - 1) / NTHREADS, NCK = NKEYS / 8;
  uint4 kv[NIT], vv[NIT];
#pragma unroll
  for (int i = 0; i < NIT; ++i) {
    const int idx = tid + i * NTHREADS;
    { const int kl = idx >> 3, cp = idx & 7, kp = kstart + kl;
      kv[i] = make_uint4(0u, 0u, 0u, 0u);
      if (idx < NCH && kp >= 0 && kp < klen) kv[i] = *(const uint4*)(QK + (size_t)(kbase + kp) * 640 + 512 + kvh * 64 + cp * 8); }
    { const int dim = idx / NCK, ck = idx % NCK, kp = kstart + ck * 8;
      vv[i] = make_uint4(0u, 0u, 0u, 0u);
      if (idx < NCH && kp >= 0 && kp < klen) vv[i] = *(const uint4*)(PT + (size_t)(1280 + kvh * 64 + dim) * T + kbase + kp); }
  }
#pragma unroll
  for (int i = 0; i < NIT; ++i) {
    const int idx = tid + i * NTHREADS;
    if (idx < NCH) {
      *(uint4*)(Ks + (idx >> 3) * AT_KSTR + (idx & 7) * 8) = kv[i];
      *(uint4*)(Vs + (idx / NCK) * AT_VSTR + (idx % NCK) * 8) = vv[i];
    }
  }
}
DEVI void attn_item(const Params& p, int l, int item) {
  const u16* QK = (const u16*)(p.ws + OFF_QK); const u16* PT = (const u16*)(p.ws + OFF_PT); u16* YC = (u16*)(p.ws + OFF_H);
  u16* Ks = (u16*)smem; u16* Vs = Ks + 400 * AT_KSTR;
  const int tid = otid();
  const int wave = tid >> 6, lane = tid & 63, fr = lane & 15, g = lane >> 4;
  int kvh, b, qb, isctx;
  if (item < 512) { kvh = item & 1; qb = (item >> 1) & 31; b = item >> 6; isctx = 0; }
  else { const int it = item - 512; kvh = it & 1; qb = (it >> 1) & 1; b = it >> 2; isctx = 1; }
  const int rowbase = isctx ? TL + b * CTXL : b * SEQ;
  const int ctxbase = TL + b * CTXL;
  const int q0b = qb * 128, q0 = q0b + wave * 16;
  const int qrow = rowbase + q0 + fr, qpos = q0 + fr;
  bf16x8 Qf[4][2];
  float m[4], lsum[4];
  f32x4 O[4][4];
#pragma unroll
  for (int hh = 0; hh < 4; ++hh) {
    const u16* qp = QK + (size_t)qrow * 640 + (kvh * 4 + hh) * 64 + g * 8;
    Qf[hh][0] = *(const bf16x8*)qp; Qf[hh][1] = *(const bf16x8*)(qp + 32);
    m[hh] = p.in[27][l * 8 + kvh * 4 + hh] * 1.4426950408889634f; lsum[hh] = 0.f;
#pragma unroll
    for (int dt = 0; dt < 4; ++dt) O[hh][dt] = (f32x4){0.f, 0.f, 0.f, 0.f};
  }
  auto chunk = [&](const int lk, const int kp0, const bool win) {
    bf16x8 Kf[2][2];
#pragma unroll
    for (int tt = 0; tt < 2; ++tt) {
      const u16* kr = Ks + (lk + 16 * tt + fr) * AT_KSTR + g * 8;
      Kf[tt][0] = *(const bf16x8*)kr; Kf[tt][1] = *(const bf16x8*)(kr + 32);
    }
    bf16x8 Vf[4];
#pragma unroll
    for (int dt = 0; dt < 4; ++dt) {
      const u16* vr = Vs + (16 * dt + fr) * AT_VSTR + lk + 4 * g;
      union { uint2 u[2]; bf16x8 v; } t; t.u[0] = *(const uint2*)vr; t.u[1] = *(const uint2*)(vr + 16); Vf[dt] = t.v;
    }
    bool valid[2][4];
#pragma unroll
    for (int tt = 0; tt < 2; ++tt)
#pragma unroll
      for (int j = 0; j < 4; ++j) {
        const int kp = kp0 + 16 * tt + 4 * g + j; int dq = qpos - kp; dq = dq < 0 ? -dq : dq;
        valid[tt][j] = win ? (kp >= 0 && kp < SEQ && dq <= 128) : true;
      }
#pragma unroll
    for (int hh = 0; hh < 4; ++hh) {
      f32x4 st[2];
#pragma unroll
      for (int tt = 0; tt < 2; ++tt) { f32x4 z = {0.f, 0.f, 0.f, 0.f}; z = mfma16(Kf[tt][0], Qf[hh][0], z); z = mfma16(Kf[tt][1], Qf[hh][1], z); st[tt] = z; }
      float mx = -3.0e38f;
#pragma unroll
      for (int tt = 0; tt < 2; ++tt)
#pragma unroll
        for (int j = 0; j < 4; ++j) { const float sv = valid[tt][j] ? st[tt][j] : -1e30f; st[tt][j] = sv; mx = fmaxf(mx, sv); }
      mx = fmaxf(mx, shx(mx, 16, lane)); mx = fmaxf(mx, shx(mx, 32, lane));
      const float mnew = fmaxf(m[hh], mx);
      const float alpha = __builtin_amdgcn_exp2f(m[hh] - mnew); m[hh] = mnew;
      float ps = 0.f; float pv[2][4];
#pragma unroll
      for (int tt = 0; tt < 2; ++tt)
#pragma unroll
        for (int j = 0; j < 4; ++j) { const float e = __builtin_amdgcn_exp2f(st[tt][j] - mnew); pv[tt][j] = e; ps += e; }
      lsum[hh] = lsum[hh] * alpha + ps;
      union { unsigned u[4]; bf16x8 v; } Pf;
      Pf.u[0] = pk_bf16(pv[0][0], pv[0][1]); Pf.u[1] = pk_bf16(pv[0][2], pv[0][3]);
      Pf.u[2] = pk_bf16(pv[1][0], pv[1][1]); Pf.u[3] = pk_bf16(pv[1][2], pv[1][3]);
#pragma unroll
      for (int dt = 0; dt < 4; ++dt) {
        f32x4 o = O[hh][dt]; o[0] *= alpha; o[1] *= alpha; o[2] *= alpha; o[3] *= alpha;
        O[hh][dt] = mfma16(Vf[dt], Pf.v, o);
      }
    }
  };
  if (!isctx) {
    attn_stage<400>(QK, PT, Ks, Vs, tid, kvh, rowbase, q0b - 128, SEQ);
    __syncthreads();
#pragma unroll 1
    for (int ci = 0; ci < 9; ++ci) {
      const int kp0 = q0 - 128 + 32 * ci;
      chunk(16 * wave + 32 * ci, kp0, ci == 0 || ci == 8 || kp0 < 0 || kp0 + 31 >= SEQ);
    }
    __syncthreads();
  }
  attn_stage<256>(QK, PT, Ks, Vs, tid, kvh, ctxbase, 0, CTXL);
  __syncthreads();
#pragma unroll 1
  for (int ci = 0; ci < 8; ++ci) chunk(32 * ci, 32 * ci, false);
#pragma unroll
  for (int hh = 0; hh < 4; ++hh) {
    float ls = lsum[hh]; ls += shx(ls, 16, lane); ls += shx(ls, 32, lane);
    const float sink = p.in[27][l * 8 + kvh * 4 + hh] * 1.4426950408889634f;
    const float inv = 1.f / (ls + __builtin_amdgcn_exp2f(sink - m[hh]));
#pragma unroll
    for (int dt = 0; dt < 4; ++dt) {
      uint2 o; o.x = pk_bf16(O[hh][dt][0] * inv, O[hh][dt][1] * inv); o.y = pk_bf16(O[hh][dt][2] * inv, O[hh][dt][3] * inv);
      *(uint2*)(YC + (size_t)qrow * D + 512 + (kvh * 4 + hh) * 64 + 16 * dt + 4 * g) = o;
    }
  }
  __syncthreads();
}

DEVI void lru_item(const Params& p, int l, int item, int pass) {
  const u16* PT = (const u16*)(p.ws + OFF_PT); u16* YC = (u16*)(p.ws + OFF_H);
  float2* SUMM = (float2*)(p.ws + OFF_SUMM);
  const int ch = item >> 2, n = item & 3;
  const int isctx = ch >= 256;
  int b, tq; if (!isctx) { b = ch >> 5; tq = ch & 31; } else { b = (ch - 256) >> 1; tq = (ch - 256) & 1; }
  const int Lseq = isctx ? CTXL : SEQ, rowbase = isctx ? TL + b * CTXL : b * SEQ, t0 = tq * 128;
  float* xs = (float*)smem;
  u16* ub = (u16*)(xs + 64 * 145);
  float* ex = (float*)(ub + 128 * 72);
  float* sm = ex + 8 * 16 * 65;
  float* hc = sm + 2 * 8 * 64 * 2;
  float2* ss = (float2*)(hc + 128);
  const int tid = otid(), e = tid & 63, tg = tid >> 6, c = n * 64 + e, lane = e, fr = lane & 15, g = lane >> 4;
  { bf16x8 xv[3];
#pragma unroll
    for (int i = 0; i < 3; ++i) {
      const int idx = tid + i * NTHREADS, chn = idx / 18, ck = idx % 18, t = t0 - 8 + ck * 8;
      xv[i] = (bf16x8){0, 0, 0, 0, 0, 0, 0, 0};
      if (idx < 64 * 18 && t >= 0 && t < Lseq) xv[i] = *(const bf16x8*)(PT + (size_t)(n * 64 + chn) * T + rowbase + t);
    }
#pragma unroll
    for (int i = 0; i < 3; ++i) {
      const int idx = tid + i * NTHREADS, chn = idx / 18, ck = idx % 18;
      if (idx < 64 * 18) {
#pragma unroll
        for (int q = 0; q < 8; ++q) xs[chn * 145 + ck * 8 + q] = bf2f((u16)xv[i][q]);
      }
    } }
  if (pass) {
    float2 sv[9];
#pragma unroll
    for (int i = 0; i < 9; ++i) {
      const int idx = tid + i * NTHREADS;
      const int d = idx / (34 * 64), rem = idx % (34 * 64), j = rem >> 6, ee = rem & 63;
      const int cidx = j < 2 ? 256 + b * 2 + j : b * 32 + (j - 2);
      sv[i] = make_float2(0.f, 0.f);
      if (idx < 2 * 34 * 64) sv[i] = SUMM[((size_t)d * 272 + cidx) * 256 + n * 64 + ee];
    }
#pragma unroll
    for (int i = 0; i < 9; ++i) { const int idx = tid + i * NTHREADS; if (idx < 2 * 34 * 64) ss[idx] = sv[i]; }
  }
  __syncthreads();
  float uo[16];
  { const float* cw = p.in[11] + (size_t)l * 4 * 256 + c;
    const float w0 = cw[0], w1 = cw[256], w2 = cw[512], w3 = cw[768], cb = p.in[12][l * 256 + c];
    const float* xr = xs + e * 145 + 8 + 16 * tg;
#pragma unroll
    for (int tt = 0; tt < 16; ++tt) { const float u = cb + w0 * xr[tt - 2] + w1 * xr[tt - 1] + w2 * xr[tt] + w3 * xr[tt + 1]; uo[tt] = u; ub[(16 * tg + tt) * 72 + e] = f2bf(u); } }
  if (pass && tid < 128) {
    const int d = tid >> 6, ee = tid & 63, my = isctx ? tq : 2 + tq;
    const float2* S = ss + d * 34 * 64 + ee;
    float h = 0.f;
    if (d == 0) { for (int j = 0; j < my; ++j) { const float2 sv = S[j * 64]; h = sv.x * h + sv.y; } }
    else {
      if (my < 2) { for (int j = 1; j > my; --j) { const float2 sv = S[j * 64]; h = sv.x * h + sv.y; } }
      else {
        { const float2 sv = S[1 * 64]; h = sv.x * h + sv.y; }
        { const float2 sv = S[0 * 64]; h = sv.x * h + sv.y; }
        for (int j = 33; j > my; --j) { const float2 sv = S[j * 64]; h = sv.x * h + sv.y; }
      }
    }
    hc[tid] = h;
  }
  __syncthreads();
  if (pass) {
    bf16x8 gv2[2];
#pragma unroll
    for (int i = 0; i < 2; ++i) { const int idx = tid + i * NTHREADS, chn = idx >> 4, ck = idx & 15; gv2[i] = *(const bf16x8*)(PT + (size_t)(256 + n * 64 + chn) * T + rowbase + t0 + ck * 8); }
#pragma unroll
    for (int i = 0; i < 2; ++i) { const int idx = tid + i * NTHREADS, chn = idx >> 4, ck = idx & 15;
#pragma unroll
      for (int q = 0; q < 8; ++q) xs[chn * 145 + 8 + ck * 8 + q] = bf2f((u16)gv2[i][q]); }
  }
  const bf16x8 A0 = *(const bf16x8*)(ub + (16 * tg + fr) * 72 + 8 * g), A1 = *(const bf16x8*)(ub + (16 * tg + fr) * 72 + 32 + 8 * g);
  const u16* WGT = (const u16*)(p.ws + OFF_WGT);
  float* exw = ex + tg * 16 * 65;
  float av[2][16], bv[2][16];
#pragma unroll
  for (int d = 0; d < 2; ++d) {
    float pre[2][16];
#pragma unroll
    for (int mat = 0; mat < 2; ++mat) {
      const u16* wb = WGT + (size_t)((((l * 2 + d) * 2 + mat) * 4 + n) * 64) * 64 + 8 * g;
      f32x4 acc[4];
#pragma unroll
      for (int nt = 0; nt < 4; ++nt) {
        const bf16x8 B0 = *(const bf16x8*)(wb + (16 * nt + fr) * 64), B1 = *(const bf16x8*)(wb + (16 * nt + fr) * 64 + 32);
        f32x4 z = {0.f, 0.f, 0.f, 0.f};
        z = mfma16(A0, B0, z); z = mfma16(A1, B1, z); acc[nt] = z;
      }
      asm volatile("s_waitcnt lgkmcnt(0)" ::: "memory");
#pragma unroll
      for (int nt = 0; nt < 4; ++nt)
#pragma unroll
        for (int j = 0; j < 4; ++j) exw[(4 * g + j) * 65 + 16 * nt + fr] = acc[nt][j];
      asm volatile("s_waitcnt lgkmcnt(0)" ::: "memory");
#pragma unroll
      for (int tt = 0; tt < 16; ++tt) pre[mat][tt] = exw[tt * 65 + lane];
    }
    const float ba = p.in[14][(l * 2 + d) * 256 + c], bx = p.in[16][(l * 2 + d) * 256 + c];
    const float lam = p.in[17][(l * 2 + d) * 256 + c];
    const float exl = __expf(-lam); const float sp = exl < 0.03f ? exl * (1.f - exl * (0.5f - exl * (0.33333334f - 0.25f * exl))) : __logf(1.f + exl);
    float Ap = 1.f, Bp = 0.f;
#pragma unroll
    for (int q = 0; q < 16; ++q) {
      const int tt = d == 0 ? q : 15 - q;
      const float r = sigmoidf_(pre[0][tt] + ba), ig = sigmoidf_(pre[1][tt] + bx);
      const float la = -8.f * r * sp;
      const float a = __expf(la);
      const float om = fmaxf(1.f - a * a, 0.f);
      const float bb = sqrtf(om) * (ig * uo[tt]);
      av[d][tt] = a; bv[d][tt] = bb;
      Bp = a * Bp + bb; Ap *= a;
    }
    sm[((d * 8 + tg) * 64 + e) * 2 + 0] = Ap; sm[((d * 8 + tg) * 64 + e) * 2 + 1] = Bp;
  }
  __syncthreads();
  if (!pass) {
    if (tid < 128) {
      const int d = tid >> 6, ee = tid & 63;
      float A = 1.f, Bc = 0.f;
      if (d == 0) { for (int g2 = 0; g2 < 8; ++g2) { const float a = sm[((0 * 8 + g2) * 64 + ee) * 2], bq = sm[((0 * 8 + g2) * 64 + ee) * 2 + 1]; Bc = a * Bc + bq; A *= a; } }
      else { for (int g2 = 7; g2 >= 0; --g2) { const float a = sm[((1 * 8 + g2) * 64 + ee) * 2], bq = sm[((1 * 8 + g2) * 64 + ee) * 2 + 1]; Bc = a * Bc + bq; A *= a; } }
      SUMM[((size_t)d * 272 + ch) * 256 + n * 64 + ee] = make_float2(A, Bc);
    }
  } else {
    float hs[16];
    { float h = hc[e];
      for (int g2 = 0; g2 < tg; ++g2) { const float a = sm[((0 * 8 + g2) * 64 + e) * 2], bq = sm[((0 * 8 + g2) * 64 + e) * 2 + 1]; h = a * h + bq; }
#pragma unroll
      for (int tt = 0; tt < 16; ++tt) { h = av[0][tt] * h + bv[0][tt]; hs[tt] = h; } }
    { float h = hc[64 + e];
      for (int g2 = 7; g2 > tg; --g2) { const float a = sm[((1 * 8 + g2) * 64 + e) * 2], bq = sm[((1 * 8 + g2) * 64 + e) * 2 + 1]; h = a * h + bq; }
#pragma unroll
      for (int tt = 15; tt >= 0; --tt) { h = av[1][tt] * h + bv[1][tt]; hs[tt] += h; } }
    const float* gr = xs + e * 145 + 8 + 16 * tg;
#pragma unroll
    for (int tt = 0; tt < 16; ++tt) {
      const float y = hs[tt] * gelu_tanh(gr[tt]);
      YC[(size_t)(rowbase + t0 + 16 * tg + tt) * D + c] = f2bf(y);
    }
  }
  __syncthreads();
}

DEVI void uprep_phase(const Params& p, int l) {
  const u16* PT = (const u16*)(p.ws + OFF_PT); u16* UT = (u16*)(p.ws + OFF_UT); u16* X0T = (u16*)(p.ws + OFF_X0T);
  constexpr int NCH = T / 8, NTOT = 256 * NCH;
  struct In { bf16x8 v[3]; u16 pv[3], nx[3]; };
  auto ld = [&](In& q, const int idx) {
    const int c = idx / NCH, ck = idx % NCH, row = ck * 8;
    int t, Lseq; if (row < TL) { t = row & 4095; Lseq = SEQ; } else { t = (row - TL) & 255; Lseq = CTXL; }
#pragma unroll
    for (int k = 0; k < 3; ++k) {
      const u16* src = PT + (size_t)(512 + k * 256 + c) * T + row;
      q.v[k] = *(const bf16x8*)src;
      q.pv[k] = t > 0 ? src[-1] : (u16)0;
      q.nx[k] = (t + 8 < Lseq) ? src[8] : (u16)0;
    }
  };
  auto fin = [&](const In& q, const int idx) {
    const int c = idx / NCH, ck = idx % NCH, row = ck * 8;
    float o[3][8];
#pragma unroll
    for (int k = 0; k < 3; ++k) {
      const int col = k * 256 + c;
      float x[10];
      x[0] = bf2f(q.pv[k]); x[9] = bf2f(q.nx[k]);
#pragma unroll
      for (int e = 0; e < 8; ++e) x[e + 1] = bf2f((u16)q.v[k][e]);
      const float w0 = p.in[18][(l * 3 + 0) * 768 + col], w1 = p.in[18][(l * 3 + 1) * 768 + col], w2 = p.in[18][(l * 3 + 2) * 768 + col], bb = p.in[19][l * 768 + col];
#pragma unroll
      for (int e = 0; e < 8; ++e) o[k][e] = bb + w0 * x[e] + w1 * x[e + 1] + w2 * x[e + 2];
    }
    uint4 uo, xo;
    uo.x = pk_bf16(o[1][0] * o[2][0], o[1][1] * o[2][1]); uo.y = pk_bf16(o[1][2] * o[2][2], o[1][3] * o[2][3]);
    uo.z = pk_bf16(o[1][4] * o[2][4], o[1][5] * o[2][5]); uo.w = pk_bf16(o[1][6] * o[2][6], o[1][7] * o[2][7]);
    xo.x = pk_bf16(o[0][0], o[0][1]); xo.y = pk_bf16(o[0][2], o[0][3]); xo.z = pk_bf16(o[0][4], o[0][5]); xo.w = pk_bf16(o[0][6], o[0][7]);
    *(uint4*)(UT + (size_t)c * T + row) = uo;
    *(uint4*)(X0T + (size_t)c * T + row) = xo;
  };
  const int stride = gridDim.x * NTHREADS;
  for (int idx = blockIdx.x * NTHREADS + otid(); idx < NTOT; idx += 2 * stride) {
    In a, b; const int idx2 = idx + stride; const bool two = idx2 < NTOT;
    ld(a, idx); if (two) ld(b, idx2);
    fin(a, idx); if (two) fin(b, idx2);
  }
}

DEVI bf16x8 ld_frag8(const u16* a) { union { uint2 u[2]; bf16x8 v; } f; f.u[0] = *(const uint2*)a; f.u[1] = *(const uint2*)(a + 4); return f.v; }
DEVI void toep_item(const Params& p, int l, int c, int isctx) {
  const int L = isctx ? CTXL : SEQ;
  const u16* KF = isctx ? (const u16*)(p.ws + OFF_KFC) + (size_t)c * 512 : (const u16*)(p.ws + OFF_KF) + (size_t)(l * 256 + c) * 8192;
  u16* R = (u16*)smem; const int CS = 2 * L + 8;
  u16* Us = R + 4 * CS; const int USTR = L + 8;
  const int tid = otid(), wave = tid >> 6, lane = tid & 63, fr = lane & 15, g = lane >> 4;
  const u16* Uc = (const u16*)(p.ws + OFF_UT) + (size_t)c * T;
  const u16* X0c = (const u16*)(p.ws + OFF_X0T) + (size_t)c * T;
  for (int q = tid; q < (2 * L) / 8; q += NTHREADS) {
    const bf16x8 v = *(const bf16x8*)(KF + 8 * q);
#pragma unroll
    for (int mm = 0; mm < 4; ++mm)
#pragma unroll
      for (int e = 0; e < 8; ++e) R[mm * CS + 8 * q + e + mm] = (u16)v[e];
  }
  if (tid < 32) { const int mm = tid >> 3, e = tid & 7; if (e < mm) R[mm * CS + e] = 0; else R[mm * CS + 2 * L + e] = 0; }
  for (int q = tid; q < L; q += NTHREADS) {
    const int bb = q / (L / 8), ck = q % (L / 8);
    const size_t row = (isctx ? (size_t)TL + (size_t)bb * CTXL : (size_t)bb * SEQ) + ck * 8;
    *(uint4*)(Us + bb * USTR + ck * 8) = *(const uint4*)(Uc + row);
  }
  __syncthreads();
  u16* YHc = (u16*)(p.ws + OFF_YHT) + (size_t)c * T;
  const float skip = p.in[26][l * 256 + c];
  const int nT = L / 256;
  const int mcp = fr & 3;
  const u16* Rl = R + mcp * CS + (L + 8 * g - (fr - mcp));
  const u16* Ul = Us + (fr & 7) * USTR + 8 * g;
  const size_t urow = isctx ? (size_t)TL + (size_t)(fr & 7) * CTXL : (size_t)(fr & 7) * SEQ;
  for (int wt = wave; wt < nT; wt += 8) {
    const int T0 = wt * 256;
    f32x4 acc[16];
#pragma unroll
    for (int m8 = 0; m8 < 16; ++m8) acc[m8] = (f32x4){0.f, 0.f, 0.f, 0.f};
    bf16x8 F[16];
#pragma unroll
    for (int m8 = 2; m8 < 16; ++m8) F[m8] = ld_frag8(Rl + (0 - T0 - 16 * m8));
#pragma unroll 1
    for (int s0 = 0; s0 < L; s0 += 256) {
#pragma unroll
      for (int k = 0; k < 8; ++k) {
        const int s = s0 + 32 * k;
        const bf16x8 Bf = *(const bf16x8*)(Ul + s);
        F[(16 - 2 * k) & 15] = ld_frag8(Rl + (s - T0));
        F[(17 - 2 * k) & 15] = ld_frag8(Rl + (s - T0 - 16));
#pragma unroll
        for (int m8 = 0; m8 < 16; ++m8) acc[m8] = mfma16(F[(m8 + 16 - 2 * k) & 15], Bf, acc[m8]);
      }
    }
    if (fr < 8) {
#pragma unroll
      for (int m8 = 0; m8 < 16; ++m8) {
        const size_t row = urow + T0 + 16 * m8 + 4 * g;
        const bf16x4 u4 = *(const bf16x4*)(Us + fr * USTR + T0 + 16 * m8 + 4 * g), x4 = *(const bf16x4*)(X0c + row);
        float y[4];
#pragma unroll
        for (int j = 0; j < 4; ++j) y[j] = bf2f((u16)x4[j]) * (acc[m8][j] + skip * bf2f((u16)u4[j]));
        uint2 o; o.x = pk_bf16(y[0], y[1]); o.y = pk_bf16(y[2], y[3]);
        *(uint2*)(YHc + row) = o;
      }
    }
  }
  __syncthreads();
}

DEVI void toep_item_lat(const Params& p, int l, int c) {
  constexpr int L = SEQ, HL = SEQ / 2, CS = 2 * L + 8, USTR = L + 8;
  const u16* KF = (const u16*)(p.ws + OFF_KF) + (size_t)(l * 256 + c) * 8192;
  u16* R = (u16*)smem;
  u16* Us = R + 4 * CS;
  const int tid = otid(), wave = tid >> 6, lane = tid & 63, fr = lane & 15, g = lane >> 4;
  const u16* Uc = (const u16*)(p.ws + OFF_UT) + (size_t)c * T;
  const u16* X0c = (const u16*)(p.ws + OFF_X0T) + (size_t)c * T;
  { const bf16x8 v0 = *(const bf16x8*)(KF + 8 * tid), v1 = *(const bf16x8*)(KF + 8 * (tid + NTHREADS));
#pragma unroll
    for (int mm = 0; mm < 4; ++mm)
#pragma unroll
      for (int e = 0; e < 8; ++e) { R[mm * CS + 8 * tid + e + mm] = (u16)v0[e]; R[mm * CS + 8 * (tid + NTHREADS) + e + mm] = (u16)v1[e]; } }
  if (tid < 32) { const int mm = tid >> 3, e = tid & 7; if (e < mm) R[mm * CS + e] = 0; else R[mm * CS + 2 * L + e] = 0; }
  { uint4 uu[8];
#pragma unroll
    for (int b2 = 0; b2 < 8; ++b2) uu[b2] = *(const uint4*)(Uc + (size_t)b2 * SEQ + tid * 8);
#pragma unroll
    for (int b2 = 0; b2 < 8; ++b2) *(uint4*)(Us + b2 * USTR + tid * 8) = uu[b2]; }
  __syncthreads();
  u16* YHc = (u16*)(p.ws + OFF_YHT) + (size_t)c * T;
  const float skip = p.in[26][l * 256 + c];
  const int mcp = fr & 3, bb = fr & 7, hh = fr >> 3;
  const u16* Rl = R + mcp * CS + (L + 8 * g - (fr - mcp));
  const u16* Ul = Us + bb * USTR + HL * hh + 8 * g;
  const int T0 = wave * 256;
  f32x4 acc[16];
#pragma unroll
  for (int m8 = 0; m8 < 16; ++m8) acc[m8] = (f32x4){0.f, 0.f, 0.f, 0.f};
  bf16x8 F[16];
#pragma unroll
  for (int m8 = 2; m8 < 16; ++m8) F[m8] = ld_frag8(Rl + (-HL - T0 - 16 * m8));
#pragma unroll 1
  for (int s0 = -HL; s0 < L; s0 += 256) {
#pragma unroll
    for (int k = 0; k < 8; ++k) {
      const int s = s0 + 32 * k;
      const int ui = s + HL * hh + 8 * g;
      const bool ok = (unsigned)ui < (unsigned)L;
      bf16x8 Bf = *(const bf16x8*)(Ul + (ok ? s : -(HL * hh)));
      if (!ok) Bf = (bf16x8){0, 0, 0, 0, 0, 0, 0, 0};
      F[(16 - 2 * k) & 15] = ld_frag8(Rl + (s - T0));
      F[(17 - 2 * k) & 15] = ld_frag8(Rl + (s - T0 - 16));
#pragma unroll
      for (int m8 = 0; m8 < 16; ++m8) acc[m8] = mfma16(F[(m8 + 16 - 2 * k) & 15], Bf, acc[m8]);
    }
  }
#pragma unroll
  for (int m8 = 0; m8 < 16; ++m8) {
    const int tt = HL * hh + T0 + 16 * m8 + 4 * g;
    const size_t row = (size_t)bb * SEQ + tt;
    const bf16x4 u4 = *(const bf16x4*)(Us + bb * USTR + tt), x4 = *(const bf16x4*)(X0c + row);
    float y[4];
#pragma unroll
    for (int j = 0; j < 4; ++j) y[j] = bf2f((u16)x4[j]) * (acc[m8][j] + skip * bf2f((u16)u4[j]));
    uint2 o; o.x = pk_bf16(y[0], y[1]); o.y = pk_bf16(y[2], y[3]);
    *(uint2*)(YHc + row) = o;
  }
  __syncthreads();
}

DEVI void yht_phase(const Params& p, int Mrows) {
  const u16* YHT = (const u16*)(p.ws + OFF_YHT); u16* YC = (u16*)(p.ws + OFF_H);
  u16* tile = (u16*)smem;
  const int tid = otid();
  const int nit = (Mrows / 256) * 4;
  for (int it = blockIdx.x; it < nit; it += gridDim.x) {
    const int cg = it & 3, row0 = (it >> 2) * 256;
    { uint4 v[4];
#pragma unroll
      for (int k = 0; k < 4; ++k) { const int idx = tid + k * NTHREADS, chn = idx >> 5, ck = idx & 31; v[k] = *(const uint4*)(YHT + (size_t)(cg * 64 + chn) * T + row0 + ck * 8); }
#pragma unroll
      for (int k = 0; k < 4; ++k) { const int idx = tid + k * NTHREADS, chn = idx >> 5, ck = idx & 31; *(uint4*)(tile + chn * 264 + ck * 8) = v[k]; } }
    __syncthreads();
#pragma unroll
    for (int k = 0; k < 4; ++k) {
      const int idx = tid + k * NTHREADS, r = idx >> 3, q = idx & 7;
      const u16* tp = tile + (q * 8) * 264 + r;
      uint4 o;
      o.x = (unsigned)tp[0] | ((unsigned)tp[264] << 16); o.y = (unsigned)tp[528] | ((unsigned)tp[792] << 16);
      o.z = (unsigned)tp[1056] | ((unsigned)tp[1320] << 16); o.w = (unsigned)tp[1584] | ((unsigned)tp[1848] << 16);
      *(uint4*)(YC + (size_t)(row0 + r) * D + 256 + cg * 64 + q * 8) = o;
    }
    __syncthreads();
  }
}

#define XB_TMO      128
#define XB_XCNT(j)  (256  + 64 * (j))
#define XB_XSUB(j)  (1280 + 64 * (j))
#define XB_XGEN(j)  (2304 + 64 * (j))
#define XB_TOP      3328
#define XB_TOPGEN   3392
#define XCD_BAR_WORDS 3456
#define XB_SPIN_CAP (1u << 18)
DEVI unsigned xb_ld(unsigned* q)              { return __hip_atomic_load(q, __ATOMIC_RELAXED, __HIP_MEMORY_SCOPE_AGENT); }
DEVI unsigned xb_add(unsigned* q, unsigned v) { return __hip_atomic_fetch_add(q, v, __ATOMIC_RELAXED, __HIP_MEMORY_SCOPE_AGENT); }
DEVI unsigned xb_xcc_id() { return (unsigned)__builtin_amdgcn_s_getreg((3 << 11) | 20) & 0xFu; }
#define XB_SPIN(cond, bar) do { unsigned _sp = 0; while (cond) { __builtin_amdgcn_s_sleep(1); \
    if ((++_sp & 255u) == 0u) { if (xb_ld(&(bar)[XB_TMO])) break; if (_sp > XB_SPIN_CAP) { atomicAdd(&(bar)[XB_TMO], 1u); break; } } } } while (0)
DEVI void xcd_barrier_complete(unsigned* bar, unsigned x, unsigned& nloc, unsigned& nx) {
  const unsigned G = gridDim.x;
  unsigned sum, cnt, mine, sp = 0u;
  for (;;) {
    sum = 0u; cnt = 0u; mine = 0u;
#pragma unroll
    for (unsigned j = 0; j < 16; ++j) { const unsigned c = xb_ld(&bar[XB_XCNT(j)]); sum += c; cnt += (c > 0u) ? 1u : 0u; mine = (j == x) ? c : mine; }
    if (sum == G) break;
    __builtin_amdgcn_s_sleep(1);
    if ((++sp & 255u) == 0u) { if (xb_ld(&bar[XB_TMO])) break; if (sp > XB_SPIN_CAP) { atomicAdd(&bar[XB_TMO], 1u); break; } }
  }
  nloc = mine > 0u ? mine : 1u; nx = cnt > 0u ? cnt : 1u;
}
DEVI void xcd_barrier(const Params& p) {
  asm volatile("s_waitcnt vmcnt(0)" ::: "memory");
  __syncthreads();
  if (otid() == 0) {
    unsigned* bar = (unsigned*)(p.ws + OFF_BAR);
    volatile unsigned* st = (volatile unsigned*)(smem + LDS_BYTES - 256);
    const unsigned x = xb_xcc_id();
    __builtin_amdgcn_s_waitcnt(0);
    unsigned nloc = st[0], nx = st[1];
    if (nloc == 0u) { xcd_barrier_complete(bar, x, nloc, nx); st[0] = nloc; st[1] = nx; }
    const unsigned old = xb_add(&bar[XB_XSUB(x)], 1u);
    const unsigned gen = old / nloc;
    if (old + 1u == (gen + 1u) * nloc) {
      __builtin_amdgcn_fence(__ATOMIC_RELEASE, "agent");
      asm volatile("s_waitcnt vmcnt(0)" ::: "memory");
      const unsigned og = xb_add(&bar[XB_TOP], 1u);
      const unsigned tg = og / nx;
      if (og + 1u == (tg + 1u) * nx) xb_add(&bar[XB_TOPGEN], 1u);
      else XB_SPIN(xb_ld(&bar[XB_TOPGEN]) == tg, bar);
      __builtin_amdgcn_fence(__ATOMIC_ACQUIRE, "agent");
      xb_add(&bar[XB_XGEN(x)], 1u);
      asm volatile("s_waitcnt vmcnt(0)" ::: "memory");
    } else {
      XB_SPIN(xb_ld(&bar[XB_XGEN(x)]) == gen, bar);
      __builtin_amdgcn_fence(__ATOMIC_ACQUIRE, "agent");
      asm volatile("s_waitcnt vmcnt(0)" ::: "memory");
    }
  }
  __syncthreads();
}

#ifndef PROBE
#define PROBE -1
#endif
#define GSYNC() xcd_barrier(p)
#define PHASE(id, ...) do { { const float rcf = 1.f; (void)rcf; __VA_ARGS__ } GSYNC(); if (PROBE == (id)) { { const float rcf = 0.f; (void)rcf; __VA_ARGS__ } GSYNC(); } } while (0)
__global__ void __launch_bounds__(NTHREADS) mega(Params p_in) {
  cg::grid_group grid = cg::this_grid();
  Params p = p_in;
  p.wv = __builtin_amdgcn_readfirstlane((int)(threadIdx.x >> 6));
  if (threadIdx.x == 0) {
    volatile unsigned* st = (volatile unsigned*)(smem + LDS_BYTES - 256); st[0] = 0u; st[1] = 0u;
    (void)xb_add(&((unsigned*)(p.ws + OFF_BAR))[XB_XCNT(xb_xcc_id())], 1u);
  }
  __syncthreads();
  phase0(p);
  grid.sync();
  if (PROBE == 0) { phase0(p); GSYNC(); }
  float* const SSQ = (float*)(p.ws + OFF_SSQ);
  const float* const GVt = (const float*)(p.ws + OFF_GV);
#pragma unroll 1
  for (int l = 0; l < 2; ++l) {
    const int Mpost = l == 0 ? T : TL;
    if (l == 0) PHASE(1, norm_phase(p, 0, 0, 0, T, true); prep2_phase(p);
      { const f32x4* src = (const f32x4*)p.in[2]; f32x4* dst = (f32x4*)((float*)(p.ws + OFF_X) + (size_t)TL * D);
        for (int i = blockIdx.x * NTHREADS + otid(); i < TC * D / 4; i += gridDim.x * NTHREADS) dst[i] = src[i]; });
    PHASE(2, { EpiAct e{(u16*)(p.ws + OFF_BIG), l == 1 ? SSQ + (size_t)1 * 4 * T : nullptr, (const float*)(p.ws + OFF_SW1)};
      gemm_phase(p, (const u16*)(p.ws + OFF_H), (const u16*)(p.ws + OFF_W1T) + (size_t)(l * 2 + 0) * 5632 * 1024, T, 2 * DFF, D, 0, e); });
    PHASE(3, { float* X = (float*)(p.ws + OFF_X); const float* modl = (const float*)(p.ws + OFF_MOD) + (size_t)l * 9 * 9216;
      const u16* W2 = (const u16*)(p.ws + OFF_W2T) + (size_t)(l * 2 + 0) * 1024 * 2816;
      EpiRes e{(l == 0 && rcf != 0.f) ? p.in[0] : X, X + (size_t)TL * D, X, modl, 2, 0.5f * rcf,
               rcf != 0.f ? (u16*)(p.ws + OFF_H) : nullptr, GVt + (size_t)(l * 3 + 1) * 9 * D, rcf != 0.f ? SSQ + (size_t)(l == 0 ? 0 : 2) * 4 * T : nullptr, (u16*)(p.ws + OFF_PS)};
      gemm_phase(p, (const u16*)(p.ws + OFF_BIG), W2, TL, D, DFF, TC, e); });
    PHASE(14, ctx_combine_phase(p, l, 2, 0.5f * rcf, l, 1););
    PHASE(4, { EpiProj e{(u16*)(p.ws + OFF_PT), (u16*)(p.ws + OFF_QK), (const float*)(p.ws + OFF_ROPE), (const float*)(p.ws + OFF_ROPE) + 4096 * 32,
                         SSQ + (size_t)(l == 0 ? 0 : 2) * 4 * T, (const float*)(p.ws + OFF_SWIN) + (size_t)l * 9 * 2048};
      gemm_phase(p, (const u16*)(p.ws + OFF_H), (const u16*)(p.ws + OFF_WINT) + (size_t)l * 2048 * 1024, T, DIN, D, 0, e); });
    PHASE(5, { const int n_att = l == 0 ? 512 + 32 : 512, n_lru = 1088;
      for (int it = blockIdx.x; it < n_att + n_lru; it += gridDim.x) { if (it < n_att) attn_item(p, l, it); else lru_item(p, l, it - n_att, 0); }
      uprep_phase(p, l); });
    if (PROBE == 8) { for (int it = blockIdx.x; it < 1088; it += gridDim.x) lru_item(p, l, it, 0); GSYNC(); }
    if (PROBE == 9) { for (int it = blockIdx.x; it < 512; it += gridDim.x) attn_item(p, l, it); GSYNC(); }
    if (PROBE == 11) { uprep_phase(p, l); GSYNC(); }
    PHASE(6, { const int n_t1 = 256, n_t2 = l == 0 ? 256 : 0, n_lru = l == 0 ? 1088 : 1024;
      for (int it = blockIdx.x; it < n_t1 + n_t2 + n_lru; it += gridDim.x) {
        if (it < n_t1) toep_item_lat(p, l, it);
        else if (it < n_t1 + n_t2) toep_item(p, l, it - n_t1, 1);
        else lru_item(p, l, it - n_t1 - n_t2, 1);
      } });
    if (PROBE == 10) { for (int it = blockIdx.x; it < 256; it += gridDim.x) toep_item_lat(p, l, it); GSYNC(); }
    PHASE(12, yht_phase(p, Mpost););
    PHASE(7, { float* X = (float*)(p.ws + OFF_X); const float* modl = (const float*)(p.ws + OFF_MOD) + (size_t)l * 9 * 9216;
      const u16* WO = (const u16*)(p.ws + OFF_WOT) + (size_t)l * 1024 * 1024;
      EpiRes e{X, X + (size_t)TL * D, X, modl, 5, 1.0f * rcf, nullptr, nullptr, nullptr, (u16*)(p.ws + OFF_PS)};
      gemm_phase(p, (const u16*)(p.ws + OFF_H), WO, TL, D, D, l == 0 ? TC : 0, e); });
    PHASE(1, norm_phase(p, l, 2, 0, TL, false); if (l == 0) ctx_combine_phase(p, 0, 5, 1.0f * rcf, 0, 2););
    PHASE(2, { EpiAct e{(u16*)(p.ws + OFF_BIG), nullptr, nullptr};
      gemm_phase(p, (const u16*)(p.ws + OFF_H), (const u16*)(p.ws + OFF_W1T) + (size_t)(l * 2 + 1) * 5632 * 1024, Mpost, 2 * DFF, D, 0, e); });
    PHASE(3, { float* X = (float*)(p.ws + OFF_X); const float* modl = (const float*)(p.ws + OFF_MOD) + (size_t)l * 9 * 9216;
      const u16* W2 = (const u16*)(p.ws + OFF_W2T) + (size_t)(l * 2 + 1) * 1024 * 2816;
      EpiRes e{X, X + (size_t)TL * D, X, modl, 8, 0.5f * rcf,
               (l == 0 && rcf != 0.f) ? (u16*)(p.ws + OFF_H) : nullptr, GVt + (size_t)(1 * 3 + 0) * 9 * D, (l == 0 && rcf != 0.f) ? SSQ + (size_t)1 * 4 * T : nullptr, (u16*)(p.ws + OFF_PS)};
      gemm_phase(p, (const u16*)(p.ws + OFF_BIG), W2, TL, D, DFF, l == 0 ? TC : 0, e); });
    if (l == 0) PHASE(14, ctx_combine_phase(p, 0, 8, 0.5f * rcf, 1, 0););
  }
  if (PROBE == 13) { for (int i = 0; i < 20; ++i) GSYNC(); }
  final_norm_phase(p);
}

extern "C" void kernel_launch(void* const* d_in, const int* in_sizes, int n_in, void* d_out, int out_size, void* d_ws, size_t ws_size, hipStream_t stream) {
  static int grid_blocks = 0;
  if (!grid_blocks) {
    if (ws_size < WS_END || n_in != 29) { fprintf(stderr, "kernel_launch: workspace %zu < %zu or n_in %d != 29\n", ws_size, (size_t)WS_END, n_in); grid_blocks = -1; return; }
    int dev = 0, cus = 0, per_cu = 0;
    hipGetDevice(&dev);
    hipDeviceGetAttribute(&cus, hipDeviceAttributeMultiprocessorCount, dev);
    if (hipFuncSetAttribute((const void*)mega, hipFuncAttributeMaxDynamicSharedMemorySize, LDS_BYTES) != hipSuccess) { fprintf(stderr, "hipFuncSetAttribute failed\n"); }
    hipOccupancyMaxActiveBlocksPerMultiprocessor(&per_cu, (const void*)mega, NTHREADS, LDS_BYTES);
    if (per_cu < 1) { fprintf(stderr, "occupancy query returned %d\n", per_cu); per_cu = 1; }
    if (per_cu > 1) per_cu = 1;
    grid_blocks = cus * per_cu;
    (void)hipGetLastError();
  }
  if (grid_blocks < 0) return;
  Params p{};
  for (int i = 0; i < 29; ++i) p.in[i] = (const float*)d_in[i];
  p.out = (float*)d_out; p.ws = (unsigned char*)d_ws;
  if (hipMemsetAsync((char*)d_ws + OFF_BAR, 0, (size_t)3456 * 4, stream) != hipSuccess) { fprintf(stderr, "kernel_launch: memset of the barrier words failed\n"); return; }
  void* args[] = {&p};
  hipError_t e = hipLaunchCooperativeKernel((void*)mega, dim3(grid_blocks), dim3(NTHREADS), args, LDS_BYTES, stream);
  if (e != hipSuccess) fprintf(stderr, "cooperative launch failed: %s (grid %d)\n", hipGetErrorString(e), grid_blocks);
}
```
